# Optimizing an MI355X kernel written in HIP

```python
import math
import jax, jax.numpy as jnp
from jax import lax
import numpy as np

D_MODEL = 1024
BATCH = 8
SEQ = 2048
DEPTH = 2
DEC_BATCH = 128
DEC_SEQ = 8
PAST_LEN = 16384
PAGE_SIZE = 128

GROUP_W = D_MODEL // 4
MIX_W = 4 * GROUP_W
RET_HEADS = 4
RET_DK = GROUP_W // RET_HEADS
RET_DV = GROUP_W // RET_HEADS
RET_CHUNK = 64
ROPE_BASE = 10000.0
HG_HEADS = 4
HG_DK = GROUP_W // HG_HEADS
HG_DV = GROUP_W // HG_HEADS
HG_CHUNK = 16
HG_MIN_FORGET = 1e-30
SSD_HEADS = 4
SSD_HEADDIM = GROUP_W // SSD_HEADS
SSD_GROUPS = 2
SSD_STATE = 128
SSD_CONV = 4
SSD_CHUNK = 128
SSD_CONV_DIM = GROUP_W + 2 * SSD_GROUPS * SSD_STATE
S5_CH = 16
S5_GROUPS = GROUP_W // S5_CH
S5_STATE = 64
D_FF = 4 * D_MODEL
IN_COLS = 8 * GROUP_W + GROUP_W + SSD_CONV_DIM + SSD_HEADS + GROUP_W
EPS = 1e-6

kernel_name = 'hybrid_retention_hgrn2_ssd_s5_step'


def rmsnorm(x, w):
    xf = x.astype(jnp.float32)
    y = xf * lax.rsqrt(jnp.mean(xf * xf, axis=-1, keepdims=True) + EPS)
    return (y * w.astype(jnp.float32)).astype(x.dtype)


def _chunk_len(L, chunk):
    return L if L <= chunk else math.gcd(L, chunk)


def chunked_scalar_decay(q, k, v, log_a, s0, chunk):
    f32 = jnp.float32
    B, L, H, K = q.shape
    V = v.shape[-1]
    c = _chunk_len(L, chunk)
    n = L // c
    qc = q.astype(f32).reshape(B, n, c, H, K)
    kc = k.astype(f32).reshape(B, n, c, H, K)
    vc = v.astype(f32).reshape(B, n, c, H, V)
    b = jnp.cumsum(log_a.astype(f32).reshape(B, n, c, H), axis=2).transpose(0, 1, 3, 2)
    causal = jnp.tril(jnp.ones((c, c), dtype=bool))
    diff = b[..., :, None] - b[..., None, :]
    decay = jnp.where(causal, jnp.exp(jnp.where(causal, diff, 0.0)), 0.0)
    scores = jnp.einsum('bnthk,bnshk->bnhts', qc, kc) * decay
    o_intra = jnp.einsum('bnhts,bnshv->bnthv', scores, vc)
    b_last = b[..., -1]
    ds = jnp.einsum('bnhs,bnshk,bnshv->bnhkv', jnp.exp(b_last[..., None] - b), kc, vc)
    a_chunk = jnp.exp(b_last)

    def step(s, inp):
        a, d = inp
        return a[..., None, None] * s + d, s

    s_fin, s_prev = lax.scan(step, s0.astype(f32), (jnp.moveaxis(a_chunk, 1, 0), jnp.moveaxis(ds, 1, 0)))
    s_prev = jnp.moveaxis(s_prev, 0, 1)
    q_dec = qc * jnp.exp(b).transpose(0, 1, 3, 2)[..., None]
    o_cross = jnp.einsum('bnthk,bnhkv->bnthv', q_dec, s_prev)
    return (o_intra + o_cross).reshape(B, L, H, V), s_fin


def chunked_vector_decay(q, k, v, log_f, s0, chunk):
    f32 = jnp.float32
    B, L, H, K = q.shape
    V = v.shape[-1]
    c = _chunk_len(L, chunk)
    n = L // c
    qc = q.astype(f32).reshape(B, n, c, H, K)
    kc = k.astype(f32).reshape(B, n, c, H, K)
    vc = v.astype(f32).reshape(B, n, c, H, V)
    b = jnp.cumsum(log_f.astype(f32).reshape(B, n, c, H, K), axis=2)
    causal = jnp.tril(jnp.ones((c, c), dtype=bool))[None, None, :, :, None, None]
    diff = b[:, :, :, None] - b[:, :, None]
    decay = jnp.where(causal, jnp.exp(jnp.where(causal, diff, 0.0)), 0.0)
    scores = jnp.einsum('bnthk,bnshk,bntshk->bnhts', qc, kc, decay)
    o_intra = jnp.einsum('bnhts,bnshv->bnthv', scores, vc)
    b_last = b[:, :, -1]
    ds = jnp.einsum('bnshk,bnshv->bnhkv', kc * jnp.exp(b_last[:, :, None] - b), vc)
    a_chunk = jnp.exp(b_last)

    def step(s, inp):
        a, d = inp
        return a[..., None] * s + d, s

    s_fin, s_prev = lax.scan(step, s0.astype(f32), (jnp.moveaxis(a_chunk, 1, 0), jnp.moveaxis(ds, 1, 0)))
    s_prev = jnp.moveaxis(s_prev, 0, 1)
    o_cross = jnp.einsum('bnthk,bnhkv->bnthv', qc * jnp.exp(b), s_prev)
    return (o_intra + o_cross).reshape(B, L, H, V), s_fin


def rotate_every_two(x, pos0):
    L, d = x.shape[1], x.shape[-1]
    angle = 1.0 / (ROPE_BASE ** jnp.linspace(0.0, 1.0, d // 2, dtype=jnp.float32))
    pos = (pos0 + jnp.arange(L)).astype(jnp.float32)
    theta = pos[:, None] * angle[None, :]
    cos = jnp.cos(theta)[None, :, None, :]
    sin = jnp.sin(theta)[None, :, None, :]
    xf = x.astype(jnp.float32).reshape(x.shape[:-1] + (d // 2, 2))
    x1, x2 = xf[..., 0], xf[..., 1]
    return jnp.stack([x1 * cos - x2 * sin, x1 * sin + x2 * cos], axis=-1).reshape(x.shape)


def retention(q, k, v, g, s0, pos0):
    B, L, _ = q.shape
    qh = rotate_every_two(q.reshape(B, L, RET_HEADS, RET_DK), pos0)
    kh = rotate_every_two(k.reshape(B, L, RET_HEADS, RET_DK), pos0) * (RET_DK ** -0.5)
    vh = v.reshape(B, L, RET_HEADS, RET_DV)
    log_gamma = jnp.log(1.0 - jnp.exp2(-5.0 - jnp.arange(RET_HEADS, dtype=jnp.float32)))
    log_a = jnp.broadcast_to(log_gamma, (B, L, RET_HEADS))
    o, s = chunked_scalar_decay(qh, kh, vh, log_a, s0, RET_CHUNK)
    mu = jnp.mean(o, axis=-1, keepdims=True)
    var = jnp.mean(jnp.square(o - mu), axis=-1, keepdims=True)
    o = (o - mu) * lax.rsqrt(var + EPS)
    return o.reshape(B, L, GROUP_W) * jax.nn.silu(g.astype(jnp.float32)), s


def hgrn2(q, f, i, g, s0, lower):
    B, L, _ = q.shape
    ff = f.astype(jnp.float32)
    forget = lower + (1.0 - lower) * jax.nn.sigmoid(ff)
    log_forget = jnp.log(jnp.maximum(forget, HG_MIN_FORGET))
    key = (1.0 - lower) * jax.nn.sigmoid(-ff)
    qh = jax.nn.silu(q.astype(jnp.float32)).reshape(B, L, HG_HEADS, HG_DK)
    o, s = chunked_vector_decay(qh, key.reshape(B, L, HG_HEADS, HG_DK),
                                i.reshape(B, L, HG_HEADS, HG_DV),
                                log_forget.reshape(B, L, HG_HEADS, HG_DK), s0, HG_CHUNK)
    o = o * lax.rsqrt(jnp.mean(o * o, axis=-1, keepdims=True) + EPS)
    return o.reshape(B, L, GROUP_W) * jax.nn.silu(g.astype(jnp.float32)), s


def ssd_mixer(z, xbc, dt, conv_buf, s0, conv_w, conv_b, dt_bias, a_log, d_skip, norm_w):
    B, L, _ = xbc.shape
    f32 = jnp.float32
    xpad = jnp.concatenate([conv_buf.astype(xbc.dtype), xbc], axis=1)
    new_buf = xpad[:, -(SSD_CONV - 1):]
    conv = lax.conv_general_dilated(xpad, conv_w[:, None, :].astype(xbc.dtype), window_strides=(1,),
                                    padding='VALID', dimension_numbers=('NWC', 'WIO', 'NWC'),
                                    feature_group_count=SSD_CONV_DIM)
    xbc = jax.nn.silu(conv.astype(f32) + conv_b.astype(f32))
    xs, bm, cm = jnp.split(xbc, [GROUP_W, GROUP_W + SSD_GROUPS * SSD_STATE], axis=-1)
    xs = xs.reshape(B, L, SSD_HEADS, SSD_HEADDIM)
    rep = SSD_HEADS // SSD_GROUPS
    bm = jnp.repeat(bm.reshape(B, L, SSD_GROUPS, SSD_STATE), rep, axis=2)
    cm = jnp.repeat(cm.reshape(B, L, SSD_GROUPS, SSD_STATE), rep, axis=2)
    delta = jax.nn.softplus(dt.astype(f32) + dt_bias.astype(f32))
    log_a = delta * (-jnp.exp(a_log.astype(f32)))
    y, s = chunked_scalar_decay(cm, bm * delta[..., None], xs, log_a, s0, SSD_CHUNK)
    y = y + d_skip.astype(f32)[:, None] * xs
    y = (y.reshape(B, L, GROUP_W) * jax.nn.silu(z.astype(f32))).reshape(B, L, SSD_GROUPS, -1)
    y = y * lax.rsqrt(jnp.mean(y * y, axis=-1, keepdims=True) + EPS)
    return y.reshape(B, L, GROUP_W) * norm_w.astype(f32), s, new_buf


def s5_mixer(u, s0_re, s0_im, a_re, a_im, log_dt, b_re, b_im, c_re, c_im, d_skip, glu_w, glu_b):
    B, L, _ = u.shape
    f32 = jnp.float32
    uf = u.astype(f32).reshape(B, L, S5_GROUPS, S5_CH)
    lam = lax.complex(a_re.astype(f32), a_im.astype(f32))
    step = jnp.exp(log_dt.astype(f32))[:, None]
    a_bar = jnp.exp(lam * step)
    b_bar = ((a_bar - 1.0) / lam)[..., None] * lax.complex(b_re.astype(f32), b_im.astype(f32))
    bu = jnp.einsum('gph,blgh->blgp', b_bar, uf)
    s0 = lax.complex(s0_re.astype(f32), s0_im.astype(f32))
    bu = bu.at[:, 0].add(a_bar * s0)
    a_seq = jnp.broadcast_to(a_bar, bu.shape)

    def combine(e1, e2):
        a1, x1 = e1
        a2, x2 = e2
        return a2 * a1, a2 * x1 + x2

    _, states = lax.associative_scan(combine, (a_seq, bu), axis=1)
    cmat = lax.complex(c_re.astype(f32), c_im.astype(f32))
    y = jnp.einsum('ghp,blgp->blgh', cmat, states).real + d_skip.astype(f32).reshape(S5_GROUPS, S5_CH) * uf
    y = jax.nn.gelu(y.reshape(B, L, GROUP_W))
    y = y * jax.nn.sigmoid(y @ glu_w.astype(f32) + glu_b.astype(f32))
    s_fin = states[:, -1]
    return y, jnp.real(s_fin), jnp.imag(s_fin)


def run_trunk(x, pos0, st_ret, st_hg, st_ssd, st_conv, st_s5_re, st_s5_im,
              norm_mix, w_in, w_out, hg_lb_logits, ssd_conv_w, ssd_conv_b, ssd_dt_bias,
              ssd_a_log, ssd_d, ssd_norm, s5_a_re, s5_a_im, s5_log_dt, s5_b_re, s5_b_im,
              s5_c_re, s5_c_im, s5_d, s5_glu_w, s5_glu_b, norm_mlp, w_up, w_down, norm_final):
    sizes = [GROUP_W] * 8 + [GROUP_W, SSD_CONV_DIM, SSD_HEADS, GROUP_W]
    cuts = [int(c) for c in np.cumsum(sizes)[:-1]]
    sm = jax.nn.softmax(hg_lb_logits.astype(jnp.float32), axis=0)
    lower = jnp.cumsum(sm, axis=0) - sm[0]
    new = [[] for _ in range(6)]
    for l in range(DEPTH):
        h = rmsnorm(x, norm_mix[l])
        (rq, rk, rv, rg, hq, hf, hi, hgate, sz, sxbc, sdt, su) = jnp.split(h @ w_in[l], cuts, axis=-1)
        ya, s_a = retention(rq, rk, rv, rg, st_ret[l], pos0)
        yb, s_b = hgrn2(hq, hf, hi, hgate, st_hg[l], lower[l])
        yc, s_c, c_c = ssd_mixer(sz, sxbc, sdt, st_conv[l], st_ssd[l], ssd_conv_w[l], ssd_conv_b[l],
                                 ssd_dt_bias[l], ssd_a_log[l], ssd_d[l], ssd_norm[l])
        yd, s_re, s_im = s5_mixer(su, st_s5_re[l], st_s5_im[l], s5_a_re[l], s5_a_im[l], s5_log_dt[l],
                                  s5_b_re[l], s5_b_im[l], s5_c_re[l], s5_c_im[l], s5_d[l],
                                  s5_glu_w[l], s5_glu_b[l])
        mix = jnp.concatenate([ya, yb, yc, yd], axis=-1).astype(x.dtype)
        x = x + mix @ w_out[l]
        h = rmsnorm(x, norm_mlp[l])
        x = x + jnp.square(jax.nn.relu(h @ w_up[l])) @ w_down[l]
        for lst, s in zip(new, (s_a, s_b, s_c, c_c, s_re, s_im)):
            lst.append(s)
    y = rmsnorm(x, norm_final)
    return (y, jnp.stack(new[0]), jnp.stack(new[1]), jnp.stack(new[2]),
            jnp.stack(new[3]), jnp.stack(new[4]), jnp.stack(new[5]))


def setup_inputs(seed: int = 0) -> dict:
    key = jax.random.key(seed)
    ks = iter(jax.random.split(key, 48))
    f32 = jnp.float32

    def nrm(shape, scale):
        return scale * jax.random.normal(next(ks), shape, f32)

    def unif(shape, lo, hi):
        return jax.random.uniform(next(ks), shape, f32, lo, hi)

    ssd_dt = jnp.exp(unif((DEPTH, SSD_HEADS), math.log(1e-3), math.log(1e-1)))
    return {
        'x_prompt': nrm((BATCH, SEQ, D_MODEL), 1.0),
        'x_sample': nrm((DEC_BATCH, DEC_SEQ, D_MODEL), 1.0),
        'state_ret': nrm((DEPTH, DEC_BATCH, RET_HEADS, RET_DK, RET_DV), 1.0),
        'state_hgrn': nrm((DEPTH, DEC_BATCH, HG_HEADS, HG_DK, HG_DV), 0.5),
        'state_ssd': nrm((DEPTH, DEC_BATCH, SSD_HEADS, SSD_STATE, SSD_HEADDIM), 0.5),
        'state_ssd_conv': nrm((DEPTH, DEC_BATCH, SSD_CONV - 1, SSD_CONV_DIM), 1.0),
        'state_s5_re': nrm((DEPTH, DEC_BATCH, S5_GROUPS, S5_STATE), 0.5),
        'state_s5_im': nrm((DEPTH, DEC_BATCH, S5_GROUPS, S5_STATE), 0.5),
        'norm_mix': 1.0 + nrm((DEPTH, D_MODEL), 0.02),
        'w_in': nrm((DEPTH, D_MODEL, IN_COLS), D_MODEL ** -0.5),
        'w_out': nrm((DEPTH, MIX_W, D_MODEL), MIX_W ** -0.5),
        'hg_lb_logits': nrm((DEPTH, GROUP_W), 1.0),
        'ssd_conv_w': nrm((DEPTH, SSD_CONV, SSD_CONV_DIM), SSD_CONV ** -0.5),
        'ssd_conv_b': nrm((DEPTH, SSD_CONV_DIM), 0.02),
        'ssd_dt_bias': ssd_dt + jnp.log(-jnp.expm1(-ssd_dt)),
        'ssd_a_log': jnp.log(unif((DEPTH, SSD_HEADS), 1.0, 16.0)),
        'ssd_d': 1.0 + nrm((DEPTH, SSD_HEADS), 0.1),
        'ssd_norm': 1.0 + nrm((DEPTH, GROUP_W), 0.02),
        's5_a_re': -0.5 + nrm((DEPTH, S5_GROUPS, S5_STATE), 0.01),
        's5_a_im': math.pi * jnp.arange(S5_STATE, dtype=f32) + nrm((DEPTH, S5_GROUPS, S5_STATE), 0.01),
        's5_log_dt': unif((DEPTH, S5_GROUPS), math.log(1e-3), math.log(1e-1)),
        's5_b_re': nrm((DEPTH, S5_GROUPS, S5_STATE, S5_CH), (2 * S5_CH) ** -0.5),
        's5_b_im': nrm((DEPTH, S5_GROUPS, S5_STATE, S5_CH), (2 * S5_CH) ** -0.5),
        's5_c_re': nrm((DEPTH, S5_GROUPS, S5_CH, S5_STATE), S5_STATE ** -0.5),
        's5_c_im': nrm((DEPTH, S5_GROUPS, S5_CH, S5_STATE), S5_STATE ** -0.5),
        's5_d': nrm((DEPTH, GROUP_W), 1.0),
        's5_glu_w': nrm((DEPTH, GROUP_W, GROUP_W), GROUP_W ** -0.5),
        's5_glu_b': nrm((DEPTH, GROUP_W), 0.02),
        'norm_mlp': 1.0 + nrm((DEPTH, D_MODEL), 0.02),
        'w_up': nrm((DEPTH, D_MODEL, D_FF), D_MODEL ** -0.5),
        'w_down': nrm((DEPTH, D_FF, D_MODEL), D_FF ** -0.5),
        'norm_final': 1.0 + nrm((D_MODEL,), 0.02),
    }


def reference(x_prompt, x_sample, state_ret, state_hgrn, state_ssd, state_ssd_conv, state_s5_re, state_s5_im,
              norm_mix, w_in, w_out, hg_lb_logits, ssd_conv_w, ssd_conv_b, ssd_dt_bias, ssd_a_log, ssd_d,
              ssd_norm, s5_a_re, s5_a_im, s5_log_dt, s5_b_re, s5_b_im, s5_c_re, s5_c_im, s5_d, s5_glu_w,
              s5_glu_b, norm_mlp, w_up, w_down, norm_final):
    nb = x_prompt.shape[0]

    def fresh(st):
        return jnp.zeros((DEPTH, nb) + st.shape[2:], st.dtype)

    (y_prompt, p_ret, p_hgrn, p_ssd, p_conv, p_s5_re, p_s5_im) = run_trunk(
        x_prompt, 0, fresh(state_ret), fresh(state_hgrn), fresh(state_ssd), fresh(state_ssd_conv),
        fresh(state_s5_re), fresh(state_s5_im),
        norm_mix, w_in, w_out, hg_lb_logits, ssd_conv_w, ssd_conv_b, ssd_dt_bias, ssd_a_log, ssd_d,
        ssd_norm, s5_a_re, s5_a_im, s5_log_dt, s5_b_re, s5_b_im, s5_c_re, s5_c_im, s5_d, s5_glu_w,
        s5_glu_b, norm_mlp, w_up, w_down, norm_final)
    (y_sample, s_ret, s_hgrn, s_ssd, s_conv, s_s5_re, s_s5_im) = run_trunk(
        x_sample, PAST_LEN, state_ret, state_hgrn, state_ssd, state_ssd_conv, state_s5_re, state_s5_im,
        norm_mix, w_in, w_out, hg_lb_logits, ssd_conv_w, ssd_conv_b, ssd_dt_bias, ssd_a_log, ssd_d,
        ssd_norm, s5_a_re, s5_a_im, s5_log_dt, s5_b_re, s5_b_im, s5_c_re, s5_c_im, s5_d, s5_glu_w,
        s5_glu_b, norm_mlp, w_up, w_down, norm_final)
    return (y_prompt, y_sample, p_ret, p_hgrn, p_ssd, p_conv, p_s5_re, p_s5_im,
            s_ret, s_hgrn, s_ssd, s_conv, s_s5_re, s_s5_im)
```

```cpp
#include <hip/hip_cooperative_groups.h>
#include <cstdio>
namespace cg = cooperative_groups;
#include <hip/hip_runtime.h>
namespace pg8 {
#define PG8_LAS __attribute__((address_space(3)))
typedef unsigned short bf16_t;
typedef short bf16x8 __attribute__((ext_vector_type(8)));
typedef float f32x4 __attribute__((ext_vector_type(4)));
typedef unsigned u32x4 __attribute__((ext_vector_type(4)));
constexpr int BM = 256, BK = 64, HALF = 128, HTB = HALF * BK * 2  , STAGE_BYTES = 8 * HTB, NXCD = 8, WGM = 8;

__host__ __device__ __forceinline__ int lds_byte(int r, int c) { const int st = (r >> 4) * 2 + (c >> 5), rr = r & 15, cc = c & 31, ob = rr * 64 + cc * 2; return st * 1024 + (ob ^ (((ob >> 9) & 1) << 5)); }
__host__ __device__ __forceinline__ void stage_rc(int b, int& R, int& C) { const int st = b / 1024, sb = b % 1024, swz = sb ^ (((sb >> 9) & 1) << 5); R = (st >> 1) * 16 + swz / 64; C = (st & 1) * 32 + (swz % 64) / 2; }
__host__ __device__ __forceinline__ int perm32(int rho) { const int n = rho >> 4, i = rho & 15; return 8 * (i >> 2) + 4 * n + (i & 3); }

struct Unit { int pm, pn; };
struct Gemm { const bf16_t* A; const bf16_t* Bt; int M, N, K; };

struct StaticOrder {
    int nM, nN, nwg, G, c;
    __host__ __device__ void init(int M, int N, int G_, int c_) { nM = M / BM; nN = N / BM; nwg = nM * nN; G = G_; c = c_; }
    __host__ __device__ bool next(int i, Unit& u) const {
        const long L = (long)i * G + c; if (L >= nwg) return false;
        int wgid = (int)L; { const int q = nwg / NXCD, r = nwg % NXCD, xcd = wgid % NXCD, off = wgid / NXCD; wgid = (xcd < r ? xcd * (q + 1) : r * (q + 1) + (xcd - r) * q) + off; }
        const int nig = WGM * nN, gid = wgid / nig, fm = gid * WGM, gsz = (nM - fm) < WGM ? (nM - fm) : WGM;
        u.pm = fm + ((wgid % nig) % gsz); u.pn = (wgid % nig) / gsz; return true;
    }
    __device__ __forceinline__ void a_ready(const Unit&) const {}
    __device__ __forceinline__ void done(const Unit&) const {}
};
typedef __bf16 bf16v2_t __attribute__((ext_vector_type(2)));
__device__ __forceinline__ unsigned cvt_pk_bf16(float lo, float hi) { bf16v2_t v; v.x = (__bf16)lo; v.y = (__bf16)hi; return __builtin_bit_cast(unsigned, v); }
typedef float f32x2 __attribute__((ext_vector_type(2)));
__device__ __forceinline__ int opaque_tid() { int t = (int)threadIdx.x; asm volatile("" : "+v"(t)); return t; }
typedef unsigned u32x2 __attribute__((ext_vector_type(2)));
constexpr int TP_ROWS = 16384;
template <int ACT> struct EpiScaleBf16 {
    static constexpr bool PERM = true, AFTER_DRAIN = false;
    bf16_t* O; int ldc; const float* ssq;
    __device__ __forceinline__ void operator()(const f32x4 (&acc)[2][2][4][2], const Unit& u, int wr, int wc, int fr, int fq) const {
        const int row0 = u.pm * BM + wr * 64 + fr, col0 = u.pn * BM + wc * 32 + 8 * fq;
#pragma unroll
        for (int ai = 0; ai < 2; ++ai)
#pragma unroll
            for (int m = 0; m < 4; ++m) {
                const int row = row0 + ai * HALF + m * 16;
                const f32x4* sp = (const f32x4*)(ssq + (size_t)row * 16);
                const f32x4 s0 = sp[0], s1 = sp[1], s2 = sp[2], s3 = sp[3];
                const float ss = ((s0[0] + s0[1]) + (s0[2] + s0[3])) + ((s1[0] + s1[1]) + (s1[2] + s1[3])) + ((s2[0] + s2[1]) + (s2[2] + s2[3])) + ((s3[0] + s3[1]) + (s3[2] + s3[3]));
                const float rstd = __builtin_amdgcn_rsqf(ss * (1.0f / 1024.0f) + 1e-6f);
                bf16_t* rowp = O + (size_t)row * ldc + col0;
#pragma unroll
                for (int bj = 0; bj < 2; ++bj) {
                    f32x4 v0 = acc[ai][bj][m][0] * rstd, v1 = acc[ai][bj][m][1] * rstd;
                    if (ACT == 1) {
#pragma unroll
                        for (int j = 0; j < 4; ++j) { const float a = fmaxf(v0[j], 0.f), b = fmaxf(v1[j], 0.f); v0[j] = a * a; v1[j] = b * b; }
                    }
                    u32x4 w; w.x = cvt_pk_bf16(v0[0], v0[1]); w.y = cvt_pk_bf16(v0[2], v0[3]); w.z = cvt_pk_bf16(v1[0], v1[1]); w.w = cvt_pk_bf16(v1[2], v1[3]);
                    *(u32x4*)(rowp + bj * HALF) = w;
                }
            }
    }
};
struct EpiRes {
    static constexpr bool PERM = false, AFTER_DRAIN = false;
    const float* base0; const float* base1; float* X; bf16_t* XB; float* ssq;
    __device__ __forceinline__ void operator()(const f32x4 (&acc)[2][2][4][2], const Unit& u, int wr, int wc, int fr, int fq) const {
        const int row0 = u.pm * BM + wr * 64 + fr, col0 = u.pn * BM + wc * 32 + 4 * fq;
#pragma unroll
        for (int ai = 0; ai < 2; ++ai)
#pragma unroll
            for (int m = 0; m < 4; ++m) {
                const int row = row0 + ai * HALF + m * 16;
                const float* bp = (row < TP_ROWS) ? (base0 + (size_t)row * 1024) : (base1 + (size_t)(row - TP_ROWS) * 1024);
                float s = 0.f;
#pragma unroll
                for (int bj = 0; bj < 2; ++bj)
#pragma unroll
                    for (int n = 0; n < 2; ++n) {
                        const int c = col0 + bj * HALF + n * 16;
                        const f32x4 b = *(const f32x4*)(bp + c);
                        const f32x4 v = b + acc[ai][bj][m][n];
                        *(f32x4*)(X + (size_t)row * 1024 + c) = v;
                        u32x2 w; w.x = cvt_pk_bf16(v[0], v[1]); w.y = cvt_pk_bf16(v[2], v[3]);
                        *(u32x2*)(XB + (size_t)row * 1024 + c) = w;
                        s += (v[0] * v[0] + v[1] * v[1]) + (v[2] * v[2] + v[3] * v[3]);
                    }
                s += __shfl_xor(s, 16); s += __shfl_xor(s, 32);
                if (fq == 0) ssq[(size_t)row * 16 + u.pn * 4 + wc] = s;
            }
    }
};
struct EpiGlu {
    static constexpr bool PERM = true, AFTER_DRAIN = false;
    const bf16_t* Y; bf16_t* MIX; const float* bias;
    __device__ __forceinline__ void operator()(const f32x4 (&acc)[2][2][4][2], const Unit& u, int wr, int wc, int fr, int fq) const {
        const int row0 = u.pm * BM + wr * 64 + fr, col0 = u.pn * BM + wc * 32 + 8 * fq;
#pragma unroll
        for (int ai = 0; ai < 2; ++ai)
#pragma unroll
            for (int m = 0; m < 4; ++m) {
                const int row = row0 + ai * HALF + m * 16;
#pragma unroll
                for (int bj = 0; bj < 2; ++bj) {
                    const int c = col0 + bj * HALF;
                    const u32x4 yw = *(const u32x4*)(Y + (size_t)row * 256 + c);
                    const f32x4 b0 = *(const f32x4*)(bias + c), b1 = *(const f32x4*)(bias + c + 4);
                    const f32x4 a0 = acc[ai][bj][m][0] + b0, a1 = acc[ai][bj][m][1] + b1;
                    float y[8], o[8];
                    y[0] = __uint_as_float(yw.x << 16); y[1] = __uint_as_float(yw.x & 0xffff0000u); y[2] = __uint_as_float(yw.y << 16); y[3] = __uint_as_float(yw.y & 0xffff0000u);
                    y[4] = __uint_as_float(yw.z << 16); y[5] = __uint_as_float(yw.z & 0xffff0000u); y[6] = __uint_as_float(yw.w << 16); y[7] = __uint_as_float(yw.w & 0xffff0000u);
#pragma unroll
                    for (int j = 0; j < 4; ++j) { o[j] = y[j] / (1.0f + __expf(-a0[j])); o[4 + j] = y[4 + j] / (1.0f + __expf(-a1[j])); }
                    u32x4 w; w.x = cvt_pk_bf16(o[0], o[1]); w.y = cvt_pk_bf16(o[2], o[3]); w.z = cvt_pk_bf16(o[4], o[5]); w.w = cvt_pk_bf16(o[6], o[7]);
                    *(u32x4*)(MIX + (size_t)row * 1024 + 768 + c) = w;
                    asm volatile("" ::: "memory");
                }
            }
    }
};
template <class Epi, class Sched, bool STAMP = false>
__device__ __forceinline__ void gemm_phase(PG8_LAS unsigned char* lds, const Gemm g, const Sched& S, const Epi& E, unsigned long long* stamps) {
    const int tid = opaque_tid(), wid = __builtin_amdgcn_readfirstlane(tid >> 6), lane = tid & 63, wr = wid >> 2, wc = wid & 3, fr = lane & 15, fq = lane >> 4;
    int K_ = g.K; asm volatile("" : "+s"(K_)); const int K = K_, nt = K / BK;
    int ts_lo = 0, ts_hi = 0, nts = 0; const unsigned long long rt_entry = STAMP ? (unsigned long long)wall_clock64() : 0ull;
#define PG8_STAMP() do { if (STAMP && wid == 0 && nts < 64) { const unsigned long long _c = (unsigned long long)clock64(); \
        ts_lo = (lane == nts) ? (int)(unsigned)_c : ts_lo; ts_hi = (lane == nts) ? (int)(unsigned)(_c >> 32) : ts_hi; ++nts; } } while (0)
    PG8_STAMP();
    unsigned voffA[2], voffB[2];
#pragma unroll
    for (int i = 0; i < 2; ++i) { int R, C; stage_rc(tid * 16 + i * 8192, R, C); const int Rb = Epi::PERM ? ((R & ~31) + perm32(R & 31)) : R;
        voffA[i] = (unsigned)(R * K + C) * 2u; voffB[i] = (unsigned)(Rb * K + C) * 2u; }
    const size_t kstep = (size_t)(BK * 2);
    const size_t hstep = (size_t)HALF * K * 2;
    const size_t tstep = 2 * hstep;
    const unsigned ldsw = (unsigned)wid * 1024u;
    const int aoff = lds_byte(wr * 64 + fr, fq * 8), boff = lds_byte(wc * 32 + fr, fq * 8);
#define PG8_SA(b, h) (((b) * 2 + (h)) * HTB)
#define PG8_SB(b, h) ((4 + (b) * 2 + (h)) * HTB)
#define PG8_STAGE(bufoff, gbase, voff) do { _Pragma("unroll") for (int _i = 0; _i < 2; ++_i) \
        __builtin_amdgcn_global_load_lds((const unsigned*)((const char*)(gbase) + (voff)[_i]), (PG8_LAS unsigned*)(lds + (bufoff) + ldsw + _i * 8192), 16, 0, 0); } while (0)
#define PG8_LDA(dst, b, h) do { _Pragma("unroll") for (int m = 0; m < 4; ++m) _Pragma("unroll") for (int k = 0; k < 2; ++k) dst[m][k] = *(const PG8_LAS bf16x8*)(lds + PG8_SA(b, h) + aoff + m * 2048 + k * 1024); } while (0)
#define PG8_LDB(dst, b, h) do { _Pragma("unroll") for (int n = 0; n < 2; ++n) _Pragma("unroll") for (int k = 0; k < 2; ++k) dst[n][k] = *(const PG8_LAS bf16x8*)(lds + PG8_SB(b, h) + boff + n * 2048 + k * 1024); } while (0)
#define PG8_MMA(ai, bj, At, Bt) do { __builtin_amdgcn_s_setprio(1); _Pragma("unroll") for (int m = 0; m < 4; ++m) _Pragma("unroll") for (int n = 0; n < 2; ++n) _Pragma("unroll") for (int k = 0; k < 2; ++k) \
        acc[ai][bj][m][n] = __builtin_amdgcn_mfma_f32_16x16x32_bf16(Bt[n][k], At[m][k], acc[ai][bj][m][n], 0, 0, 0); __builtin_amdgcn_s_setprio(0); } while (0)
#define PG8_WAIT_V(n) asm volatile("s_waitcnt vmcnt(" #n ")" ::: "memory")
#define PG8_WAIT_L(n) asm volatile("s_waitcnt lgkmcnt(" #n ")" ::: "memory")
#define PG8_BAR __builtin_amdgcn_s_barrier()
#define PG8_SCHED __builtin_amdgcn_sched_barrier(0)
    Unit cur, nxt; int ui = 0;
    if (!S.next(0, cur)) return;
    f32x4 acc[2][2][4][2];
#pragma unroll
    for (int a = 0; a < 2; ++a)
#pragma unroll
        for (int b = 0; b < 2; ++b)
#pragma unroll
            for (int m = 0; m < 4; ++m)
#pragma unroll
                for (int n = 0; n < 2; ++n) acc[a][b][m][n] = (f32x4){0.f, 0.f, 0.f, 0.f};
    bf16x8 At[4][2], B0[2][2], B1[2][2];
    const char* cA = (const char*)g.A + (size_t)cur.pm * tstep; const char* cB = (const char*)g.Bt + (size_t)cur.pn * tstep;
    S.a_ready(cur);
    PG8_STAGE(PG8_SB(0, 0), cB, voffB); PG8_STAGE(PG8_SA(0, 0), cA, voffA); PG8_STAGE(PG8_SB(0, 1), cB + hstep, voffB); PG8_STAGE(PG8_SA(0, 1), cA + hstep, voffA);
    if (wr == 1) PG8_BAR;
    PG8_WAIT_V(4); PG8_BAR;
    PG8_STAGE(PG8_SB(1, 0), cB + kstep, voffB); PG8_STAGE(PG8_SA(1, 0), cA + kstep, voffA); PG8_STAGE(PG8_SB(1, 1), cB + hstep + kstep, voffB);
    PG8_WAIT_V(6); PG8_BAR;
    PG8_STAMP();
    for (;;) {
        const bool has_next = S.next(ui + 1, nxt);
        const char* nA = has_next ? (const char*)g.A + (size_t)nxt.pm * tstep : cA; const char* nB = has_next ? (const char*)g.Bt + (size_t)nxt.pn * tstep : cB;
        for (int t = 0; t < nt; t += 2) {
            const bool last = (t == nt - 2);
            const char* a1 = cA + (size_t)(t + 1) * kstep;
            const char* a2 = last ? nA : cA + (size_t)(t + 2) * kstep; const char* b2 = last ? nB : cB + (size_t)(t + 2) * kstep;
            const char* a3 = a2 + kstep; const char* b3 = b2 + kstep;
            if (last && has_next) S.a_ready(nxt);
            PG8_LDB(B0, 0, 0); PG8_SCHED; PG8_LDA(At, 0, 0); PG8_STAGE(PG8_SA(1, 1), a1 + hstep, voffA);
            PG8_WAIT_L(8); PG8_BAR; PG8_WAIT_L(0); PG8_MMA(0, 0, At, B0); PG8_BAR; PG8_SCHED;
            PG8_LDB(B1, 0, 1); PG8_STAGE(PG8_SB(0, 0), b2, voffB);
            PG8_BAR; PG8_WAIT_L(0); PG8_MMA(0, 1, At, B1); PG8_BAR;
            PG8_LDA(At, 0, 1); PG8_STAGE(PG8_SA(0, 0), a2, voffA);
            PG8_BAR; PG8_WAIT_L(0); PG8_MMA(1, 0, At, B0); PG8_BAR; PG8_SCHED;
            PG8_STAGE(PG8_SB(0, 1), b2 + hstep, voffB);
            PG8_WAIT_V(6); PG8_BAR; PG8_MMA(1, 1, At, B1); PG8_BAR;
            PG8_LDB(B0, 1, 0); PG8_SCHED; PG8_LDA(At, 1, 0); PG8_STAGE(PG8_SA(0, 1), a2 + hstep, voffA);
            PG8_WAIT_L(8); PG8_BAR; PG8_WAIT_L(0); PG8_MMA(0, 0, At, B0); PG8_BAR; PG8_SCHED;
            PG8_LDB(B1, 1, 1); PG8_STAGE(PG8_SB(1, 0), b3, voffB);
            PG8_BAR; PG8_WAIT_L(0); PG8_MMA(0, 1, At, B1); PG8_BAR;
            PG8_LDA(At, 1, 1); PG8_STAGE(PG8_SA(1, 0), a3, voffA);
            PG8_BAR; PG8_WAIT_L(0); PG8_MMA(1, 0, At, B0); PG8_BAR; PG8_SCHED;
            PG8_STAGE(PG8_SB(1, 1), b3 + hstep, voffB);
            PG8_WAIT_V(6); PG8_BAR; PG8_MMA(1, 1, At, B1); PG8_BAR;
        }
        PG8_STAMP();
        if constexpr (!Epi::AFTER_DRAIN) { E(acc, cur, wr, wc, fr, fq); S.done(cur); }
        PG8_STAMP();
        if (!has_next) break;
#pragma unroll
        for (int a = 0; a < 2; ++a)
#pragma unroll
            for (int b = 0; b < 2; ++b)
#pragma unroll
                for (int m = 0; m < 4; ++m)
#pragma unroll
                    for (int n = 0; n < 2; ++n) acc[a][b][m][n] = (f32x4){0.f, 0.f, 0.f, 0.f};
        cur = nxt; cA = nA; cB = nB; ++ui;
    }
    PG8_WAIT_V(0);
    if (wr == 0) PG8_BAR;
    PG8_BAR;
    if constexpr (Epi::AFTER_DRAIN) { E.fused(acc, cur, wr, wc, fr, fq, lds, wid, lane); S.done(cur); }
    PG8_STAMP();
    if (STAMP && wid == 0) { stamps[lane] = lane < nts ? (((unsigned long long)(unsigned)ts_hi << 32) | (unsigned)ts_lo) : 0ull;
        if (lane == 62) stamps[62] = rt_entry; if (lane == 63) stamps[63] = (unsigned long long)wall_clock64(); }
#undef PG8_STAMP
#undef PG8_SA
#undef PG8_SB
#undef PG8_STAGE
#undef PG8_LDA
#undef PG8_LDB
#undef PG8_MMA
#undef PG8_WAIT_V
#undef PG8_WAIT_L
#undef PG8_BAR
#undef PG8_SCHED
}
}

namespace mk {
using pg8::bf16_t; using pg8::bf16x8; using pg8::f32x4; using pg8::u32x4; using pg8::u32x2; using pg8::cvt_pk_bf16;
#define LAS PG8_LAS
typedef LAS unsigned char* ldsp;
constexpr int T_P = 16384, T_S = 1024, TT = 17408, DM = 1024, NPROJ = 3584, DFF = 4096, INC = 3332;
constexpr int LEN_P = 2048, LEN_S = 8, NB_P = 8, NB_S = 128;
constexpr int LDS_BYTES = 131072;
constexpr int C_RQ = 0, C_RK = 256, C_RV = 512, C_RG = 768, C_HQ = 1024, C_HF = 1280, C_HI = 1536, C_HG = 1792, C_SZ = 2048, C_XBC = 2304, C_U = 3072, C_DT = 3328;
enum { I_XP = 0, I_XS, I_SRET, I_SHG, I_SSSD, I_SCONV, I_S5RE, I_S5IM, I_NMIX, I_WIN, I_WOUT, I_HGLB, I_CONVW, I_CONVB, I_DTB, I_ALOG, I_SSDD, I_SSDN,
       I_S5AR, I_S5AI, I_S5DT, I_S5BR, I_S5BI, I_S5CR, I_S5CI, I_S5D, I_GLUW, I_GLUB, I_NMLP, I_WUP, I_WDOWN, I_NFIN, N_IN };
constexpr size_t O_YP = 0, O_YS = 16777216, O_PRET = O_YS + 1048576, O_PHG = O_PRET + 262144, O_PSSD = O_PHG + 262144, O_PCONV = O_PSSD + 524288, O_PS5R = O_PCONV + 36864, O_PS5I = O_PS5R + 16384,
                 O_SRET = O_PS5I + 16384, O_SHG = O_SRET + 4194304, O_SSSD = O_SHG + 4194304, O_SCONV = O_SSSD + 8388608, O_SS5R = O_SCONV + 589824, O_SS5I = O_SS5R + 262144, O_END = O_SS5I + 262144;
constexpr size_t W_CTL = 0, W_WIN = 4096, W_WOUT = W_WIN + (size_t)2 * NPROJ * DM * 2, W_WUP = W_WOUT + (size_t)2 * DM * DM * 2, W_WDN = W_WUP + (size_t)2 * DFF * DM * 2, W_WGLU = W_WDN + (size_t)2 * DM * DFF * 2,
                 W_XB = W_WGLU + (size_t)2 * 256 * 256 * 2, W_MIX = W_XB + (size_t)TT * DM * 2, W_SSQ = W_MIX + (size_t)TT * DM * 2, W_SSDSQ = W_SSQ + (size_t)TT * 16 * 4, W_HID = W_SSDSQ + (size_t)TT * 4 * 4,
                 W_END = W_HID + (size_t)TT * DFF * 2;
constexpr size_t W_PROJ = W_HID;
constexpr size_t W_YPRE = W_HID + (size_t)TT * NPROJ * 2;
static_assert(W_YPRE + (size_t)TT * 256 * 2 <= W_END, "ypre fits");
static_assert(W_END <= 268435456ull, "workspace fits 256 MiB");

struct Params { const float* in[N_IN]; float* out; unsigned char* ws; };
constexpr size_t W_TAB = 2048;
struct Ctx { float* out; unsigned char* ws; __device__ __forceinline__ const float* in(int i) const { return ((const float* const*)(ws + W_TAB))[i]; } };

__device__ __forceinline__ float bf2f(unsigned short b) { return __uint_as_float(((unsigned)b) << 16); }
__device__ __forceinline__ unsigned short f2bf(float f) { return __builtin_bit_cast(unsigned short, (__bf16)f); }
__device__ __forceinline__ float sigmoidf_(float x) { return 1.0f / (1.0f + __expf(-x)); }
__device__ __forceinline__ float siluf_(float x) { return x / (1.0f + __expf(-x)); }
__device__ __forceinline__ void unpack8(const u32x4 w, float (&f)[8]) {
    f[0] = __uint_as_float(w.x << 16); f[1] = __uint_as_float(w.x & 0xffff0000u); f[2] = __uint_as_float(w.y << 16); f[3] = __uint_as_float(w.y & 0xffff0000u);
    f[4] = __uint_as_float(w.z << 16); f[5] = __uint_as_float(w.z & 0xffff0000u); f[6] = __uint_as_float(w.w << 16); f[7] = __uint_as_float(w.w & 0xffff0000u);
}
__device__ __forceinline__ u32x4 pack8(const float (&f)[8]) { u32x4 w; w.x = cvt_pk_bf16(f[0], f[1]); w.y = cvt_pk_bf16(f[2], f[3]); w.z = cvt_pk_bf16(f[4], f[5]); w.w = cvt_pk_bf16(f[6], f[7]); return w; }

template <int MODE>
__device__ __forceinline__ void convert_wt(const float* src, int ldsrc, bf16_t* dst, int K, int N, const float* kscale, ldsp lds, int vb, int nvb) {
    LAS float* tile = (LAS float*)lds;
    const int tid = pg8::opaque_tid(), nkt = K / 64, ntile = nkt * (N / 64);
    for (int tl = vb; tl < ntile; tl += nvb) {
        const int k0 = (tl % nkt) * 64, n0 = (tl / nkt) * 64;
#pragma unroll
        for (int i = 0; i < 8; ++i) {
            const int idx = tid + i * 512, kk = idx >> 6, nn = idx & 63, n = n0 + nn;
            int sc = n;
            if (MODE == 1) sc = (n < 3072) ? n : (n < 3328 ? n + 4 : (n < 3332 ? n - 256 : -1));
            float v = 0.f;
            if (sc >= 0) { v = src[(size_t)(k0 + kk) * ldsrc + sc]; if (kscale) v *= kscale[k0 + kk]; }
            tile[kk * 65 + nn] = v;
        }
        __syncthreads();
#pragma unroll
        for (int i = 0; i < 4; ++i) {
            const int p = tid + i * 512, nn = p >> 5, k2 = (p & 31) * 2;
            *(unsigned*)(dst + (size_t)(n0 + nn) * K + k0 + k2) = cvt_pk_bf16(tile[k2 * 65 + nn], tile[(k2 + 1) * 65 + nn]);
        }
        __syncthreads();
    }
}
__device__ __forceinline__ void phase0(const Params& P, ldsp lds) {
    unsigned char* ws = P.ws;
    const int G = gridDim.x, b = blockIdx.x;
    for (int l = 0; l < 2; ++l) {
        convert_wt<1>(P.in[I_WIN] + (size_t)l * DM * INC, INC, (bf16_t*)(ws + W_WIN) + (size_t)l * NPROJ * DM, DM, NPROJ, P.in[I_NMIX] + l * DM, lds, b, G);
        convert_wt<0>(P.in[I_WOUT] + (size_t)l * DM * DM, DM, (bf16_t*)(ws + W_WOUT) + (size_t)l * DM * DM, DM, DM, nullptr, lds, (b + 64) % G, G);
        convert_wt<0>(P.in[I_WUP] + (size_t)l * DM * DFF, DFF, (bf16_t*)(ws + W_WUP) + (size_t)l * DFF * DM, DM, DFF, P.in[I_NMLP] + l * DM, lds, (b + 128) % G, G);
        convert_wt<0>(P.in[I_WDOWN] + (size_t)l * DFF * DM, DM, (bf16_t*)(ws + W_WDN) + (size_t)l * DM * DFF, DFF, DM, nullptr, lds, (b + 192) % G, G);
        convert_wt<0>(P.in[I_GLUW] + (size_t)l * 256 * 256, 256, (bf16_t*)(ws + W_WGLU) + (size_t)l * 256 * 256, 256, 256, nullptr, lds, (b + 32) % G, G);
    }
    const int wave = threadIdx.x >> 6, lane = threadIdx.x & 63;
    bf16_t* XB = (bf16_t*)(ws + W_XB); float* SSQ = (float*)(ws + W_SSQ);
    for (int row = b * 8 + wave; row < TT; row += G * 8) {
        const float* xp = (row < T_P) ? (P.in[I_XP] + (size_t)row * DM) : (P.in[I_XS] + (size_t)(row - T_P) * DM);
        float s = 0.f;
#pragma unroll
        for (int j = 0; j < 4; ++j) {
            const f32x4 v = *(const f32x4*)(xp + j * 256 + lane * 4);
            s += (v[0] * v[0] + v[1] * v[1]) + (v[2] * v[2] + v[3] * v[3]);
            u32x2 w; w.x = cvt_pk_bf16(v[0], v[1]); w.y = cvt_pk_bf16(v[2], v[3]);
            *(u32x2*)(XB + (size_t)row * DM + j * 256 + lane * 4) = w;
        }
#pragma unroll
        for (int o = 32; o >= 1; o >>= 1) s += __shfl_xor(s, o);
        if (lane < 16) SSQ[(size_t)row * 16 + lane] = (lane == 0) ? s : 0.f;
    }
}

constexpr int QS = 136, RS = 72, OS = 68;
constexpr int L_QI = 0, L_KI = 17408, L_KDT = 34816, L_VT = 53248, L_ST = 62464, L_FL = 79872, L_P = 83968, L_OB = 93184, L_XT = 110592, L_RAW = L_P, L_QSLOT = 130048;
constexpr int F_B = 0, F_RS = 64, F_CS = 128, F_DL = 256, F_KS = 320, F_SEG = 384;

__device__ __forceinline__ f32x4 mma_tile(const LAS bf16_t* A, int lda, const LAS bf16_t* B, int ldb, int K, f32x4 acc, int r, int q) {
    for (int k0 = 0; k0 < K; k0 += 32) {
        const bf16x8 a = *(const LAS bf16x8*)(A + r * lda + k0 + q * 8);
        const bf16x8 b = *(const LAS bf16x8*)(B + r * ldb + k0 + q * 8);
        acc = __builtin_amdgcn_mfma_f32_16x16x32_bf16(a, b, acc, 0, 0, 0);
    }
    return acc;
}
template <int DK, int DMODE>
__device__ __forceinline__ void la_scores(ldsp lds, int wave, int lane, float lg2) {
    const LAS bf16_t* Qi = (const LAS bf16_t*)(lds + L_QI); const LAS bf16_t* Ki = (const LAS bf16_t*)(lds + L_KI);
    LAS bf16_t* Pm = (LAS bf16_t*)(lds + L_P); const LAS float* FL = (const LAS float*)(lds + L_FL);
    const int r = lane & 15, q = lane >> 4;
#pragma unroll
    for (int i = 0; i < 2; ++i) {
        const int id = wave * 2 + i, tm = id >> 2, tn = id & 3;
        f32x4 acc = {0.f, 0.f, 0.f, 0.f};
        if (tn <= tm) acc = mma_tile(Qi + tm * 16 * QS, QS, Ki + tn * 16 * QS, QS, DK, acc, r, q);
#pragma unroll
        for (int j = 0; j < 4; ++j) {
            const int t = tm * 16 + q * 4 + j, s = tn * 16 + r;
            float v = acc[j];
            if (DMODE == 1) v *= exp2f((float)(t - s) * lg2);
            if (DMODE == 2) v *= __expf(fminf(FL[F_B + t] - FL[F_B + s], 0.f));
            v = (s <= t) ? v : 0.f;
            Pm[t * RS + s] = f2bf(v);
        }
    }
}
template <int DK, bool SEPQC>
__device__ __forceinline__ void la_out(ldsp lds, int wave, int lane) {
    const LAS bf16_t* Qx = (const LAS bf16_t*)(lds + (SEPQC ? L_XT : L_QI)); const LAS bf16_t* Pm = (const LAS bf16_t*)(lds + L_P);
    const LAS bf16_t* Vt = (const LAS bf16_t*)(lds + L_VT); const LAS bf16_t* St = (const LAS bf16_t*)(lds + L_ST);
    LAS float* Ob = (LAS float*)(lds + L_OB); const LAS float* FL = (const LAS float*)(lds + L_FL);
    const int r = lane & 15, q = lane >> 4;
#pragma unroll
    for (int i = 0; i < 2; ++i) {
        const int id = wave * 2 + i, tm = id >> 2, tv = id & 3;
        f32x4 a1 = {0.f, 0.f, 0.f, 0.f}, a2 = {0.f, 0.f, 0.f, 0.f};
        a1 = mma_tile(Pm + tm * 16 * RS, RS, Vt + tv * 16 * RS, RS, 64, a1, r, q);
        a2 = mma_tile(Qx + tm * 16 * QS, QS, St + tv * 16 * QS, QS, DK, a2, r, q);
#pragma unroll
        for (int j = 0; j < 4; ++j) {
            const int t = tm * 16 + q * 4 + j, v = tv * 16 + r;
            Ob[t * OS + v] = a1[j] + (SEPQC ? a2[j] : FL[F_RS + t] * a2[j]);
        }
    }
}
template <int DK>
__device__ __forceinline__ void la_state(ldsp lds, int wave, int lane, f32x4 (&sacc)[DK / 32]) {
    constexpr int NT = DK / 32, TK = DK / 16;
    const LAS bf16_t* Vt = (const LAS bf16_t*)(lds + L_VT); const LAS bf16_t* Kdt = (const LAS bf16_t*)(lds + L_KDT);
    LAS bf16_t* St = (LAS bf16_t*)(lds + L_ST); const LAS float* FL = (const LAS float*)(lds + L_FL);
    const int r = lane & 15, q = lane >> 4;
#pragma unroll
    for (int i = 0; i < NT; ++i) {
        const int id = wave * NT + i, tv = id / TK, tk = id % TK;
        const float sc = FL[F_CS + tk * 16 + r];
        sacc[i] = sacc[i] * sc;
        sacc[i] = mma_tile(Vt + tv * 16 * RS, RS, Kdt + tk * 16 * RS, RS, 64, sacc[i], r, q);
#pragma unroll
        for (int j = 0; j < 4; ++j) St[(tv * 16 + q * 4 + j) * QS + tk * 16 + r] = f2bf(sacc[i][j]);
    }
}
template <int DK>
__device__ __forceinline__ void la_state_init(ldsp lds, int wave, int lane, f32x4 (&sacc)[DK / 32], const float* s0  ) {
    constexpr int NT = DK / 32, TK = DK / 16;
    LAS bf16_t* St = (LAS bf16_t*)(lds + L_ST);
    const int r = lane & 15, q = lane >> 4;
#pragma unroll
    for (int i = 0; i < NT; ++i) {
        const int id = wave * NT + i, tv = id / TK, tk = id % TK;
        f32x4 v = {0.f, 0.f, 0.f, 0.f};
        if (s0) v = *(const f32x4*)(s0 + (size_t)(tk * 16 + r) * 64 + tv * 16 + q * 4);
        sacc[i] = v;
#pragma unroll
        for (int j = 0; j < 4; ++j) St[(tv * 16 + q * 4 + j) * QS + tk * 16 + r] = f2bf(v[j]);
    }
}
template <int DK>
__device__ __forceinline__ void la_state_store(int wave, int lane, const f32x4 (&sacc)[DK / 32], float* so  ) {
    constexpr int NT = DK / 32, TK = DK / 16;
    const int r = lane & 15, q = lane >> 4;
#pragma unroll
    for (int i = 0; i < NT; ++i) {
        const int id = wave * NT + i, tv = id / TK, tk = id % TK;
        *(f32x4*)(so + (size_t)(tk * 16 + r) * 64 + tv * 16 + q * 4) = sacc[i];
    }
}

struct SeqInfo { int L, row0, pos0, b; bool sample; };
__device__ __forceinline__ SeqInfo seq_info(int seq) {
    SeqInfo s;
    if (seq < NB_P) { s.L = LEN_P; s.row0 = seq * LEN_P; s.pos0 = 0; s.b = seq; s.sample = false; }
    else { s.L = LEN_S; s.row0 = T_P + (seq - NB_P) * LEN_S; s.pos0 = 16384; s.b = seq - NB_P; s.sample = true; }
    return s;
}

__device__ __forceinline__ void ret_item(const Ctx& P, int l, int seq, int h, ldsp lds) {
    const SeqInfo si = seq_info(seq);
    const int tid = pg8::opaque_tid(), wave = tid >> 6, lane = tid & 63;
    const bf16_t* PROJ = (const bf16_t*)(P.ws + W_PROJ); bf16_t* MIX = (bf16_t*)(P.ws + W_MIX);
    LAS bf16_t* Qi = (LAS bf16_t*)(lds + L_QI); LAS bf16_t* Ki = (LAS bf16_t*)(lds + L_KI); LAS bf16_t* Kdt = (LAS bf16_t*)(lds + L_KDT); LAS bf16_t* Vt = (LAS bf16_t*)(lds + L_VT);
    LAS float* FL = (LAS float*)(lds + L_FL); const LAS float* Ob = (const LAS float*)(lds + L_OB);
    const float lg2 = log2f(1.0f - exp2f(-5.0f - (float)h));
    const float* s0 = si.sample ? (P.in(I_SRET) + ((size_t)(l * NB_S + si.b) * 4 + h) * 4096) : nullptr;
    float* so = P.out + (si.sample ? (O_SRET + ((size_t)(l * NB_S + si.b) * 4 + h) * 4096) : (O_PRET + ((size_t)(l * NB_P + si.b) * 4 + h) * 4096));
    f32x4 sacc[2];
    la_state_init<64>(lds, wave, lane, sacc, s0);
    const int t = tid >> 3, c0 = (tid & 7) * 8;
    float ang[4];
#pragma unroll
    for (int i = 0; i < 4; ++i) ang[i] = exp2f(-(float)(c0 / 2 + i) * (13.287712379549449f / 31.0f));
    for (int t0 = 0; t0 < si.L; t0 += 64) {
        const int nv = min(64, si.L - t0);
        const bool valid = t < nv;
        const size_t row = (size_t)(si.row0 + t0 + t);
#ifdef RET_COPY
        if (valid) *(u32x4*)(MIX + row * DM + h * 64 + c0) = *(const u32x4*)(PROJ + row * NPROJ + C_RQ + h * 64 + c0);
        continue;
#endif
        float qf[8], kf[8], vf[8];
        if (valid) {
            unpack8(*(const u32x4*)(PROJ + row * NPROJ + C_RQ + h * 64 + c0), qf);
            unpack8(*(const u32x4*)(PROJ + row * NPROJ + C_RK + h * 64 + c0), kf);
            unpack8(*(const u32x4*)(PROJ + row * NPROJ + C_RV + h * 64 + c0), vf);
            const double pos = (double)(si.pos0 + t0 + t);
#pragma unroll
            for (int i = 0; i < 4; ++i) {
                const double tr = pos * (double)ang[i] * 0.15915494309189535;
                const float fr = (float)(tr - floor(tr)) * 6.283185307179586f;
                const float sn = __sinf(fr), cs = __cosf(fr);
                const float q1 = qf[2 * i], q2 = qf[2 * i + 1], k1 = kf[2 * i] * 0.125f, k2 = kf[2 * i + 1] * 0.125f;
                qf[2 * i] = q1 * cs - q2 * sn; qf[2 * i + 1] = q1 * sn + q2 * cs;
                kf[2 * i] = k1 * cs - k2 * sn; kf[2 * i + 1] = k1 * sn + k2 * cs;
            }
        } else {
#pragma unroll
            for (int i = 0; i < 8; ++i) { qf[i] = 0.f; kf[i] = 0.f; vf[i] = 0.f; }
        }
        *(LAS u32x4*)(Qi + t * QS + c0) = pack8(qf);
        *(LAS u32x4*)(Ki + t * QS + c0) = pack8(kf);
        const float kd = exp2f((float)(nv - 1 - t) * lg2);
#pragma unroll
        for (int i = 0; i < 8; ++i) { Kdt[(c0 + i) * RS + t] = f2bf(kf[i] * kd); Vt[(c0 + i) * RS + t] = f2bf(vf[i]); }
        if ((tid & 7) == 0) FL[F_RS + t] = exp2f((float)(t + 1) * lg2);
        if (tid < 64) FL[F_CS + tid] = exp2f((float)nv * lg2);
        __syncthreads();
        la_scores<64, 1>(lds, wave, lane, lg2);
        __syncthreads();
        la_out<64, false>(lds, wave, lane);
        __syncthreads();
        la_state<64>(lds, wave, lane, sacc);
        {
            float o[8]; float s = 0.f;
#pragma unroll
            for (int i = 0; i < 8; ++i) { o[i] = Ob[t * OS + c0 + i]; s += o[i]; }
            s += __shfl_xor(s, 1); s += __shfl_xor(s, 2); s += __shfl_xor(s, 4);
            const float mu = s * (1.0f / 64.0f); float vq = 0.f;
#pragma unroll
            for (int i = 0; i < 8; ++i) { o[i] -= mu; vq += o[i] * o[i]; }
            vq += __shfl_xor(vq, 1); vq += __shfl_xor(vq, 2); vq += __shfl_xor(vq, 4);
            const float rstd = rsqrtf(vq * (1.0f / 64.0f) + 1e-6f);
            if (valid) {
                float g[8]; unpack8(*(const u32x4*)(PROJ + row * NPROJ + C_RG + h * 64 + c0), g);
#pragma unroll
                for (int i = 0; i < 8; ++i) o[i] = o[i] * rstd * siluf_(g[i]);
                *(u32x4*)(MIX + row * DM + h * 64 + c0) = pack8(o);
            }
        }
        __syncthreads();
    }
    la_state_store<64>(wave, lane, sacc, so);
}

__device__ __forceinline__ void hgrn_item(const Ctx& P, int l, int seq, int h, ldsp lds) {
    const SeqInfo si = seq_info(seq);
    const int tid = pg8::opaque_tid(), wave = tid >> 6, lane = tid & 63;
    const bf16_t* PROJ = (const bf16_t*)(P.ws + W_PROJ); bf16_t* MIX = (bf16_t*)(P.ws + W_MIX);
    LAS bf16_t* Qi = (LAS bf16_t*)(lds + L_QI); LAS bf16_t* Ki = (LAS bf16_t*)(lds + L_KI); LAS bf16_t* Kdt = (LAS bf16_t*)(lds + L_KDT); LAS bf16_t* Vt = (LAS bf16_t*)(lds + L_VT);
    LAS bf16_t* Qc = (LAS bf16_t*)(lds + L_XT);
    LAS float* FL = (LAS float*)(lds + L_FL); const LAS float* Ob = (const LAS float*)(lds + L_OB);
    const float* s0 = si.sample ? (P.in(I_SHG) + ((size_t)(l * NB_S + si.b) * 4 + h) * 4096) : nullptr;
    float* so = P.out + (si.sample ? (O_SHG + ((size_t)(l * NB_S + si.b) * 4 + h) * 4096) : (O_PHG + ((size_t)(l * NB_P + si.b) * 4 + h) * 4096));
    f32x4 sacc[2];
    la_state_init<64>(lds, wave, lane, sacc, s0);
    const int k = lane, seg = wave;
    float lower = 0.f;
    if (l == 1) { const float a0 = P.in(I_HGLB)[h * 64 + k], a1 = P.in(I_HGLB)[256 + h * 64 + k]; lower = 1.0f / (1.0f + expf(a0 - a1)); }
    const int tp = tid >> 3, c0 = (tid & 7) * 8;
    for (int t0 = 0; t0 < si.L; t0 += 64) {
        const int nv = min(64, si.L - t0);
        float cs[8], ky[8], qs[8], vv[8];
        float run = 0.f;
#pragma unroll
        for (int j = 0; j < 8; ++j) {
            const int t = seg * 8 + j;
            float lf = 0.f; ky[j] = 0.f; qs[j] = 0.f; vv[j] = 0.f;
            if (t < nv) {
                const size_t base = (size_t)(si.row0 + t0 + t) * NPROJ + h * 64 + k;
                const float qq = bf2f(PROJ[base + C_HQ]), ff = bf2f(PROJ[base + C_HF]), ii = bf2f(PROJ[base + C_HI]);
                const float sg = 1.0f / (1.0f + expf(-ff));
                const float forget = lower + (1.0f - lower) * sg;
                lf = logf(fmaxf(forget, 1e-30f));
                ky[j] = (1.0f - lower) / (1.0f + expf(ff));
                qs[j] = qq / (1.0f + expf(-qq));
                vv[j] = ii;
            }
            run += lf; cs[j] = run;
        }
        FL[F_SEG + seg * 64 + k] = run;
        __syncthreads();
        float pre = 0.f, tot = 0.f, bref = 0.f;
#pragma unroll
        for (int s = 0; s < 8; ++s) { const float x = FL[F_SEG + s * 64 + k]; if (s < seg) pre += x; if (s < 4) bref += x; tot += x; }
#pragma unroll
        for (int j = 0; j < 8; ++j) {
            const int t = seg * 8 + j; const float b = pre + cs[j];
            Qi[t * QS + k] = f2bf(qs[j] * expf(fminf(b - bref, 80.f)));
            Ki[t * QS + k] = f2bf(ky[j] * expf(fminf(bref - b, 80.f)));
            Qc[t * QS + k] = f2bf(qs[j] * expf(b));
            Kdt[k * RS + t] = f2bf(ky[j] * expf(tot - b));
            Vt[k * RS + t] = f2bf(vv[j]);
        }
        if (seg == 0) FL[F_CS + k] = expf(tot);
        __syncthreads();
        la_scores<64, 0>(lds, wave, lane, 0.f);
        __syncthreads();
        la_out<64, true>(lds, wave, lane);
        __syncthreads();
        la_state<64>(lds, wave, lane, sacc);
        {
            float o[8]; float s = 0.f;
#pragma unroll
            for (int i = 0; i < 8; ++i) { o[i] = Ob[tp * OS + c0 + i]; s += o[i] * o[i]; }
            s += __shfl_xor(s, 1); s += __shfl_xor(s, 2); s += __shfl_xor(s, 4);
            const float rstd = rsqrtf(s * (1.0f / 64.0f) + 1e-6f);
            if (tp < nv) {
                const size_t row = (size_t)(si.row0 + t0 + tp);
                float g[8]; unpack8(*(const u32x4*)(PROJ + row * NPROJ + C_HG + h * 64 + c0), g);
#pragma unroll
                for (int i = 0; i < 8; ++i) o[i] = o[i] * rstd * siluf_(g[i]);
                *(u32x4*)(MIX + row * DM + 256 + h * 64 + c0) = pack8(o);
            }
        }
        __syncthreads();
    }
    la_state_store<64>(wave, lane, sacc, so);
}

__device__ __forceinline__ void ssd_item(const Ctx& P, int l, int seq, int h, ldsp lds) {
    const SeqInfo si = seq_info(seq);
    const int tid = pg8::opaque_tid(), wave = tid >> 6, lane = tid & 63, g = h >> 1;
    const bf16_t* PROJ = (const bf16_t*)(P.ws + W_PROJ); bf16_t* MIX = (bf16_t*)(P.ws + W_MIX); float* SSDSQ = (float*)(P.ws + W_SSDSQ);
    LAS bf16_t* Qi = (LAS bf16_t*)(lds + L_QI); LAS bf16_t* Ki = (LAS bf16_t*)(lds + L_KI); LAS bf16_t* Kdt = (LAS bf16_t*)(lds + L_KDT); LAS bf16_t* Vt = (LAS bf16_t*)(lds + L_VT);
    LAS bf16_t* RAW = (LAS bf16_t*)(lds + L_RAW);
    LAS float* FL = (LAS float*)(lds + L_FL); const LAS float* Ob = (const LAS float*)(lds + L_OB);
    const float* s0 = si.sample ? (P.in(I_SSSD) + ((size_t)(l * NB_S + si.b) * 4 + h) * 8192) : nullptr;
    float* so = P.out + (si.sample ? (O_SSSD + ((size_t)(l * NB_S + si.b) * 4 + h) * 8192) : (O_PSSD + ((size_t)(l * NB_P + si.b) * 4 + h) * 8192));
    const float* cbuf = si.sample ? (P.in(I_SCONV) + (size_t)(l * NB_S + si.b) * 3 * 768) : nullptr;
    f32x4 sacc[4];
    la_state_init<128>(lds, wave, lane, sacc, s0);
    const float dtb = P.in(I_DTB)[l * 4 + h], aexp = expf(P.in(I_ALOG)[l * 4 + h]), dsk = P.in(I_SSDD)[l * 4 + h];
    int cc = 0; float cw0 = 0.f, cw1 = 0.f, cw2 = 0.f, cw3 = 0.f, cbv = 0.f;
    if (tid < 320) {
        cc = (tid < 64) ? (h * 64 + tid) : (tid < 192 ? 256 + g * 128 + (tid - 64) : 512 + g * 128 + (tid - 192));
        const float* cwp = P.in(I_CONVW) + (size_t)l * 4 * 768;
        cw0 = cwp[cc]; cw1 = cwp[768 + cc]; cw2 = cwp[2 * 768 + cc]; cw3 = cwp[3 * 768 + cc]; cbv = P.in(I_CONVB)[l * 768 + cc];
    }
    const int tp = tid >> 3, c0 = (tid & 7) * 8;
    for (int t0 = 0; t0 < si.L; t0 += 64) {
        const int nv = min(64, si.L - t0);
        for (int idx = tid; idx < 67 * 40; idx += 512) {
            const int tt = idx / 40, v8 = idx % 40, ts = t0 - 3 + tt;
            const int sc = (v8 < 8) ? (h * 64 + v8 * 8) : (v8 < 24 ? 256 + g * 128 + (v8 - 8) * 8 : 512 + g * 128 + (v8 - 24) * 8);
            u32x4 w = {0u, 0u, 0u, 0u};
            if (ts >= 0 && ts < si.L) w = *(const u32x4*)(PROJ + (size_t)(si.row0 + ts) * NPROJ + C_XBC + sc);
            else if (ts < 0 && cbuf) {
                const f32x4 a = *(const f32x4*)(cbuf + (ts + 3) * 768 + sc), b = *(const f32x4*)(cbuf + (ts + 3) * 768 + sc + 4);
                w.x = cvt_pk_bf16(a[0], a[1]); w.y = cvt_pk_bf16(a[2], a[3]); w.z = cvt_pk_bf16(b[0], b[1]); w.w = cvt_pk_bf16(b[2], b[3]);
            }
            *(LAS u32x4*)(RAW + tt * 320 + v8 * 8) = w;
        }
        if (wave == 7) {
            const int t = lane; float delta = 0.f, la = 0.f;
            if (t < nv) {
                const float dtv = bf2f(PROJ[(size_t)(si.row0 + t0 + t) * NPROJ + C_DT + h]) + dtb;
                delta = (dtv > 20.f) ? dtv : log1pf(expf(dtv));
                la = -delta * aexp;
            }
            float b = la;
#pragma unroll
            for (int o = 1; o < 64; o <<= 1) { const float x = __shfl_up(b, o); if (lane >= o) b += x; }
            const float bl = __shfl(b, 63);
            FL[F_B + t] = b; FL[F_RS + t] = expf(b); FL[F_DL + t] = delta; FL[F_KS + t] = delta * expf(bl - b);
            FL[F_CS + t] = expf(bl); FL[F_CS + 64 + t] = expf(bl);
        }
        __syncthreads();
        if (tid < 320) {
            float x0 = bf2f(RAW[0 * 320 + tid]), x1 = bf2f(RAW[1 * 320 + tid]), x2 = bf2f(RAW[2 * 320 + tid]);
            for (int t = 0; t < 64; ++t) {
                const float x3 = bf2f(RAW[(t + 3) * 320 + tid]);
                float v = cbv + cw0 * x0 + cw1 * x1 + cw2 * x2 + cw3 * x3;
                v = siluf_(v);
                if (t >= nv) v = 0.f;
                if (tid < 64) Vt[tid * RS + t] = f2bf(v);
                else if (tid < 192) { const int n = tid - 64; Ki[t * QS + n] = f2bf(v * FL[F_DL + t]); Kdt[n * RS + t] = f2bf(v * FL[F_KS + t]); }
                else { const int n = tid - 192; Qi[t * QS + n] = f2bf(v); }
                x0 = x1; x1 = x2; x2 = x3;
            }
        }
        __syncthreads();
        la_scores<128, 2>(lds, wave, lane, 0.f);
        __syncthreads();
        la_out<128, false>(lds, wave, lane);
        __syncthreads();
        la_state<128>(lds, wave, lane, sacc);
        {
            float o[8]; float s = 0.f;
            const size_t row = (size_t)(si.row0 + t0 + tp);
            float z[8];
            if (tp < nv) unpack8(*(const u32x4*)(PROJ + row * NPROJ + C_SZ + h * 64 + c0), z);
            else {
#pragma unroll
                for (int i = 0; i < 8; ++i) z[i] = 0.f;
            }
#pragma unroll
            for (int i = 0; i < 8; ++i) { const float xs = bf2f(Vt[(c0 + i) * RS + tp]); o[i] = (Ob[tp * OS + c0 + i] + dsk * xs) * siluf_(z[i]); s += o[i] * o[i]; }
            s += __shfl_xor(s, 1); s += __shfl_xor(s, 2); s += __shfl_xor(s, 4);
            if (tp < nv) {
                *(u32x4*)(MIX + row * DM + 512 + h * 64 + c0) = pack8(o);
                if ((tid & 7) == 0) SSDSQ[row * 4 + h] = s;
            }
        }
        __syncthreads();
    }
    la_state_store<128>(wave, lane, sacc, so);
    if (h == 0) {
        float* co = P.out + (si.sample ? (O_SCONV + (size_t)(l * NB_S + si.b) * 2304) : (O_PCONV + (size_t)(l * NB_P + si.b) * 2304));
        for (int idx = tid; idx < 2304; idx += 512) { const int rr = idx / 768, c = idx % 768; co[idx] = bf2f(PROJ[(size_t)(si.row0 + si.L - 3 + rr) * NPROJ + C_XBC + c]); }
    }
}

constexpr int S5_U = 0, S5_S = 4096, S5_C = 4096 + 32768, S5_SE = S5_C + 8192, S5_CH = S5_SE + 4096;
__device__ __forceinline__ void s5_item(const Ctx& P, int l, int g, int seq_b, int nseq, ldsp lds) {
    typedef float f32x2 __attribute__((ext_vector_type(2)));
    const int tid = pg8::opaque_tid(), w = tid >> 6, p = tid & 63;
    const bf16_t* PROJ = (const bf16_t*)(P.ws + W_PROJ); bf16_t* YPRE = (bf16_t*)(P.ws + W_YPRE);
    LAS float* U = (LAS float*)(lds + S5_U); LAS float* S = (LAS float*)(lds + S5_S); LAS float* Cm = (LAS float*)(lds + S5_C);
    LAS f32x2* SE = (LAS f32x2*)(lds + S5_SE); LAS f32x2* CH = (LAS f32x2*)(lds + S5_CH);
    const int lg = l * 16 + g;
    const float are = P.in(I_S5AR)[lg * 64 + p], aim = P.in(I_S5AI)[lg * 64 + p], step = expf(P.in(I_S5DT)[lg]);
    const float mag = expf(are * step), angr = aim * step;
    const float abr = mag * cosf(angr), abi = mag * sinf(angr);
    const float d2 = are * are + aim * aim, nr = abr - 1.0f;
    const float cr = (nr * are + abi * aim) / d2, ci = (abi * are - nr * aim) / d2;
    float bbr[16], bbi[16];
    {
        const f32x4* br = (const f32x4*)(P.in(I_S5BR) + ((size_t)lg * 64 + p) * 16); const f32x4* bi = (const f32x4*)(P.in(I_S5BI) + ((size_t)lg * 64 + p) * 16);
#pragma unroll
        for (int q4 = 0; q4 < 4; ++q4) { const f32x4 a = br[q4], b = bi[q4];
#pragma unroll
            for (int j = 0; j < 4; ++j) { bbr[q4 * 4 + j] = cr * a[j] - ci * b[j]; bbi[q4 * 4 + j] = cr * b[j] + ci * a[j]; } }
    }
    float pr[8], pi[8]; pr[0] = abr; pi[0] = abi;
#pragma unroll
    for (int j = 1; j < 8; ++j) { pr[j] = pr[j - 1] * abr - pi[j - 1] * abi; pi[j] = pr[j - 1] * abi + pi[j - 1] * abr; }
    __syncthreads();
    for (int idx = tid; idx < 1024; idx += 512) { const int hh = idx >> 6, pp = idx & 63;
        Cm[hh * 128 + 2 * pp] = P.in(I_S5CR)[((size_t)lg * 16 + hh) * 64 + pp]; Cm[hh * 128 + 2 * pp + 1] = -P.in(I_S5CI)[((size_t)lg * 16 + hh) * 64 + pp]; }
    const int to = tid >> 3, hp = (tid & 7) * 2;
    const float dk0 = P.in(I_S5D)[l * 256 + g * 16 + hp], dk1 = P.in(I_S5D)[l * 256 + g * 16 + hp + 1];
    for (int sq = seq_b; sq < seq_b + nseq; ++sq) {
        const SeqInfo si = seq_info(sq);
        float sr = 0.f, sim = 0.f;
        if (si.sample) { sr = P.in(I_S5RE)[((size_t)(l * NB_S + si.b) * 16 + g) * 64 + p]; sim = P.in(I_S5IM)[((size_t)(l * NB_S + si.b) * 16 + g) * 64 + p]; }
        for (int t0 = 0; t0 < si.L; t0 += 64) {
            const int nv = min(64, si.L - t0);
            __syncthreads();
            for (int idx = tid; idx < 1024; idx += 512) { const int t = idx >> 4, hh = idx & 15;
                U[idx] = (t < nv) ? bf2f(PROJ[(size_t)(si.row0 + t0 + t) * NPROJ + C_U + g * 16 + hh]) : 0.f; }
            __syncthreads();
            float lr[8], li[8]; float xr = 0.f, xi = 0.f;
#pragma unroll
            for (int j = 0; j < 8; ++j) {
                const LAS f32x4* up = (const LAS f32x4*)(U + (w * 8 + j) * 16);
                float br_ = 0.f, bi_ = 0.f;
#pragma unroll
                for (int q4 = 0; q4 < 4; ++q4) { const f32x4 u4 = up[q4];
#pragma unroll
                    for (int e = 0; e < 4; ++e) { br_ += bbr[q4 * 4 + e] * u4[e]; bi_ += bbi[q4 * 4 + e] * u4[e]; } }
                const float nxr = abr * xr - abi * xi + br_, nxi = abr * xi + abi * xr + bi_;
                xr = nxr; xi = nxi; lr[j] = xr; li[j] = xi;
            }
            SE[w * 64 + p] = (f32x2){xr, xi};
            __syncthreads();
            float cr_ = sr, ci_ = sim;
            for (int m = 0; m < w; ++m) { const f32x2 e = SE[m * 64 + p]; const float nr_ = pr[7] * cr_ - pi[7] * ci_ + e.x, ni_ = pr[7] * ci_ + pi[7] * cr_ + e.y; cr_ = nr_; ci_ = ni_; }
            const int wl = (nv - 1) >> 3, jl = (nv - 1) & 7;
#pragma unroll
            for (int j = 0; j < 8; ++j) {
                const float fr_ = lr[j] + pr[j] * cr_ - pi[j] * ci_, fi_ = li[j] + pr[j] * ci_ + pi[j] * cr_;
                *(LAS f32x2*)(S + (w * 8 + j) * 128 + 2 * p) = (f32x2){fr_, fi_};
                if (w == wl && j == jl) CH[p] = (f32x2){fr_, fi_};
            }
            __syncthreads();
            { const f32x2 e = CH[p]; sr = e.x; sim = e.y; }
            {
                const LAS f32x4* sp = (const LAS f32x4*)(S + to * 128); const LAS f32x4* c0p = (const LAS f32x4*)(Cm + hp * 128); const LAS f32x4* c1p = (const LAS f32x4*)(Cm + (hp + 1) * 128);
                float y0 = 0.f, y1 = 0.f;
#pragma unroll 8
                for (int i = 0; i < 32; ++i) { const f32x4 s4 = sp[i], a = c0p[i], b = c1p[i];
                    y0 += (s4[0] * a[0] + s4[1] * a[1]) + (s4[2] * a[2] + s4[3] * a[3]); y1 += (s4[0] * b[0] + s4[1] * b[1]) + (s4[2] * b[2] + s4[3] * b[3]); }
                y0 += dk0 * U[to * 16 + hp]; y1 += dk1 * U[to * 16 + hp + 1];
                const float z0 = 0.7978845608028654f * (y0 + 0.044715f * y0 * y0 * y0), z1 = 0.7978845608028654f * (y1 + 0.044715f * y1 * y1 * y1);
                const float g0 = y0 * (1.0f - 1.0f / (__expf(2.0f * z0) + 1.0f)), g1 = y1 * (1.0f - 1.0f / (__expf(2.0f * z1) + 1.0f));
                if (to < nv) *(unsigned*)(YPRE + (size_t)(si.row0 + t0 + to) * 256 + g * 16 + hp) = cvt_pk_bf16(g0, g1);
            }
        }
        if (w == 0) {
            float* ore = P.out + (si.sample ? (O_SS5R + ((size_t)(l * NB_S + si.b) * 16 + g) * 64) : (O_PS5R + ((size_t)(l * NB_P + si.b) * 16 + g) * 64));
            float* oim = P.out + (si.sample ? (O_SS5I + ((size_t)(l * NB_S + si.b) * 16 + g) * 64) : (O_PS5I + ((size_t)(l * NB_P + si.b) * 16 + g) * 64));
            ore[p] = sr; oim[p] = sim;
        }
    }
    __syncthreads();
}

constexpr int N_ITEMS = 224 + 512 * 3 + 128;
__device__ __forceinline__ void mixer_phase(const Ctx& P, int l, ldsp lds) {
    unsigned* ctr = (unsigned*)(P.ws + W_CTL) + l * 64;
    LAS int* slot = (LAS int*)(lds + L_QSLOT);
#ifdef STATIC_Q
    for (int id = blockIdx.x; id < N_ITEMS; id += gridDim.x) {
        __syncthreads();
#else
    for (;;) {
        __syncthreads();
        if (threadIdx.x == 0) *slot = (int)atomicAdd(ctr, 1u);
        __syncthreads();
        const int id = *slot;
        if (id >= N_ITEMS) break;
#endif
        int type, a, b2, c = 1;
        if (id < 32) { type = 0; a = id >> 2; b2 = id & 3; }
        else if (id < 64) { type = 1; a = (id - 32) >> 2; b2 = id & 3; }
        else if (id < 96) { type = 2; a = (id - 64) >> 2; b2 = id & 3; }
        else if (id < 224) { type = 3; a = (id - 96) & 15; b2 = (id - 96) >> 4; }
        else if (id < 736) { type = 0; a = NB_P + ((id - 224) >> 2); b2 = id & 3; }
        else if (id < 1248) { type = 1; a = NB_P + ((id - 736) >> 2); b2 = id & 3; }
        else if (id < 1760) { type = 2; a = NB_P + ((id - 1248) >> 2); b2 = id & 3; }
        else { type = 3; a = (id - 1760) & 15; b2 = NB_P + ((id - 1760) >> 4) * 16; c = 16; }
        type = __builtin_amdgcn_readfirstlane(type); a = __builtin_amdgcn_readfirstlane(a); b2 = __builtin_amdgcn_readfirstlane(b2); c = __builtin_amdgcn_readfirstlane(c);
#ifndef SK_SSD
        if (type == 0) ssd_item(P, l, a, b2, lds);
#endif
#ifndef SK_RET
        if (type == 1) ret_item(P, l, a, b2, lds);
#endif
#ifndef SK_HG
        if (type == 2) hgrn_item(P, l, a, b2, lds);
#endif
#ifndef SK_S5
        if (type == 3) s5_item(P, l, a, b2, c, lds);
#endif
    }
}

__device__ __forceinline__ void ssd_norm_fix(const Ctx& P, int l) {
    const int wave = threadIdx.x >> 6, lane = threadIdx.x & 63;
    bf16_t* MIX = (bf16_t*)(P.ws + W_MIX); const float* SSDSQ = (const float*)(P.ws + W_SSDSQ);
    const f32x4 nw = *(const f32x4*)(P.in(I_SSDN) + l * 256 + lane * 4);
    const int gq = lane >> 5;
    for (int row = blockIdx.x * 8 + wave; row < TT; row += gridDim.x * 8) {
        const float ss = SSDSQ[(size_t)row * 4 + 2 * gq] + SSDSQ[(size_t)row * 4 + 2 * gq + 1];
        const float rstd = rsqrtf(ss * (1.0f / 128.0f) + 1e-6f);
        u32x2* mp = (u32x2*)(MIX + (size_t)row * DM + 512 + lane * 4);
        const u32x2 w = *mp;
        const float a = __uint_as_float(w.x << 16) * rstd * nw[0], b = __uint_as_float(w.x & 0xffff0000u) * rstd * nw[1];
        const float c = __uint_as_float(w.y << 16) * rstd * nw[2], d = __uint_as_float(w.y & 0xffff0000u) * rstd * nw[3];
        u32x2 o; o.x = cvt_pk_bf16(a, b); o.y = cvt_pk_bf16(c, d);
        *mp = o;
    }
}
__device__ __forceinline__ void final_norm(const Ctx& P) {
    const int wave = threadIdx.x >> 6, lane = threadIdx.x & 63;
    const float* SSQ = (const float*)(P.ws + W_SSQ); const float* nf = P.in(I_NFIN);
    for (int row = blockIdx.x * 8 + wave; row < TT; row += gridDim.x * 8) {
        float s = (lane < 16) ? SSQ[(size_t)row * 16 + lane] : 0.f;
#pragma unroll
        for (int o = 8; o >= 1; o >>= 1) s += __shfl_xor(s, o);
        s = __shfl(s, 0);
        const float rstd = rsqrtf(s * (1.0f / 1024.0f) + 1e-6f);
        float* xp = P.out + (size_t)row * DM;
#pragma unroll
        for (int j = 0; j < 4; ++j) {
            const f32x4 v = *(const f32x4*)(xp + j * 256 + lane * 4); const f32x4 wv = *(const f32x4*)(nf + j * 256 + lane * 4);
            *(f32x4*)(xp + j * 256 + lane * 4) = v * rstd * wv;
        }
    }
}

__device__ __forceinline__ void gsync(cg::grid_group& grid, unsigned* bar, unsigned& epoch) {
    asm volatile("s_waitcnt vmcnt(0) lgkmcnt(0)" ::: "memory");
    __syncthreads();
    if (threadIdx.x == 0) { __builtin_amdgcn_fence(__ATOMIC_RELEASE, "agent"); asm volatile("s_waitcnt vmcnt(0)" ::: "memory"); }
    grid.sync();
    ++epoch;
    if (threadIdx.x == 0) {
        __hip_atomic_fetch_add(bar, 1u, __ATOMIC_RELAXED, __HIP_MEMORY_SCOPE_AGENT);
        const unsigned want = epoch * gridDim.x;
        while (__hip_atomic_load(bar, __ATOMIC_RELAXED, __HIP_MEMORY_SCOPE_AGENT) < want) __builtin_amdgcn_s_sleep(2);
        __builtin_amdgcn_fence(__ATOMIC_ACQUIRE, "agent"); asm volatile("s_waitcnt vmcnt(0)" ::: "memory");
    }
    __syncthreads();
}
__global__ void __launch_bounds__(512, 2) fwd_megakernel(Params P) {
    extern __shared__ __attribute__((aligned(16))) unsigned char lds_raw[];
    cg::grid_group grid = cg::this_grid();
    ldsp lds = (ldsp)lds_raw;
    unsigned char* ws = P.ws;
    const int G = gridDim.x, bid = blockIdx.x;
    bf16_t* XB = (bf16_t*)(ws + W_XB); bf16_t* MIX = (bf16_t*)(ws + W_MIX); bf16_t* PROJ = (bf16_t*)(ws + W_PROJ); bf16_t* HID = (bf16_t*)(ws + W_HID); bf16_t* YPRE = (bf16_t*)(ws + W_YPRE);
    float* SSQ = (float*)(ws + W_SSQ); float* X = P.out;
    unsigned* gbar = (unsigned*)(ws + W_CTL) + 256; unsigned epoch = 0;

#ifndef SK_P0
    phase0(P, lds);
#endif
    if (bid == 0) {
#pragma unroll
        for (int i = 0; i < N_IN; ++i) if ((int)threadIdx.x == i) ((const float**)(ws + W_TAB))[i] = P.in[i];
    }
    gsync(grid, gbar, epoch);
    Ctx C; C.out = P.out; C.ws = P.ws;
#pragma unroll 1
    for (int l = 0; l < 2; ++l) {
#ifndef SK_IN
        {
            pg8::Gemm g{XB, (const bf16_t*)(ws + W_WIN) + (size_t)l * NPROJ * DM, TT, NPROJ, DM}; pg8::StaticOrder S; S.init(TT, NPROJ, G, bid);
            pg8::EpiScaleBf16<0> E{PROJ, NPROJ, SSQ};
            pg8::gemm_phase<pg8::EpiScaleBf16<0>, pg8::StaticOrder>(lds, g, S, E, nullptr);
        }
#endif
        gsync(grid, gbar, epoch);
#ifndef SK_MIX
        mixer_phase(C, l, lds);
#endif
        gsync(grid, gbar, epoch);
#ifndef SK_GLU
        {
            pg8::Gemm g{YPRE, (const bf16_t*)(ws + W_WGLU) + (size_t)l * 256 * 256, TT, 256, 256}; pg8::StaticOrder S; S.init(TT, 256, G, bid);
            pg8::EpiGlu E{YPRE, MIX, C.in(I_GLUB) + l * 256};
            pg8::gemm_phase<pg8::EpiGlu, pg8::StaticOrder>(lds, g, S, E, nullptr);
            ssd_norm_fix(C, l);
        }
#endif
        gsync(grid, gbar, epoch);
#ifndef SK_OUT
        {
            pg8::Gemm g{MIX, (const bf16_t*)(ws + W_WOUT) + (size_t)l * DM * DM, TT, DM, DM}; pg8::StaticOrder S; S.init(TT, DM, G, bid);
            pg8::EpiRes E{l == 0 ? C.in(I_XP) : X, l == 0 ? C.in(I_XS) : X + (size_t)T_P * DM, X, XB, SSQ};
            pg8::gemm_phase<pg8::EpiRes, pg8::StaticOrder>(lds, g, S, E, nullptr);
        }
#endif
        gsync(grid, gbar, epoch);
#ifndef SK_UP
        {
            pg8::Gemm g{XB, (const bf16_t*)(ws + W_WUP) + (size_t)l * DFF * DM, TT, DFF, DM}; pg8::StaticOrder S; S.init(TT, DFF, G, bid);
            pg8::EpiScaleBf16<1> E{HID, DFF, SSQ};
            pg8::gemm_phase<pg8::EpiScaleBf16<1>, pg8::StaticOrder>(lds, g, S, E, nullptr);
        }
#endif
        gsync(grid, gbar, epoch);
#ifndef SK_DN
        {
            pg8::Gemm g{HID, (const bf16_t*)(ws + W_WDN) + (size_t)l * DM * DFF, TT, DM, DFF}; pg8::StaticOrder S; S.init(TT, DM, G, bid);
            pg8::EpiRes E{X, X + (size_t)T_P * DM, X, XB, SSQ};
            pg8::gemm_phase<pg8::EpiRes, pg8::StaticOrder>(lds, g, S, E, nullptr);
        }
#endif
        gsync(grid, gbar, epoch);
    }
    final_norm(C);
}
}

extern "C" void kernel_launch(void* const* d_in, const int* in_sizes, int n_in, void* d_out, int out_size, void* d_ws, size_t ws_size, hipStream_t stream) {
    static int grid_blocks = 0;
    if (grid_blocks == 0) {
        if (n_in != mk::N_IN || (size_t)out_size != mk::O_END || ws_size < mk::W_END) {
            fprintf(stderr, "kernel_launch: unexpected shapes: n_in %d out %d ws %zu (need %zu)\n", n_in, out_size, ws_size, (size_t)mk::W_END); grid_blocks = -1; return; }
        int dev = 0, cus = 0, per_cu = 0;
        (void)hipGetDevice(&dev);
        (void)hipDeviceGetAttribute(&cus, hipDeviceAttributeMultiprocessorCount, dev);
        (void)hipFuncSetAttribute((const void*)mk::fwd_megakernel, hipFuncAttributeMaxDynamicSharedMemorySize, mk::LDS_BYTES);
        (void)hipOccupancyMaxActiveBlocksPerMultiprocessor(&per_cu, (const void*)mk::fwd_megakernel, 512, mk::LDS_BYTES);
        if (per_cu < 1) { fprintf(stderr, "kernel_launch: occupancy query says 0 blocks per CU\n"); per_cu = 1; }
        if (per_cu > 1) per_cu = 1;
        grid_blocks = cus * per_cu;
    }
    if (grid_blocks < 0) return;
    (void)hipMemsetAsync((char*)d_ws + mk::W_CTL, 0, 4096, stream);
    mk::Params p{};
    for (int i = 0; i < mk::N_IN; ++i) p.in[i] = (const float*)d_in[i];
    p.out = (float*)d_out; p.ws = (unsigned char*)d_ws;
    void* args[] = {&p};
    hipError_t e = hipLaunchCooperativeKernel((const void*)mk::fwd_megakernel, dim3(grid_blocks), dim3(512), args, mk::LDS_BYTES, stream);
    if (e != hipSuccess) fprintf(stderr, "cooperative launch failed: %s (grid %d)\n", hipGetErrorString(e), grid_blocks);
}
```

```cpp
#include <hip/hip_cooperative_groups.h>
#include <cstdio>
namespace cg = cooperative_groups;
#include <hip/hip_runtime.h>
namespace pg8 {
#define PG8_LAS __attribute__((address_space(3)))
typedef unsigned short bf16_t;
typedef short bf16x8 __attribute__((ext_vector_type(8)));
typedef float f32x4 __attribute__((ext_vector_type(4)));
typedef unsigned u32x4 __attribute__((ext_vector_type(4)));
constexpr int BM = 256, BK = 64, HALF = 128, HTB = HALF * BK * 2  , STAGE_BYTES = 8 * HTB, NXCD = 8, WGM = 8;

__host__ __device__ __forceinline__ int lds_byte(int r, int c) { const int st = (r >> 4) * 2 + (c >> 5), rr = r & 15, cc = c & 31, ob = rr * 64 + cc * 2; return st * 1024 + (ob ^ (((ob >> 9) & 1) << 5)); }
__host__ __device__ __forceinline__ void stage_rc(int b, int& R, int& C) { const int st = b / 1024, sb = b % 1024, swz = sb ^ (((sb >> 9) & 1) << 5); R = (st >> 1) * 16 + swz / 64; C = (st & 1) * 32 + (swz % 64) / 2; }
__host__ __device__ __forceinline__ int perm32(int rho) { const int n = rho >> 4, i = rho & 15; return 8 * (i >> 2) + 4 * n + (i & 3); }

struct Unit { int pm, pn, ki; __host__ __device__ int kt0() const { return ki & 0xff; } __host__ __device__ int nkt() const { return (ki >> 8) & 0xff; } __host__ __device__ int split() const { return ki >> 16; } };
struct Gemm { const bf16_t* A; const bf16_t* Bt; int M, N, K; };

struct StaticOrder {
    int nM, nN, nwg, G, c, nkt;
    __host__ __device__ void init(int M, int N, int G_, int c_, int K = 1024) { nM = M / BM; nN = N / BM; nwg = nM * nN; G = G_; c = c_; nkt = K / BK; }
    __host__ __device__ bool next(int i, Unit& u) const {
        const long L = (long)i * G + c; if (L >= nwg) return false;
        int wgid = (int)L; { const int q = nwg / NXCD, r = nwg % NXCD, xcd = wgid % NXCD, off = wgid / NXCD; wgid = (xcd < r ? xcd * (q + 1) : r * (q + 1) + (xcd - r) * q) + off; }
        const int nig = WGM * nN, gid = wgid / nig, fm = gid * WGM, gsz = (nM - fm) < WGM ? (nM - fm) : WGM;
        u.pm = fm + ((wgid % nig) % gsz); u.pn = (wgid % nig) / gsz; u.ki = nkt << 8; return true;
    }
    __device__ __forceinline__ void a_ready(const Unit&) const {}
    __device__ __forceinline__ void done(const Unit&) const {}
};
struct SplitOrder {
    StaticOrder P; int nP, nS, SPLIT, nkt_s, nNn;
    __host__ __device__ void init(int Mp, int N, int G_, int c_, int K, int SPLIT_) { P.init(Mp, N, G_, c_, K); nP = P.nwg; nNn = N / BM; SPLIT = SPLIT_; nS = 4 * nNn * SPLIT; nkt_s = K / BK / SPLIT; }
    __host__ __device__ bool next(int i, Unit& u) const {
        const long L = (long)i * P.G + P.c;
        if (L < nP) return P.next(i, u);
        const int s = (int)(L - nP); if (s >= nS) return false;
        const int tile = s / SPLIT, ks = s % SPLIT;
        u.pm = 64 + tile / nNn; u.pn = tile % nNn; u.ki = (ks * nkt_s) | (nkt_s << 8) | (1 << 16); return true;
    }
    __device__ __forceinline__ void a_ready(const Unit&) const {}
    __device__ __forceinline__ void done(const Unit&) const {}
};
struct OneUnit {
    int pm, nkt;
    __host__ __device__ bool next(int i, Unit& u) const { if (i) return false; u.pm = pm; u.pn = 0; u.ki = nkt << 8; return true; }
    __device__ __forceinline__ void a_ready(const Unit&) const {}
    __device__ __forceinline__ void done(const Unit&) const {}
};
typedef __bf16 bf16v2_t __attribute__((ext_vector_type(2)));
__device__ __forceinline__ unsigned cvt_pk_bf16(float lo, float hi) { bf16v2_t v; v.x = (__bf16)lo; v.y = (__bf16)hi; return __builtin_bit_cast(unsigned, v); }
typedef float f32x2 __attribute__((ext_vector_type(2)));
__device__ __forceinline__ int opaque_tid() { int t = (int)threadIdx.x; asm volatile("" : "+v"(t)); return t; }
typedef unsigned u32x2 __attribute__((ext_vector_type(2)));
constexpr int TP_ROWS = 16384;
template <int ACT> struct EpiScaleBf16 {
    static constexpr bool PERM = true, AFTER_DRAIN = false;
    bf16_t* O; int ldc; const float* ssq;
    __device__ __forceinline__ void operator()(const f32x4 (&acc)[2][2][4][2], const Unit& u, int wr, int wc, int fr, int fq) const {
        const int row0 = u.pm * BM + wr * 64 + fr, col0 = u.pn * BM + wc * 32 + 8 * fq;
#pragma unroll
        for (int ai = 0; ai < 2; ++ai)
#pragma unroll
            for (int m = 0; m < 4; ++m) {
                const int row = row0 + ai * HALF + m * 16;
                const f32x4* sp = (const f32x4*)(ssq + (size_t)row * 16);
                const f32x4 s0 = sp[0], s1 = sp[1], s2 = sp[2], s3 = sp[3];
                const float ss = ((s0[0] + s0[1]) + (s0[2] + s0[3])) + ((s1[0] + s1[1]) + (s1[2] + s1[3])) + ((s2[0] + s2[1]) + (s2[2] + s2[3])) + ((s3[0] + s3[1]) + (s3[2] + s3[3]));
                const float rstd = __builtin_amdgcn_rsqf(ss * (1.0f / 1024.0f) + 1e-6f);
                bf16_t* rowp = O + (size_t)row * ldc + col0;
#pragma unroll
                for (int bj = 0; bj < 2; ++bj) {
                    f32x4 v0 = acc[ai][bj][m][0] * rstd, v1 = acc[ai][bj][m][1] * rstd;
                    if (ACT == 1) {
#pragma unroll
                        for (int j = 0; j < 4; ++j) { const float a = fmaxf(v0[j], 0.f), b = fmaxf(v1[j], 0.f); v0[j] = a * a; v1[j] = b * b; }
                    }
                    u32x4 w; w.x = cvt_pk_bf16(v0[0], v0[1]); w.y = cvt_pk_bf16(v0[2], v0[3]); w.z = cvt_pk_bf16(v1[0], v1[1]); w.w = cvt_pk_bf16(v1[2], v1[3]);
                    *(u32x4*)(rowp + bj * HALF) = w;
                }
            }
    }
};
struct EpiRes {
    static constexpr bool PERM = false, AFTER_DRAIN = false;
    const float* base0; const float* base1; float* X; bf16_t* XB; float* ssq; float* slab; int slab16;
    __device__ __forceinline__ void operator()(const f32x4 (&acc)[2][2][4][2], const Unit& u, int wr, int wc, int fr, int fq) const {
        const int row0 = u.pm * BM + wr * 64 + fr, col0 = u.pn * BM + wc * 32 + 4 * fq;
        if (u.split()) {
            const int ks = u.kt0() / u.nkt();
#pragma unroll
            for (int ai = 0; ai < 2; ++ai)
#pragma unroll
                for (int m = 0; m < 4; ++m) {
                    const size_t so_ = ((size_t)ks * 1024 + (size_t)(row0 + ai * HALF + m * 16 - TP_ROWS)) * 1024 + col0;
                    if (slab16) {
                        bf16_t* sp = (bf16_t*)slab + so_;
#pragma unroll
                        for (int bj = 0; bj < 2; ++bj)
#pragma unroll
                            for (int n = 0; n < 2; ++n) { const f32x4 a = acc[ai][bj][m][n]; u32x2 w; w.x = cvt_pk_bf16(a[0], a[1]); w.y = cvt_pk_bf16(a[2], a[3]); *(u32x2*)(sp + bj * HALF + n * 16) = w; }
                    } else {
                        float* sp = slab + so_;
#pragma unroll
                        for (int bj = 0; bj < 2; ++bj)
#pragma unroll
                            for (int n = 0; n < 2; ++n) *(f32x4*)(sp + bj * HALF + n * 16) = acc[ai][bj][m][n];
                    }
                }
            return;
        }
#pragma unroll
        for (int ai = 0; ai < 2; ++ai)
#pragma unroll
            for (int m = 0; m < 4; ++m) {
                const int row = row0 + ai * HALF + m * 16;
                const float* bp = (row < TP_ROWS) ? (base0 + (size_t)row * 1024) : (base1 + (size_t)(row - TP_ROWS) * 1024);
                float s = 0.f;
#pragma unroll
                for (int bj = 0; bj < 2; ++bj)
#pragma unroll
                    for (int n = 0; n < 2; ++n) {
                        const int c = col0 + bj * HALF + n * 16;
                        const f32x4 b = *(const f32x4*)(bp + c);
                        const f32x4 v = b + acc[ai][bj][m][n];
                        *(f32x4*)(X + (size_t)row * 1024 + c) = v;
                        u32x2 w; w.x = cvt_pk_bf16(v[0], v[1]); w.y = cvt_pk_bf16(v[2], v[3]);
                        *(u32x2*)(XB + (size_t)row * 1024 + c) = w;
                        s += (v[0] * v[0] + v[1] * v[1]) + (v[2] * v[2] + v[3] * v[3]);
                    }
                s += __shfl_xor(s, 16); s += __shfl_xor(s, 32);
                if (fq == 0) ssq[(size_t)row * 16 + u.pn * 4 + wc] = s;
                asm volatile("" ::: "memory");
            }
    }
};
struct EpiGlu {
    static constexpr bool PERM = true, AFTER_DRAIN = false;
    const bf16_t* Y; bf16_t* MIX; const float* bias;
    __device__ __forceinline__ void operator()(const f32x4 (&acc)[2][2][4][2], const Unit& u, int wr, int wc, int fr, int fq) const {
        const int row0 = u.pm * BM + wr * 64 + fr, col0 = u.pn * BM + wc * 32 + 8 * fq;
#pragma unroll
        for (int ai = 0; ai < 2; ++ai)
#pragma unroll
            for (int m = 0; m < 4; ++m) {
                const int row = row0 + ai * HALF + m * 16;
#pragma unroll
                for (int bj = 0; bj < 2; ++bj) {
                    const int c = col0 + bj * HALF;
                    const u32x4 yw = *(const u32x4*)(Y + (size_t)row * 256 + c);
                    const f32x4 b0 = *(const f32x4*)(bias + c), b1 = *(const f32x4*)(bias + c + 4);
                    const f32x4 a0 = acc[ai][bj][m][0] + b0, a1 = acc[ai][bj][m][1] + b1;
                    float y[8], o[8];
                    y[0] = __uint_as_float(yw.x << 16); y[1] = __uint_as_float(yw.x & 0xffff0000u); y[2] = __uint_as_float(yw.y << 16); y[3] = __uint_as_float(yw.y & 0xffff0000u);
                    y[4] = __uint_as_float(yw.z << 16); y[5] = __uint_as_float(yw.z & 0xffff0000u); y[6] = __uint_as_float(yw.w << 16); y[7] = __uint_as_float(yw.w & 0xffff0000u);
#pragma unroll
                    for (int j = 0; j < 4; ++j) { o[j] = y[j] / (1.0f + __expf(-a0[j])); o[4 + j] = y[4 + j] / (1.0f + __expf(-a1[j])); }
                    u32x4 w; w.x = cvt_pk_bf16(o[0], o[1]); w.y = cvt_pk_bf16(o[2], o[3]); w.z = cvt_pk_bf16(o[4], o[5]); w.w = cvt_pk_bf16(o[6], o[7]);
                    *(u32x4*)(MIX + (size_t)row * 1024 + 768 + c) = w;
                    asm volatile("" ::: "memory");
                }
            }
    }
};
template <class Epi, class Sched, bool STAMP = false>
__device__ __forceinline__ void gemm_phase(PG8_LAS unsigned char* lds, const Gemm g, const Sched& S, const Epi& E, unsigned long long* stamps) {
    const int tid = opaque_tid(), wid = __builtin_amdgcn_readfirstlane(tid >> 6), lane = tid & 63, wr = wid >> 2, wc = wid & 3, fr = lane & 15, fq = lane >> 4;
    int K_ = g.K; asm volatile("" : "+s"(K_)); const int K = K_, nt = K / BK;
    int ts_lo = 0, ts_hi = 0, nts = 0; const unsigned long long rt_entry = STAMP ? (unsigned long long)wall_clock64() : 0ull;
#define PG8_STAMP() do { if (STAMP && wid == 0 && nts < 64) { const unsigned long long _c = (unsigned long long)clock64(); \
        ts_lo = (lane == nts) ? (int)(unsigned)_c : ts_lo; ts_hi = (lane == nts) ? (int)(unsigned)(_c >> 32) : ts_hi; ++nts; } } while (0)
    PG8_STAMP();
    unsigned voffA[2], voffB[2];
#pragma unroll
    for (int i = 0; i < 2; ++i) { int R, C; stage_rc(tid * 16 + i * 8192, R, C); const int Rb = Epi::PERM ? ((R & ~31) + perm32(R & 31)) : R;
        voffA[i] = (unsigned)(R * K + C) * 2u; voffB[i] = (unsigned)(Rb * K + C) * 2u; }
    const size_t kstep = (size_t)(BK * 2);
    const size_t hstep = (size_t)HALF * K * 2;
    const size_t tstep = 2 * hstep;
    const unsigned ldsw = (unsigned)wid * 1024u;
    const int aoff = lds_byte(wr * 64 + fr, fq * 8), boff = lds_byte(wc * 32 + fr, fq * 8);
#define PG8_SA(b, h) (((b) * 2 + (h)) * HTB)
#define PG8_SB(b, h) ((4 + (b) * 2 + (h)) * HTB)
#define PG8_STAGE(bufoff, gbase, voff) do { _Pragma("unroll") for (int _i = 0; _i < 2; ++_i) \
        __builtin_amdgcn_global_load_lds((const unsigned*)((const char*)(gbase) + (voff)[_i]), (PG8_LAS unsigned*)(lds + (bufoff) + ldsw + _i * 8192), 16, 0, 0); } while (0)
#define PG8_LDA(dst, b, h) do { _Pragma("unroll") for (int m = 0; m < 4; ++m) _Pragma("unroll") for (int k = 0; k < 2; ++k) dst[m][k] = *(const PG8_LAS bf16x8*)(lds + PG8_SA(b, h) + aoff + m * 2048 + k * 1024); } while (0)
#define PG8_LDB(dst, b, h) do { _Pragma("unroll") for (int n = 0; n < 2; ++n) _Pragma("unroll") for (int k = 0; k < 2; ++k) dst[n][k] = *(const PG8_LAS bf16x8*)(lds + PG8_SB(b, h) + boff + n * 2048 + k * 1024); } while (0)
#define PG8_MMA(ai, bj, At, Bt) do { __builtin_amdgcn_s_setprio(1); _Pragma("unroll") for (int m = 0; m < 4; ++m) _Pragma("unroll") for (int n = 0; n < 2; ++n) _Pragma("unroll") for (int k = 0; k < 2; ++k) \
        acc[ai][bj][m][n] = __builtin_amdgcn_mfma_f32_16x16x32_bf16(Bt[n][k], At[m][k], acc[ai][bj][m][n], 0, 0, 0); __builtin_amdgcn_s_setprio(0); } while (0)
#define PG8_WAIT_V(n) asm volatile("s_waitcnt vmcnt(" #n ")" ::: "memory")
#define PG8_WAIT_L(n) asm volatile("s_waitcnt lgkmcnt(" #n ")" ::: "memory")
#define PG8_BAR __builtin_amdgcn_s_barrier()
#define PG8_SCHED __builtin_amdgcn_sched_barrier(0)
    Unit cur, nxt; int ui = 0;
    if (!S.next(0, cur)) return;
    f32x4 acc[2][2][4][2];
#pragma unroll
    for (int a = 0; a < 2; ++a)
#pragma unroll
        for (int b = 0; b < 2; ++b)
#pragma unroll
            for (int m = 0; m < 4; ++m)
#pragma unroll
                for (int n = 0; n < 2; ++n) acc[a][b][m][n] = (f32x4){0.f, 0.f, 0.f, 0.f};
    bf16x8 At[4][2], B0[2][2], B1[2][2];
    const char* cA = (const char*)g.A + (size_t)cur.pm * tstep + (size_t)cur.kt0() * kstep; const char* cB = (const char*)g.Bt + (size_t)cur.pn * tstep + (size_t)cur.kt0() * kstep;
    S.a_ready(cur);
    PG8_STAGE(PG8_SB(0, 0), cB, voffB); PG8_STAGE(PG8_SA(0, 0), cA, voffA); PG8_STAGE(PG8_SB(0, 1), cB + hstep, voffB); PG8_STAGE(PG8_SA(0, 1), cA + hstep, voffA);
    if (wr == 1) PG8_BAR;
    PG8_WAIT_V(4); PG8_BAR;
    PG8_STAGE(PG8_SB(1, 0), cB + kstep, voffB); PG8_STAGE(PG8_SA(1, 0), cA + kstep, voffA); PG8_STAGE(PG8_SB(1, 1), cB + hstep + kstep, voffB);
    PG8_WAIT_V(6); PG8_BAR;
    PG8_STAMP();
    for (;;) {
        const bool has_next = S.next(ui + 1, nxt);
        const char* nA = has_next ? (const char*)g.A + (size_t)nxt.pm * tstep + (size_t)nxt.kt0() * kstep : cA; const char* nB = has_next ? (const char*)g.Bt + (size_t)nxt.pn * tstep + (size_t)nxt.kt0() * kstep : cB;
        const int cnt = cur.nkt();
        for (int t = 0; t < cnt; t += 2) {
            const bool last = (t == cnt - 2);
            const char* a1 = cA + (size_t)(t + 1) * kstep;
            const char* a2 = last ? nA : cA + (size_t)(t + 2) * kstep; const char* b2 = last ? nB : cB + (size_t)(t + 2) * kstep;
            const char* a3 = a2 + kstep; const char* b3 = b2 + kstep;
            if (last && has_next) S.a_ready(nxt);
            PG8_LDB(B0, 0, 0); PG8_SCHED; PG8_LDA(At, 0, 0); PG8_STAGE(PG8_SA(1, 1), a1 + hstep, voffA);
            PG8_WAIT_L(8); PG8_BAR; PG8_WAIT_L(0); PG8_MMA(0, 0, At, B0); PG8_BAR; PG8_SCHED;
            PG8_LDB(B1, 0, 1); PG8_STAGE(PG8_SB(0, 0), b2, voffB);
            PG8_BAR; PG8_WAIT_L(0); PG8_MMA(0, 1, At, B1); PG8_BAR;
            PG8_LDA(At, 0, 1); PG8_STAGE(PG8_SA(0, 0), a2, voffA);
            PG8_BAR; PG8_WAIT_L(0); PG8_MMA(1, 0, At, B0); PG8_BAR; PG8_SCHED;
            PG8_STAGE(PG8_SB(0, 1), b2 + hstep, voffB);
            PG8_WAIT_V(6); PG8_BAR; PG8_MMA(1, 1, At, B1); PG8_BAR;
            PG8_LDB(B0, 1, 0); PG8_SCHED; PG8_LDA(At, 1, 0); PG8_STAGE(PG8_SA(0, 1), a2 + hstep, voffA);
            PG8_WAIT_L(8); PG8_BAR; PG8_WAIT_L(0); PG8_MMA(0, 0, At, B0); PG8_BAR; PG8_SCHED;
            PG8_LDB(B1, 1, 1); PG8_STAGE(PG8_SB(1, 0), b3, voffB);
            PG8_BAR; PG8_WAIT_L(0); PG8_MMA(0, 1, At, B1); PG8_BAR;
            PG8_LDA(At, 1, 1); PG8_STAGE(PG8_SA(1, 0), a3, voffA);
            PG8_BAR; PG8_WAIT_L(0); PG8_MMA(1, 0, At, B0); PG8_BAR; PG8_SCHED;
            PG8_STAGE(PG8_SB(1, 1), b3 + hstep, voffB);
            PG8_WAIT_V(6); PG8_BAR; PG8_MMA(1, 1, At, B1); PG8_BAR;
        }
        PG8_STAMP();
        if constexpr (!Epi::AFTER_DRAIN) { E(acc, cur, wr, wc, fr, fq); S.done(cur); }
        PG8_STAMP();
        if (!has_next) break;
#pragma unroll
        for (int a = 0; a < 2; ++a)
#pragma unroll
            for (int b = 0; b < 2; ++b)
#pragma unroll
                for (int m = 0; m < 4; ++m)
#pragma unroll
                    for (int n = 0; n < 2; ++n) acc[a][b][m][n] = (f32x4){0.f, 0.f, 0.f, 0.f};
        cur = nxt; cA = nA; cB = nB; ++ui;
    }
    PG8_WAIT_V(0);
    if (wr == 0) PG8_BAR;
    PG8_BAR;
    if constexpr (Epi::AFTER_DRAIN) { E.fused(acc, cur, wr, wc, fr, fq, lds, wid, lane); S.done(cur); }
    PG8_STAMP();
    if (STAMP && wid == 0) { stamps[lane] = lane < nts ? (((unsigned long long)(unsigned)ts_hi << 32) | (unsigned)ts_lo) : 0ull;
        if (lane == 62) stamps[62] = rt_entry; if (lane == 63) stamps[63] = (unsigned long long)wall_clock64(); }
#undef PG8_STAMP
#undef PG8_SA
#undef PG8_SB
#undef PG8_STAGE
#undef PG8_LDA
#undef PG8_LDB
#undef PG8_MMA
#undef PG8_WAIT_V
#undef PG8_WAIT_L
#undef PG8_BAR
#undef PG8_SCHED
}
}

namespace mk {
using pg8::bf16_t; using pg8::bf16x8; using pg8::f32x4; using pg8::u32x4; using pg8::u32x2; using pg8::cvt_pk_bf16;
#define LAS PG8_LAS
typedef LAS unsigned char* ldsp;
#define XB_TMO      128
#define XB_XCNT(j)  (256  + 64 * (j))
#define XB_XSUB(j)  (1280 + 64 * (j))
#define XB_XGEN(j)  (2304 + 64 * (j))
#define XB_TOP      3328
#define XB_TOPGEN   3392
#define XCD_BAR_WORDS 3456
#define XB_SPIN_CAP (1u << 18)
__device__ __forceinline__ unsigned xb_ld(unsigned* p)              { return __hip_atomic_load(p, __ATOMIC_RELAXED, __HIP_MEMORY_SCOPE_AGENT); }
__device__ __forceinline__ unsigned xb_add(unsigned* p, unsigned v) { return __hip_atomic_fetch_add(p, v, __ATOMIC_RELAXED, __HIP_MEMORY_SCOPE_AGENT); }
__device__ __forceinline__ unsigned xb_xcc_id() { return (unsigned)__builtin_amdgcn_s_getreg((3 << 11) | 20) & 0xFu; }
#define XB_SPIN(cond, bar) do { unsigned _sp = 0; while (cond) { __builtin_amdgcn_s_sleep(1); \
    if ((++_sp & 255u) == 0u) { if (xb_ld(&(bar)[XB_TMO])) break; if (_sp > XB_SPIN_CAP) { atomicAdd(&(bar)[XB_TMO], 1u); break; } } } } while (0)

struct XcdBarrier {
    unsigned* bar; unsigned x;
    volatile LAS unsigned* st;
};

__device__ __forceinline__ XcdBarrier xcd_barrier_post(unsigned* bar, volatile LAS unsigned* st) {
    XcdBarrier b; b.bar = bar; b.x = xb_xcc_id(); b.st = st;
    if (threadIdx.x == 0) (void)xb_add(&bar[XB_XCNT(b.x)], 1u);
    return b;
}
__device__ __forceinline__ void xcd_barrier_complete(unsigned* bar, unsigned x, unsigned& nloc, unsigned& nx) {
    const unsigned G = gridDim.x * gridDim.y * gridDim.z;
    unsigned sum, cnt, mine, sp = 0u;
    for (;;) {
        sum = 0u; cnt = 0u; mine = 0u;
#pragma unroll
        for (unsigned j = 0; j < 16; ++j) { const unsigned c = xb_ld(&bar[XB_XCNT(j)]); sum += c; cnt += (c > 0u) ? 1u : 0u; mine = (j == x) ? c : mine; }
        if (sum == G) break;
        __builtin_amdgcn_s_sleep(1);
        if ((++sp & 255u) == 0u) { if (xb_ld(&bar[XB_TMO])) break; if (sp > XB_SPIN_CAP) { atomicAdd(&bar[XB_TMO], 1u); break; } }
    }
    nloc = mine > 0u ? mine : 1u; nx = cnt > 0u ? cnt : 1u;
}

__device__ __forceinline__ void xcd_barrier(const XcdBarrier& b) {
    asm volatile("s_waitcnt vmcnt(0)" ::: "memory");
    __syncthreads();
    if (threadIdx.x == 0) {
        unsigned* bar = b.bar;
        __builtin_amdgcn_s_waitcnt(0);
        unsigned nloc = b.st[0], nx = b.st[1];
        if (nloc == 0u) { xcd_barrier_complete(bar, b.x, nloc, nx); b.st[0] = nloc; b.st[1] = nx; }
        const unsigned old = xb_add(&bar[XB_XSUB(b.x)], 1u);
        const unsigned gen = old / nloc;
        if (old + 1u == (gen + 1u) * nloc) {
            __builtin_amdgcn_fence(__ATOMIC_RELEASE, "agent");
            asm volatile("s_waitcnt vmcnt(0)" ::: "memory");
            const unsigned og = xb_add(&bar[XB_TOP], 1u);
            const unsigned tg = og / nx;
            if (og + 1u == (tg + 1u) * nx) xb_add(&bar[XB_TOPGEN], 1u);
            else XB_SPIN(xb_ld(&bar[XB_TOPGEN]) == tg, bar);
            __builtin_amdgcn_fence(__ATOMIC_ACQUIRE, "agent");
            xb_add(&bar[XB_XGEN(b.x)], 1u);
            asm volatile("s_waitcnt vmcnt(0)" ::: "memory");
        } else {
            XB_SPIN(xb_ld(&bar[XB_XGEN(b.x)]) == gen, bar);
            __builtin_amdgcn_fence(__ATOMIC_ACQUIRE, "agent");
            asm volatile("s_waitcnt vmcnt(0)" ::: "memory");
        }
    }
    __syncthreads();
}

constexpr int T_P = 16384, T_S = 1024, TT = 17408, DM = 1024, NPROJ = 3584, DFF = 4096, INC = 3332;
constexpr int LEN_P = 2048, LEN_S = 8, NB_P = 8, NB_S = 128;
constexpr int LDS_BYTES = 138240, L_BARST = 131072;
constexpr int C_RQ = 0, C_RK = 256, C_RV = 512, C_RG = 768, C_HQ = 1024, C_HF = 1280, C_HI = 1536, C_HG = 1792, C_SZ = 2048, C_XBC = 2304, C_U = 3072, C_DT = 3328;
enum { I_XP = 0, I_XS, I_SRET, I_SHG, I_SSSD, I_SCONV, I_S5RE, I_S5IM, I_NMIX, I_WIN, I_WOUT, I_HGLB, I_CONVW, I_CONVB, I_DTB, I_ALOG, I_SSDD, I_SSDN,
       I_S5AR, I_S5AI, I_S5DT, I_S5BR, I_S5BI, I_S5CR, I_S5CI, I_S5D, I_GLUW, I_GLUB, I_NMLP, I_WUP, I_WDOWN, I_NFIN, N_IN };
constexpr size_t O_YP = 0, O_YS = 16777216, O_PRET = O_YS + 1048576, O_PHG = O_PRET + 262144, O_PSSD = O_PHG + 262144, O_PCONV = O_PSSD + 524288, O_PS5R = O_PCONV + 36864, O_PS5I = O_PS5R + 16384,
                 O_SRET = O_PS5I + 16384, O_SHG = O_SRET + 4194304, O_SSSD = O_SHG + 4194304, O_SCONV = O_SSSD + 8388608, O_SS5R = O_SCONV + 589824, O_SS5I = O_SS5R + 262144, O_END = O_SS5I + 262144;
constexpr size_t W_CTL = 0, W_BAR = 4096, W_WIN = 32768, W_WOUT = W_WIN + (size_t)2 * NPROJ * DM * 2, W_WUP = W_WOUT + (size_t)2 * DM * DM * 2, W_WDN = W_WUP + (size_t)2 * DFF * DM * 2, W_WGLU = W_WDN + (size_t)2 * DM * DFF * 2,
                 W_XB = W_WGLU + (size_t)2 * 256 * 256 * 2, W_MIX = W_XB + (size_t)TT * DM * 2, W_SSQ = W_MIX + (size_t)TT * DM * 2, W_SSDSQ = W_SSQ + (size_t)TT * 16 * 4, W_HID = W_SSDSQ + (size_t)TT * 4 * 4,
                 W_END = W_HID + (size_t)TT * DFF * 2;
constexpr size_t W_PROJ = W_HID;
constexpr size_t W_YPRE = W_HID + (size_t)TT * NPROJ * 2;
static_assert(W_YPRE + (size_t)TT * 256 * 2 <= W_END, "ypre fits");
static_assert(W_END <= 268435456ull, "workspace fits 256 MiB");

struct Params { const float* in[N_IN]; float* out; unsigned char* ws; };
constexpr size_t W_TAB = 2048;
struct Ctx { float* out; unsigned char* ws; __device__ __forceinline__ const float* in(int i) const { return ((const float* const*)(ws + W_TAB))[i]; } };

__device__ __forceinline__ float bf2f(unsigned short b) { return __uint_as_float(((unsigned)b) << 16); }
__device__ __forceinline__ unsigned short f2bf(float f) { return __builtin_bit_cast(unsigned short, (__bf16)f); }
__device__ __forceinline__ float sigmoidf_(float x) { return 1.0f / (1.0f + __expf(-x)); }
__device__ __forceinline__ float siluf_(float x) { return x / (1.0f + __expf(-x)); }
__device__ __forceinline__ void unpack8(const u32x4 w, float (&f)[8]) {
    f[0] = __uint_as_float(w.x << 16); f[1] = __uint_as_float(w.x & 0xffff0000u); f[2] = __uint_as_float(w.y << 16); f[3] = __uint_as_float(w.y & 0xffff0000u);
    f[4] = __uint_as_float(w.z << 16); f[5] = __uint_as_float(w.z & 0xffff0000u); f[6] = __uint_as_float(w.w << 16); f[7] = __uint_as_float(w.w & 0xffff0000u);
}
__device__ __forceinline__ u32x4 pack8(const float (&f)[8]) { u32x4 w; w.x = cvt_pk_bf16(f[0], f[1]); w.y = cvt_pk_bf16(f[2], f[3]); w.z = cvt_pk_bf16(f[4], f[5]); w.w = cvt_pk_bf16(f[6], f[7]); return w; }

template <int MODE>
__device__ __forceinline__ void convert_wt(const float* src, int ldsrc, bf16_t* dst, int K, int N, const float* kscale, ldsp lds, int vb, int nvb) {
    LAS float* tile = (LAS float*)lds;
    const int tid = pg8::opaque_tid(), nkt = K / 64, ntile = nkt * (N / 256);
    for (int tl = vb; tl < ntile; tl += nvb) {
        const int k0 = (tl % nkt) * 64, n0 = (tl / nkt) * 256;
#pragma unroll
        for (int i = 0; i < 8; ++i) {
            const int idx = tid + i * 512, kk = idx >> 6, n = n0 + (idx & 63) * 4;
            int sc = n;
            if (MODE == 1) sc = (n < 3072) ? n : (n < 3328 ? n + 4 : (n < 3332 ? n - 256 : -1));
            f32x4 v = {0.f, 0.f, 0.f, 0.f};
            if (sc >= 0) { v = *(const f32x4*)(src + (size_t)(k0 + kk) * ldsrc + sc); if (kscale) v = v * kscale[k0 + kk]; }
            *(LAS f32x4*)(tile + kk * 260 + (idx & 63) * 4) = v;
        }
        __syncthreads();
#pragma unroll
        for (int i = 0; i < 4; ++i) {
            const int idx = tid + i * 512, nl = idx >> 3, k8 = (idx & 7) * 8;
            float f[8];
#pragma unroll
            for (int j = 0; j < 8; ++j) f[j] = tile[(k8 + j) * 260 + nl];
            *(u32x4*)(dst + (size_t)(n0 + nl) * K + k0 + k8) = pack8(f);
        }
        __syncthreads();
    }
}
__device__ __forceinline__ void phase0(const Params& P, ldsp lds) {
    unsigned char* ws = P.ws;
    const int G = gridDim.x, b = blockIdx.x;
    for (int l = 0; l < 2; ++l) {
        convert_wt<1>(P.in[I_WIN] + (size_t)l * DM * INC, INC, (bf16_t*)(ws + W_WIN) + (size_t)l * NPROJ * DM, DM, NPROJ, P.in[I_NMIX] + l * DM, lds, b, G);
        convert_wt<0>(P.in[I_WOUT] + (size_t)l * DM * DM, DM, (bf16_t*)(ws + W_WOUT) + (size_t)l * DM * DM, DM, DM, nullptr, lds, (b + 64) % G, G);
        convert_wt<0>(P.in[I_WUP] + (size_t)l * DM * DFF, DFF, (bf16_t*)(ws + W_WUP) + (size_t)l * DFF * DM, DM, DFF, P.in[I_NMLP] + l * DM, lds, (b + 128) % G, G);
        convert_wt<0>(P.in[I_WDOWN] + (size_t)l * DFF * DM, DM, (bf16_t*)(ws + W_WDN) + (size_t)l * DM * DFF, DFF, DM, nullptr, lds, (b + 192) % G, G);
        convert_wt<0>(P.in[I_GLUW] + (size_t)l * 256 * 256, 256, (bf16_t*)(ws + W_WGLU) + (size_t)l * 256 * 256, 256, 256, nullptr, lds, (b + 32) % G, G);
    }
    const int tid_ = pg8::opaque_tid(), wave = tid_ >> 6, lane = tid_ & 63;
    bf16_t* XB = (bf16_t*)(ws + W_XB); float* SSQ = (float*)(ws + W_SSQ);
    const int stride = G * 8;
    for (int rb = b * 8 + wave; rb < TT; rb += 4 * stride) {
        f32x4 v[4][4];
#pragma unroll
        for (int u = 0; u < 4; ++u) {
            const int row = rb + u * stride;
            const float* xp = (row < T_P) ? (P.in[I_XP] + (size_t)row * DM) : (P.in[I_XS] + (size_t)(row - T_P) * DM);
#pragma unroll
            for (int j = 0; j < 4; ++j) v[u][j] = (row < TT) ? *(const f32x4*)(xp + j * 256 + lane * 4) : (f32x4){0.f, 0.f, 0.f, 0.f};
        }
#pragma unroll
        for (int u = 0; u < 4; ++u) {
            const int row = rb + u * stride;
            if (row < TT) {
                float s = 0.f;
#pragma unroll
                for (int j = 0; j < 4; ++j) {
                    const f32x4 x = v[u][j];
                    s += (x[0] * x[0] + x[1] * x[1]) + (x[2] * x[2] + x[3] * x[3]);
                    u32x2 w; w.x = cvt_pk_bf16(x[0], x[1]); w.y = cvt_pk_bf16(x[2], x[3]);
                    *(u32x2*)(XB + (size_t)row * DM + j * 256 + lane * 4) = w;
                    if (row >= T_P) *(f32x4*)(P.out + (size_t)row * DM + j * 256 + lane * 4) = x;
                }
#pragma unroll
                for (int o = 32; o >= 1; o >>= 1) s += __shfl_xor(s, o);
                if (lane < 16) SSQ[(size_t)row * 16 + lane] = (lane == 0) ? s : 0.f;
            }
        }
    }
}

constexpr int QS = 136, RS = 72, OS = 68;
constexpr int L_QI = 0, L_KI = 17408, L_KDT = 34816, L_VT = 53248, L_ST = 62464, L_FL = 79872, L_P = 83968, L_OB = 93184, L_XT = 110592, L_RAW = L_P, L_QSLOT = 130048;
constexpr int F_B = 0, F_RS = 64, F_CS = 128, F_DL = 256, F_KS = 320, F_SEG = 384;

__device__ __forceinline__ void lds_barrier() { asm volatile("s_waitcnt lgkmcnt(0)" ::: "memory"); __builtin_amdgcn_s_barrier(); asm volatile("" ::: "memory"); }
__device__ __forceinline__ f32x4 mma_tile(const LAS bf16_t* A, int lda, const LAS bf16_t* B, int ldb, int K, f32x4 acc, int r, int q) {
    for (int k0 = 0; k0 < K; k0 += 32) {
        const bf16x8 a = *(const LAS bf16x8*)(A + r * lda + k0 + q * 8);
        const bf16x8 b = *(const LAS bf16x8*)(B + r * ldb + k0 + q * 8);
        acc = __builtin_amdgcn_mfma_f32_16x16x32_bf16(a, b, acc, 0, 0, 0);
    }
    return acc;
}
template <int DK, int DMODE>
__device__ __forceinline__ void la_scores(ldsp lds, int wave, int lane, float lg2) {
    const LAS bf16_t* Qi = (const LAS bf16_t*)(lds + L_QI); const LAS bf16_t* Ki = (const LAS bf16_t*)(lds + L_KI);
    LAS bf16_t* Pm = (LAS bf16_t*)(lds + L_P); const LAS float* FL = (const LAS float*)(lds + L_FL);
    const int r = lane & 15, q = lane >> 4;
#pragma unroll
    for (int i = 0; i < 2; ++i) {
        const int id = wave * 2 + i, tm = id >> 2, tn = id & 3;
        f32x4 acc = {0.f, 0.f, 0.f, 0.f};
        if (tn <= tm) acc = mma_tile(Qi + tm * 16 * QS, QS, Ki + tn * 16 * QS, QS, DK, acc, r, q);
#pragma unroll
        for (int j = 0; j < 4; ++j) {
            const int t = tm * 16 + q * 4 + j, s = tn * 16 + r;
            float v = acc[j];
            if (DMODE == 1) v *= exp2f((float)(t - s) * lg2);
            if (DMODE == 2) v *= __expf(fminf(FL[F_B + t] - FL[F_B + s], 0.f));
            v = (s <= t) ? v : 0.f;
            Pm[t * RS + s] = f2bf(v);
        }
    }
}
template <int DK, bool SEPQC>
__device__ __forceinline__ void la_out(ldsp lds, int wave, int lane) {
    const LAS bf16_t* Qx = (const LAS bf16_t*)(lds + (SEPQC ? L_XT : L_QI)); const LAS bf16_t* Pm = (const LAS bf16_t*)(lds + L_P);
    const LAS bf16_t* Vt = (const LAS bf16_t*)(lds + L_VT); const LAS bf16_t* St = (const LAS bf16_t*)(lds + L_ST);
    LAS float* Ob = (LAS float*)(lds + L_OB); const LAS float* FL = (const LAS float*)(lds + L_FL);
    const int r = lane & 15, q = lane >> 4;
#pragma unroll
    for (int i = 0; i < 2; ++i) {
        const int id = wave * 2 + i, tm = id >> 2, tv = id & 3;
        f32x4 a1 = {0.f, 0.f, 0.f, 0.f}, a2 = {0.f, 0.f, 0.f, 0.f};
        a1 = mma_tile(Pm + tm * 16 * RS, RS, Vt + tv * 16 * RS, RS, 64, a1, r, q);
        a2 = mma_tile(Qx + tm * 16 * QS, QS, St + tv * 16 * QS, QS, DK, a2, r, q);
#pragma unroll
        for (int j = 0; j < 4; ++j) {
            const int t = tm * 16 + q * 4 + j, v = tv * 16 + r;
            Ob[t * OS + v] = a1[j] + (SEPQC ? a2[j] : FL[F_RS + t] * a2[j]);
        }
    }
}
template <int DK>
__device__ __forceinline__ void la_state(ldsp lds, int wave, int lane, f32x4 (&sacc)[DK / 32]) {
    constexpr int NT = DK / 32, TK = DK / 16;
    const LAS bf16_t* Vt = (const LAS bf16_t*)(lds + L_VT); const LAS bf16_t* Kdt = (const LAS bf16_t*)(lds + L_KDT);
    LAS bf16_t* St = (LAS bf16_t*)(lds + L_ST); const LAS float* FL = (const LAS float*)(lds + L_FL);
    const int r = lane & 15, q = lane >> 4;
#pragma unroll
    for (int i = 0; i < NT; ++i) {
        const int id = wave * NT + i, tv = id / TK, tk = id % TK;
        const float sc = FL[F_CS + tk * 16 + r];
        sacc[i] = sacc[i] * sc;
        sacc[i] = mma_tile(Vt + tv * 16 * RS, RS, Kdt + tk * 16 * RS, RS, 64, sacc[i], r, q);
#pragma unroll
        for (int j = 0; j < 4; ++j) St[(tv * 16 + q * 4 + j) * QS + tk * 16 + r] = f2bf(sacc[i][j]);
    }
}
template <int DK>
__device__ __forceinline__ void la_state_init(ldsp lds, int wave, int lane, f32x4 (&sacc)[DK / 32], const float* s0  ) {
    constexpr int NT = DK / 32, TK = DK / 16;
    LAS bf16_t* St = (LAS bf16_t*)(lds + L_ST);
    const int r = lane & 15, q = lane >> 4;
#pragma unroll
    for (int i = 0; i < NT; ++i) {
        const int id = wave * NT + i, tv = id / TK, tk = id % TK;
        f32x4 v = {0.f, 0.f, 0.f, 0.f};
        if (s0) v = *(const f32x4*)(s0 + (size_t)(tk * 16 + r) * 64 + tv * 16 + q * 4);
        sacc[i] = v;
#pragma unroll
        for (int j = 0; j < 4; ++j) St[(tv * 16 + q * 4 + j) * QS + tk * 16 + r] = f2bf(v[j]);
    }
}
template <int DK>
__device__ __forceinline__ void la_state_store(int wave, int lane, const f32x4 (&sacc)[DK / 32], float* so  ) {
    constexpr int NT = DK / 32, TK = DK / 16;
    const int r = lane & 15, q = lane >> 4;
#pragma unroll
    for (int i = 0; i < NT; ++i) {
        const int id = wave * NT + i, tv = id / TK, tk = id % TK;
        *(f32x4*)(so + (size_t)(tk * 16 + r) * 64 + tv * 16 + q * 4) = sacc[i];
    }
}

struct SeqInfo { int L, row0, pos0, b; bool sample; };
__device__ __forceinline__ SeqInfo seq_info(int seq) {
    SeqInfo s;
    if (seq < NB_P) { s.L = LEN_P; s.row0 = seq * LEN_P; s.pos0 = 0; s.b = seq; s.sample = false; }
    else { s.L = LEN_S; s.row0 = T_P + (seq - NB_P) * LEN_S; s.pos0 = 16384; s.b = seq - NB_P; s.sample = true; }
    return s;
}
constexpr int NS = 8, SL = 256;
constexpr size_t SG_RET = 0, SG_HG = SG_RET + (size_t)8 * 4 * NS * 4096 * 4, SG_SSD = SG_HG + (size_t)8 * 4 * NS * 4096 * 4, SG_HGD = SG_SSD + (size_t)8 * 4 * NS * 8192 * 4,
                 SG_SSDD = SG_HGD + (size_t)8 * 4 * NS * 64 * 4, SG_S5 = SG_SSDD + 4096, SG_END = SG_S5 + (size_t)8 * 16 * NS * 64 * 8;
static_assert(SG_END <= (size_t)TT * DM * 2, "segment scratch fits the XB region");

template <int DK, int DMODE>
__device__ __forceinline__ void la_state_scan(ldsp lds, int wave, int lane, f32x4 (&sacc)[DK / 32], const float* segb, int seg, float dsc, const float* dtab) {
    constexpr int NT = DK / 32, TK = DK / 16;
    LAS bf16_t* St = (LAS bf16_t*)(lds + L_ST);
    const int r = lane & 15, q = lane >> 4;
#pragma unroll
    for (int i = 0; i < NT; ++i) sacc[i] = (f32x4){0.f, 0.f, 0.f, 0.f};
#pragma unroll 4
    for (int s = 0; s < seg; ++s) {
#pragma unroll
        for (int i = 0; i < NT; ++i) {
            const int id = wave * NT + i, tv = id / TK, tk = id % TK;
            float sc = dsc;
            if (DMODE == 1) sc = dtab[s * 64 + tk * 16 + r];
            if (DMODE == 2) sc = dtab[s];
            const f32x4 v = *(const f32x4*)(segb + (size_t)s * DK * 64 + (size_t)(tk * 16 + r) * 64 + tv * 16 + q * 4);
            sacc[i] = sacc[i] * sc + v;
        }
    }
#pragma unroll
    for (int i = 0; i < NT; ++i) {
        const int id = wave * NT + i, tv = id / TK, tk = id % TK;
#pragma unroll
        for (int j = 0; j < 4; ++j) St[(tv * 16 + q * 4 + j) * QS + tk * 16 + r] = f2bf(sacc[i][j]);
    }
}

__device__ __forceinline__ void ret_item(const Ctx& P, int l, int seq, int h, int tb, int te, int init, int full, int store, int seg, ldsp lds) {
    const SeqInfo si = seq_info(seq);
    const int tid = pg8::opaque_tid(), wave = tid >> 6, lane = tid & 63;
    const bf16_t* PROJ = (const bf16_t*)(P.ws + W_PROJ); bf16_t* MIX = (bf16_t*)(P.ws + W_MIX);
    LAS bf16_t* Qi = (LAS bf16_t*)(lds + L_QI); LAS bf16_t* Ki = (LAS bf16_t*)(lds + L_KI); LAS bf16_t* Kdt = (LAS bf16_t*)(lds + L_KDT); LAS bf16_t* Vt = (LAS bf16_t*)(lds + L_VT);
    LAS float* FL = (LAS float*)(lds + L_FL); const LAS float* Ob = (const LAS float*)(lds + L_OB);
    const float lg2 = log2f(1.0f - exp2f(-5.0f - (float)h));
    float* segb = (float*)(P.ws + W_XB + SG_RET) + (size_t)((seq & 7) * 4 + h) * NS * 4096;
    f32x4 sacc[2];
    if (init == 2) la_state_scan<64, 0>(lds, wave, lane, sacc, segb, seg, exp2f((float)SL * lg2), nullptr);
    else la_state_init<64>(lds, wave, lane, sacc, init == 1 ? (P.in(I_SRET) + ((size_t)(l * NB_S + si.b) * 4 + h) * 4096) : nullptr);
    const int t = tid >> 3, c0 = (tid & 7) * 8;
    float ang[4];
#pragma unroll
    for (int i = 0; i < 4; ++i) ang[i] = exp2f(-(float)(c0 / 2 + i) * (13.287712379549449f / 31.0f));
    u32x4 rq, rk, rv, rg;
#define RET_LOAD(T0) do { rq = (u32x4){0u, 0u, 0u, 0u}; rk = rq; rv = rq; rg = rq; \
        if ((T0) < te && t < te - (T0)) { const bf16_t* pp_ = PROJ + (size_t)(si.row0 + (T0) + t) * NPROJ + h * 64 + c0; \
            rq = *(const u32x4*)(pp_ + C_RQ); rk = *(const u32x4*)(pp_ + C_RK); rv = *(const u32x4*)(pp_ + C_RV); if (full) rg = *(const u32x4*)(pp_ + C_RG); } } while (0)
    RET_LOAD(tb);
    for (int t0 = tb; t0 < te; t0 += 64) {
        const int nv = min(64, te - t0);
        const bool valid = t < nv;
        const size_t row = (size_t)(si.row0 + t0 + t);
        float qf[8], kf[8], vf[8];
        unpack8(rq, qf); unpack8(rk, kf); unpack8(rv, vf);
        const u32x4 gcur = rg;
        if (valid) {
            const double pos = (double)(si.pos0 + t0 + t);
#pragma unroll
            for (int i = 0; i < 4; ++i) {
                const double tr = pos * (double)ang[i] * 0.15915494309189535;
                const float fr = (float)(tr - floor(tr)) * 6.283185307179586f;
                const float sn = __sinf(fr), cs = __cosf(fr);
                const float q1 = qf[2 * i], q2 = qf[2 * i + 1], k1 = kf[2 * i] * 0.125f, k2 = kf[2 * i + 1] * 0.125f;
                if (full) { qf[2 * i] = q1 * cs - q2 * sn; qf[2 * i + 1] = q1 * sn + q2 * cs; }
                kf[2 * i] = k1 * cs - k2 * sn; kf[2 * i + 1] = k1 * sn + k2 * cs;
            }
        }
        const float gq = exp2f((float)t * lg2), gk = exp2f(-(float)t * lg2);
#pragma unroll
        for (int i = 0; i < 8; ++i) { qf[i] *= gq; kf[i] *= gk; }
        if (full) { *(LAS u32x4*)(Qi + t * QS + c0) = pack8(qf); *(LAS u32x4*)(Ki + t * QS + c0) = pack8(kf); }
        const float kd = exp2f((float)(nv - 1) * lg2);
#pragma unroll
        for (int i = 0; i < 8; ++i) { Kdt[(c0 + i) * RS + t] = f2bf(kf[i] * kd); Vt[(c0 + i) * RS + t] = f2bf(vf[i]); }
        if ((tid & 7) == 0) FL[F_RS + t] = exp2f(lg2);
        if (tid < 64) FL[F_CS + tid] = exp2f((float)nv * lg2);
        RET_LOAD(t0 + 64);
        lds_barrier();
        if (full) {
            la_scores<64, 0>(lds, wave, lane, 0.f);
            lds_barrier();
            la_out<64, false>(lds, wave, lane);
            lds_barrier();
        }
        la_state<64>(lds, wave, lane, sacc);
        if (full) {
            float o[8]; float s = 0.f;
#pragma unroll
            for (int i = 0; i < 8; ++i) { o[i] = Ob[t * OS + c0 + i]; s += o[i]; }
            s += __shfl_xor(s, 1); s += __shfl_xor(s, 2); s += __shfl_xor(s, 4);
            const float mu = s * (1.0f / 64.0f); float vq = 0.f;
#pragma unroll
            for (int i = 0; i < 8; ++i) { o[i] -= mu; vq += o[i] * o[i]; }
            vq += __shfl_xor(vq, 1); vq += __shfl_xor(vq, 2); vq += __shfl_xor(vq, 4);
            const float rstd = rsqrtf(vq * (1.0f / 64.0f) + 1e-6f);
            if (valid) {
                float g[8]; unpack8(gcur, g);
#pragma unroll
                for (int i = 0; i < 8; ++i) o[i] = o[i] * rstd * siluf_(g[i]);
                *(u32x4*)(MIX + row * DM + h * 64 + c0) = pack8(o);
            }
        }
        lds_barrier();
    }
#undef RET_LOAD
    if (store == 1) la_state_store<64>(wave, lane, sacc, P.out + (si.sample ? (O_SRET + ((size_t)(l * NB_S + si.b) * 4 + h) * 4096) : (O_PRET + ((size_t)(l * NB_P + si.b) * 4 + h) * 4096)));
    if (store == 2) la_state_store<64>(wave, lane, sacc, segb + (size_t)seg * 4096);
}

__device__ __forceinline__ void hgrn_item(const Ctx& P, int l, int seq, int h, int tb, int te, int init, int full, int store, int seg, ldsp lds) {
    const SeqInfo si = seq_info(seq);
    const int tid = pg8::opaque_tid(), wave = tid >> 6, lane = tid & 63;
    const bf16_t* PROJ = (const bf16_t*)(P.ws + W_PROJ); bf16_t* MIX = (bf16_t*)(P.ws + W_MIX);
    LAS bf16_t* Qi = (LAS bf16_t*)(lds + L_QI); LAS bf16_t* Ki = (LAS bf16_t*)(lds + L_KI); LAS bf16_t* Kdt = (LAS bf16_t*)(lds + L_KDT); LAS bf16_t* Vt = (LAS bf16_t*)(lds + L_VT);
    LAS bf16_t* Qc = (LAS bf16_t*)(lds + L_XT);
    LAS float* FL = (LAS float*)(lds + L_FL); const LAS float* Ob = (const LAS float*)(lds + L_OB);
    float* segb = (float*)(P.ws + W_XB + SG_HG) + (size_t)((seq & 7) * 4 + h) * NS * 4096;
    float* segd = (float*)(P.ws + W_XB + SG_HGD) + (size_t)((seq & 7) * 4 + h) * NS * 64;
    f32x4 sacc[2];
    if (init == 2) la_state_scan<64, 1>(lds, wave, lane, sacc, segb, seg, 1.f, segd);
    else la_state_init<64>(lds, wave, lane, sacc, init == 1 ? (P.in(I_SHG) + ((size_t)(l * NB_S + si.b) * 4 + h) * 4096) : nullptr);
    const int k = lane, sg = wave;
    float lower = 0.f;
    if (l == 1) { const float a0 = P.in(I_HGLB)[h * 64 + k], a1 = P.in(I_HGLB)[256 + h * 64 + k]; lower = 1.0f / (1.0f + expf(a0 - a1)); }
    const int tp = tid >> 3, c0 = (tid & 7) * 8;
    float cumlog = 0.f;
    unsigned short pq[8], pf[8], pi_[8]; u32x4 rg;
#define HG_LOAD(T0) do { rg = (u32x4){0u, 0u, 0u, 0u}; \
        _Pragma("unroll") for (int j = 0; j < 8; ++j) { pq[j] = 0; pf[j] = 0; pi_[j] = 0; const int tt_ = sg * 8 + j; \
            if ((T0) < te && tt_ < te - (T0)) { const size_t b_ = (size_t)(si.row0 + (T0) + tt_) * NPROJ + h * 64 + k; pq[j] = PROJ[b_ + C_HQ]; pf[j] = PROJ[b_ + C_HF]; pi_[j] = PROJ[b_ + C_HI]; } } \
        if (full && (T0) < te && tp < te - (T0)) rg = *(const u32x4*)(PROJ + (size_t)(si.row0 + (T0) + tp) * NPROJ + C_HG + h * 64 + c0); } while (0)
    HG_LOAD(tb);
    for (int t0 = tb; t0 < te; t0 += 64) {
        const int nv = min(64, te - t0);
        float cs[8], ky[8], qs[8], vv[8];
        float run = 0.f;
#pragma unroll
        for (int j = 0; j < 8; ++j) {
            const int t = sg * 8 + j;
            float lf = 0.f; ky[j] = 0.f; qs[j] = 0.f; vv[j] = 0.f;
            if (t < nv) {
                const float qq = bf2f(pq[j]), ff = bf2f(pf[j]), ii = bf2f(pi_[j]);
                const float ef = __expf(-fminf(fmaxf(ff, -30.f), 30.f));
                const float sgm = 1.0f / (1.0f + ef);
                const float forget = lower + (1.0f - lower) * sgm;
                lf = __logf(fmaxf(forget, 1e-30f));
                ky[j] = (1.0f - lower) * ef * sgm;
                if (full) qs[j] = qq / (1.0f + __expf(-qq));
                vv[j] = ii;
            }
            run += lf; cs[j] = run;
        }
        const u32x4 gcur = rg;
        FL[F_SEG + sg * 64 + k] = run;
        HG_LOAD(t0 + 64);
        lds_barrier();
        float pre = 0.f, tot = 0.f, bref = 0.f;
#pragma unroll
        for (int s = 0; s < 8; ++s) { const float x = FL[F_SEG + s * 64 + k]; if (s < sg) pre += x; if (s < 4) bref += x; tot += x; }
        cumlog += tot;
        const float eb = __expf(bref), et = __expf(tot - bref);
#pragma unroll
        for (int j = 0; j < 8; ++j) {
            const int t = sg * 8 + j; const float b = pre + cs[j];
            if (full) {
                const float e1 = __expf(fminf(fmaxf(b - bref, -80.f), 80.f)), r1 = __builtin_amdgcn_rcpf(e1);
                Qi[t * QS + k] = f2bf(qs[j] * e1);
                Ki[t * QS + k] = f2bf(ky[j] * r1);
                Qc[t * QS + k] = f2bf(qs[j] * e1 * eb);
                Kdt[k * RS + t] = f2bf(ky[j] * r1 * et);
            } else Kdt[k * RS + t] = f2bf(ky[j] * __expf(tot - b));
            Vt[k * RS + t] = f2bf(vv[j]);
        }
        if (sg == 0) FL[F_CS + k] = __expf(tot);
        lds_barrier();
        if (full) {
            la_scores<64, 0>(lds, wave, lane, 0.f);
            lds_barrier();
            la_out<64, true>(lds, wave, lane);
            lds_barrier();
        }
        la_state<64>(lds, wave, lane, sacc);
        if (full) {
            float o[8]; float s = 0.f;
#pragma unroll
            for (int i = 0; i < 8; ++i) { o[i] = Ob[tp * OS + c0 + i]; s += o[i] * o[i]; }
            s += __shfl_xor(s, 1); s += __shfl_xor(s, 2); s += __shfl_xor(s, 4);
            const float rstd = rsqrtf(s * (1.0f / 64.0f) + 1e-6f);
            if (tp < nv) {
                const size_t row = (size_t)(si.row0 + t0 + tp);
                float g[8]; unpack8(gcur, g);
#pragma unroll
                for (int i = 0; i < 8; ++i) o[i] = o[i] * rstd * siluf_(g[i]);
                *(u32x4*)(MIX + row * DM + 256 + h * 64 + c0) = pack8(o);
            }
        }
        lds_barrier();
    }
#undef HG_LOAD
    if (store == 1) la_state_store<64>(wave, lane, sacc, P.out + (si.sample ? (O_SHG + ((size_t)(l * NB_S + si.b) * 4 + h) * 4096) : (O_PHG + ((size_t)(l * NB_P + si.b) * 4 + h) * 4096)));
    if (store == 2) { la_state_store<64>(wave, lane, sacc, segb + (size_t)seg * 4096); if (sg == 0) segd[seg * 64 + k] = __expf(cumlog); }
}

constexpr int L_CW = 131136;
__device__ __forceinline__ void ssd_item(const Ctx& P, int l, int seq, int h, int tb, int te, int init, int full, int store, int seg, ldsp lds) {
    const SeqInfo si = seq_info(seq);
    const int tid = pg8::opaque_tid(), wave = tid >> 6, lane = tid & 63, g = h >> 1;
    const bf16_t* PROJ = (const bf16_t*)(P.ws + W_PROJ); bf16_t* MIX = (bf16_t*)(P.ws + W_MIX); float* SSDSQ = (float*)(P.ws + W_SSDSQ);
    LAS bf16_t* Qi = (LAS bf16_t*)(lds + L_QI); LAS bf16_t* Ki = (LAS bf16_t*)(lds + L_KI); LAS bf16_t* Kdt = (LAS bf16_t*)(lds + L_KDT); LAS bf16_t* Vt = (LAS bf16_t*)(lds + L_VT);
    LAS bf16_t* RAW = (LAS bf16_t*)(lds + L_RAW);
    LAS float* FL = (LAS float*)(lds + L_FL); const LAS float* Ob = (const LAS float*)(lds + L_OB); LAS float* CW = (LAS float*)(lds + L_CW);
    float* segb = (float*)(P.ws + W_XB + SG_SSD) + (size_t)((seq & 7) * 4 + h) * NS * 8192;
    float* segd = (float*)(P.ws + W_XB + SG_SSDD) + (size_t)((seq & 7) * 4 + h) * NS;
    const float* cbuf = si.sample ? (P.in(I_SCONV) + (size_t)(l * NB_S + si.b) * 3 * 768) : nullptr;
    f32x4 sacc[4];
    if (init == 2) la_state_scan<128, 2>(lds, wave, lane, sacc, segb, seg, 1.f, segd);
    else la_state_init<128>(lds, wave, lane, sacc, init == 1 ? (P.in(I_SSSD) + ((size_t)(l * NB_S + si.b) * 4 + h) * 8192) : nullptr);
    const float dtb = P.in(I_DTB)[l * 4 + h], aexp = expf(P.in(I_ALOG)[l * 4 + h]), dsk = P.in(I_SSDD)[l * 4 + h];
    if (tid < 320) {
        const int cc = (tid < 64) ? (h * 64 + tid) : (tid < 192 ? 256 + g * 128 + (tid - 64) : 512 + g * 128 + (tid - 192));
        const float* cwp = P.in(I_CONVW) + (size_t)l * 4 * 768;
        CW[tid] = cwp[cc]; CW[320 + tid] = cwp[768 + cc]; CW[640 + tid] = cwp[2 * 768 + cc]; CW[960 + tid] = cwp[3 * 768 + cc]; CW[1280 + tid] = P.in(I_CONVB)[l * 768 + cc];
    }
    const int tp = tid >> 3, c0 = (tid & 7) * 8;
    float cumlog = 0.f;
    u32x4 rw[6]; u32x4 rz; unsigned short rdt;
    int stt[6], ssrc[6], slds[6];
#pragma unroll
    for (int i = 0; i < 6; ++i) { const int idx = tid + i * 512, tt = idx / 40, v8 = idx % 40;
        stt[i] = idx < 67 * 40 ? tt : -1000000; slds[i] = tt * 320 + v8 * 8;
        ssrc[i] = (v8 < 8) ? (h * 64 + v8 * 8) : (v8 < 24 ? 256 + g * 128 + (v8 - 8) * 8 : 512 + g * 128 + (v8 - 24) * 8); }
#define SSD_LOAD(T0) do { \
        _Pragma("unroll") for (int i_ = 0; i_ < 6; ++i_) { rw[i_] = (u32x4){0u, 0u, 0u, 0u}; const int ts_ = (T0) - 3 + stt[i_]; \
            if (stt[i_] >= 0 && (T0) < te) { const int sc_ = ssrc[i_]; \
                if (ts_ >= 0 && ts_ < te) rw[i_] = *(const u32x4*)(PROJ + (size_t)(si.row0 + ts_) * NPROJ + C_XBC + sc_); \
                else if (ts_ < 0 && cbuf) { const f32x4 a_ = *(const f32x4*)(cbuf + (ts_ + 3) * 768 + sc_), b_ = *(const f32x4*)(cbuf + (ts_ + 3) * 768 + sc_ + 4); \
                    rw[i_].x = cvt_pk_bf16(a_[0], a_[1]); rw[i_].y = cvt_pk_bf16(a_[2], a_[3]); rw[i_].z = cvt_pk_bf16(b_[0], b_[1]); rw[i_].w = cvt_pk_bf16(b_[2], b_[3]); } } } \
        rdt = 0; if (wave == 7 && (T0) < te && lane < te - (T0)) rdt = PROJ[(size_t)(si.row0 + (T0) + lane) * NPROJ + C_DT + h]; \
        rz = (u32x4){0u, 0u, 0u, 0u}; if (full && (T0) < te && tp < te - (T0)) rz = *(const u32x4*)(PROJ + (size_t)(si.row0 + (T0) + tp) * NPROJ + C_SZ + h * 64 + c0); } while (0)
    SSD_LOAD(tb);
    for (int t0 = tb; t0 < te; t0 += 64) {
        const int nv = min(64, te - t0);
#pragma unroll
        for (int i = 0; i < 6; ++i) { if (stt[i] >= 0) *(LAS u32x4*)(RAW + slds[i]) = rw[i]; }
        const u32x4 zcur = rz;
        if (wave == 7) {
            const int t = lane; float delta = 0.f, la = 0.f;
            if (t < nv) {
                const float dtv = bf2f(rdt) + dtb;
                delta = (dtv > 20.f) ? dtv : log1pf(__expf(dtv));
                la = -delta * aexp;
            }
            float b = la;
#pragma unroll
            for (int o = 1; o < 64; o <<= 1) { const float x = __shfl_up(b, o); if (lane >= o) b += x; }
            const float bl = __shfl(b, 63);
            cumlog += bl;
            FL[F_B + t] = b; FL[F_RS + t] = __expf(b); FL[F_DL + t] = delta; FL[F_KS + t] = delta * __expf(bl - b);
            FL[F_CS + t] = __expf(bl); FL[F_CS + 64 + t] = __expf(bl);
        }
        SSD_LOAD(t0 + 64);
        lds_barrier();
        for (int u = tid; u < 2560; u += 512) {
            const int c = u % 320, oc = u / 320;
            if (!full && c >= 192) continue;
            const float w0 = CW[c], w1 = CW[320 + c], w2 = CW[640 + c], w3 = CW[960 + c], bb = CW[1280 + c];
            float x0 = bf2f(RAW[(oc * 8 + 0) * 320 + c]), x1 = bf2f(RAW[(oc * 8 + 1) * 320 + c]), x2 = bf2f(RAW[(oc * 8 + 2) * 320 + c]);
#pragma unroll
            for (int j = 0; j < 8; ++j) {
                const int t = oc * 8 + j;
                const float x3 = bf2f(RAW[(t + 3) * 320 + c]);
                float v = bb + w0 * x0 + w1 * x1 + w2 * x2 + w3 * x3;
                v = siluf_(v);
                if (t >= nv) v = 0.f;
                if (c < 64) Vt[c * RS + t] = f2bf(v);
                else if (c < 192) { const int n = c - 64; if (full) Ki[t * QS + n] = f2bf(v * FL[F_DL + t]); Kdt[n * RS + t] = f2bf(v * FL[F_KS + t]); }
                else if (full) { const int n = c - 192; Qi[t * QS + n] = f2bf(v); }
                x0 = x1; x1 = x2; x2 = x3;
            }
        }
        lds_barrier();
        if (full) {
            la_scores<128, 2>(lds, wave, lane, 0.f);
            lds_barrier();
            la_out<128, false>(lds, wave, lane);
            lds_barrier();
        }
        la_state<128>(lds, wave, lane, sacc);
        if (full) {
            float o[8]; float s = 0.f;
            const size_t row = (size_t)(si.row0 + t0 + tp);
            float z[8]; unpack8(zcur, z);
#pragma unroll
            for (int i = 0; i < 8; ++i) { const float xs = bf2f(Vt[(c0 + i) * RS + tp]); o[i] = (Ob[tp * OS + c0 + i] + dsk * xs) * siluf_(z[i]); s += o[i] * o[i]; }
            s += __shfl_xor(s, 1); s += __shfl_xor(s, 2); s += __shfl_xor(s, 4);
            if (tp < nv) {
                *(u32x4*)(MIX + row * DM + 512 + h * 64 + c0) = pack8(o);
                if ((tid & 7) == 0) SSDSQ[row * 4 + h] = s;
            }
        }
        lds_barrier();
    }
#undef SSD_LOAD
    if (store == 1) la_state_store<128>(wave, lane, sacc, P.out + (si.sample ? (O_SSSD + ((size_t)(l * NB_S + si.b) * 4 + h) * 8192) : (O_PSSD + ((size_t)(l * NB_P + si.b) * 4 + h) * 8192)));
    if (store == 2) { la_state_store<128>(wave, lane, sacc, segb + (size_t)seg * 8192); if (tid == 7 * 64) segd[seg] = __expf(cumlog); }
    if (store == 1 && h == 0) {
        float* co = P.out + (si.sample ? (O_SCONV + (size_t)(l * NB_S + si.b) * 2304) : (O_PCONV + (size_t)(l * NB_P + si.b) * 2304));
        for (int idx = tid; idx < 2304; idx += 512) { const int rr = idx / 768, c = idx % 768; co[idx] = bf2f(PROJ[(size_t)(si.row0 + si.L - 3 + rr) * NPROJ + C_XBC + c]); }
    }
}

constexpr int S5W = 15360, S5_U = 0, S5_SB = 2048, S5_CB = 2048 + 8704, S5S = 136, S5C = 32;
__device__ __forceinline__ void s5_item(const Ctx& P, int l, int oct, int seq_b, int nseq, int tb, int te, int init, int full, int store, int seg, ldsp lds) {
    typedef float f32x2 __attribute__((ext_vector_type(2)));
    const int tid = pg8::opaque_tid(), w = tid >> 6, p = tid & 63, g = oct * 8 + w;
    const bf16_t* PROJ = (const bf16_t*)(P.ws + W_PROJ); bf16_t* YPRE = (bf16_t*)(P.ws + W_YPRE);
    LAS float* U = (LAS float*)(lds + w * S5W + S5_U); LAS bf16_t* Sb = (LAS bf16_t*)(lds + w * S5W + S5_SB); LAS bf16_t* Cb = (LAS bf16_t*)(lds + w * S5W + S5_CB);
    const int lg = l * 16 + g;
    const float are = P.in(I_S5AR)[lg * 64 + p], aim = P.in(I_S5AI)[lg * 64 + p], step = expf(P.in(I_S5DT)[lg]);
    const float mag = expf(are * step), angr = aim * step;
    const float abr = mag * cosf(angr), abi = mag * sinf(angr);
    const float d2 = are * are + aim * aim, nr = abr - 1.0f;
    const float cr = (nr * are + abi * aim) / d2, ci = (abi * are - nr * aim) / d2;
    float bbr[16], bbi[16];
    {
        const f32x4* br = (const f32x4*)(P.in(I_S5BR) + ((size_t)lg * 64 + p) * 16); const f32x4* bi = (const f32x4*)(P.in(I_S5BI) + ((size_t)lg * 64 + p) * 16);
#pragma unroll
        for (int q4 = 0; q4 < 4; ++q4) { const f32x4 a = br[q4], b = bi[q4];
#pragma unroll
            for (int j = 0; j < 4; ++j) { bbr[q4 * 4 + j] = cr * a[j] - ci * b[j]; bbi[q4 * 4 + j] = cr * b[j] + ci * a[j]; } }
    }
#pragma unroll
    for (int hh = 0; hh < 16; ++hh)
        *(LAS unsigned*)(Cb + hh * S5S + 2 * p) = cvt_pk_bf16(P.in(I_S5CR)[((size_t)lg * 16 + hh) * 64 + p], -P.in(I_S5CI)[((size_t)lg * 16 + hh) * 64 + p]);
    const int r = p & 15, q = p >> 4;
    const float dk = P.in(I_S5D)[l * 256 + g * 16 + r];
    const int ut = p >> 1, uc = (p & 1) * 8;
    for (int sq = seq_b; sq < seq_b + nseq; ++sq) {
        const SeqInfo si = seq_info(sq);
        float sr = 0.f, sim = 0.f;
        if (init == 1) { sr = P.in(I_S5RE)[((size_t)(l * NB_S + si.b) * 16 + g) * 64 + p]; sim = P.in(I_S5IM)[((size_t)(l * NB_S + si.b) * 16 + g) * 64 + p]; }
        f32x2* segs = (f32x2*)(P.ws + W_XB + SG_S5) + (size_t)((sq & 7) * 16 + g) * NS * 64;
        if (init == 2) {
            float qr = abr, qi = abi;
            for (int s = 1; s < SL; s <<= 1) { const float nr_ = qr * qr - qi * qi, ni_ = 2.f * qr * qi; qr = nr_; qi = ni_; }
            for (int s = 0; s < seg; ++s) { const f32x2 e = segs[s * 64 + p]; const float nr_ = qr * sr - qi * sim + e.x, ni_ = qr * sim + qi * sr + e.y; sr = nr_; sim = ni_; }
        }
        u32x4 ru;
#define S5_LOAD(T0) do { ru = (u32x4){0u, 0u, 0u, 0u}; if ((T0) < te && ut < te - (T0)) ru = *(const u32x4*)(PROJ + (size_t)(si.row0 + (T0) + ut) * NPROJ + C_U + g * 16 + uc); } while (0)
        S5_LOAD(tb);
        for (int t0 = tb; t0 < te; t0 += S5C) {
            const int nv = min(S5C, te - t0);
            { float uf[8]; unpack8(ru, uf);
              *(LAS f32x4*)(U + ut * 16 + uc) = (f32x4){uf[0], uf[1], uf[2], uf[3]}; *(LAS f32x4*)(U + ut * 16 + uc + 4) = (f32x4){uf[4], uf[5], uf[6], uf[7]}; }
            S5_LOAD(t0 + S5C);
            asm volatile("s_waitcnt lgkmcnt(0)" ::: "memory"); __builtin_amdgcn_wave_barrier();
            float xr = sr, xi = sim, kr = sr, ki = sim;
            const int nvr = (nv + 3) & ~3;
#pragma unroll 4
            for (int t = 0; t < nvr; ++t) {
                const LAS f32x4* up = (const LAS f32x4*)(U + t * 16);
                float br_ = 0.f, bi_ = 0.f;
#pragma unroll
                for (int q4 = 0; q4 < 4; ++q4) { const f32x4 u4 = up[q4];
#pragma unroll
                    for (int e = 0; e < 4; ++e) { br_ += bbr[q4 * 4 + e] * u4[e]; bi_ += bbi[q4 * 4 + e] * u4[e]; } }
                const float nxr = abr * xr - abi * xi + br_, nxi = abr * xi + abi * xr + bi_;
                xr = nxr; xi = nxi;
                if (full) *(LAS unsigned*)(Sb + t * S5S + 2 * p) = cvt_pk_bf16(xr, xi);
                if (t == nv - 1) { kr = xr; ki = xi; }
            }
            sr = kr; sim = ki;
            if (full) {
                asm volatile("s_waitcnt lgkmcnt(0)" ::: "memory"); __builtin_amdgcn_wave_barrier();
#pragma unroll
                for (int m = 0; m < 2; ++m) {
                    if (m * 16 >= nv) break;
                    f32x4 acc = {0.f, 0.f, 0.f, 0.f};
                    acc = mma_tile(Sb + m * 16 * S5S, S5S, Cb, S5S, 128, acc, r, q);
#pragma unroll
                    for (int j = 0; j < 4; ++j) {
                        const int t = m * 16 + q * 4 + j;
                        const float y = acc[j] + dk * U[t * 16 + r];
                        const float z = 0.7978845608028654f * (y + 0.044715f * y * y * y);
                        const float gl = y * (1.0f - 1.0f / (__expf(2.0f * z) + 1.0f));
                        if (t < nv) YPRE[(size_t)(si.row0 + t0 + t) * 256 + g * 16 + r] = f2bf(gl);
                    }
                }
                asm volatile("s_waitcnt lgkmcnt(0)" ::: "memory"); __builtin_amdgcn_wave_barrier();
            }
        }
#undef S5_LOAD
        if (store == 1) {
            float* ore = P.out + (si.sample ? (O_SS5R + ((size_t)(l * NB_S + si.b) * 16 + g) * 64) : (O_PS5R + ((size_t)(l * NB_P + si.b) * 16 + g) * 64));
            float* oim = P.out + (si.sample ? (O_SS5I + ((size_t)(l * NB_S + si.b) * 16 + g) * 64) : (O_PS5I + ((size_t)(l * NB_P + si.b) * 16 + g) * 64));
            ore[p] = sr; oim[p] = sim;
        }
        if (store == 2) segs[seg * 64 + p] = (f32x2){sr, sim};
    }
}

__device__ __forceinline__ float rdl(float x, int k) { return __uint_as_float((unsigned)__builtin_amdgcn_readlane((int)__float_as_uint(x), k)); }
__device__ __forceinline__ float wsum(float x) {
#pragma unroll
    for (int o = 32; o >= 1; o >>= 1) x += __shfl_xor(x, o);
    return x;
}
__device__ __forceinline__ void rh_sample_wave(const Ctx& P, int l, int b, int h, int lane, int isret) {
    const bf16_t* PROJ = (const bf16_t*)(P.ws + W_PROJ); bf16_t* MIX = (bf16_t*)(P.ws + W_MIX);
    const size_t so_ = ((size_t)(l * NB_S + b) * 4 + h) * 4096;
    const float* s0 = P.in(isret ? I_SRET : I_SHG) + so_; float* so = P.out + (isret ? O_SRET : O_SHG) + so_;
    float S[64];
#pragma unroll
    for (int k = 0; k < 64; ++k) S[k] = s0[k * 64 + lane];
    const float gam = 1.0f - exp2f(-5.0f - (float)h);
    const float angk = exp2f(-(float)(lane >> 1) * (13.287712379549449f / 31.0f)) * 0.15915494309189535f;
    float lower = 0.f;
    if (!isret && l == 1) { const float a0 = P.in(I_HGLB)[h * 64 + lane], a1 = P.in(I_HGLB)[256 + h * 64 + lane]; lower = 1.0f / (1.0f + expf(a0 - a1)); }
    const int cb = isret ? 0 : C_HQ;
#pragma unroll 1
    for (int t = 0; t < LEN_S; ++t) {
        const size_t row = (size_t)(T_P + b * LEN_S + t);
        const bf16_t* pp = PROJ + row * NPROJ + cb + h * 64 + lane;
        const float x0 = bf2f(pp[0]), x1 = bf2f(pp[256]), val = bf2f(pp[512]), g = bf2f(pp[768]);
        float dec, key, qry;
        if (isret) {
            const float tr = (float)(16384 + t) * angk;
            const float fr = (tr - floorf(tr)) * 6.283185307179586f;
            const float sn = __sinf(fr), cs = __cosf(fr);
            const float qp = __shfl_xor(x0, 1), kp = __shfl_xor(x1, 1);
            qry = (lane & 1) ? (qp * sn + x0 * cs) : (x0 * cs - qp * sn);
            key = ((lane & 1) ? (kp * sn + x1 * cs) : (x1 * cs - kp * sn)) * 0.125f;
            dec = gam;
        } else {
            const float ef = __expf(-fminf(fmaxf(x1, -30.f), 30.f)), sgm = 1.0f / (1.0f + ef);
            dec = fmaxf(lower + (1.0f - lower) * sgm, 1e-30f); key = (1.0f - lower) * ef * sgm; qry = x0 / (1.0f + __expf(-x0));
        }
        float o = 0.f;
#pragma unroll
        for (int kk = 0; kk < 64; ++kk) { const float dk = rdl(dec, kk), kyk = rdl(key, kk), qk = rdl(qry, kk); S[kk] = fmaf(kyk, val, dk * S[kk]); o = fmaf(qk, S[kk], o); if ((kk & 7) == 7) __builtin_amdgcn_sched_barrier(0); }
        const float mu = isret ? wsum(o) * (1.0f / 64.0f) : 0.f, d = o - mu;
        const float var = wsum(d * d) * (1.0f / 64.0f);
        MIX[row * DM + (isret ? 0 : 256) + h * 64 + lane] = f2bf(d * rsqrtf(var + 1e-6f) * siluf_(g));
    }
#pragma unroll
    for (int k = 0; k < 64; ++k) so[k * 64 + lane] = S[k];
}
__device__ __forceinline__ void ssd_sample_wave(const Ctx& P, int l, int b, int h, int lane, LAS float* YL  ) {
    const bf16_t* PROJ = (const bf16_t*)(P.ws + W_PROJ); bf16_t* MIX = (bf16_t*)(P.ws + W_MIX); float* SSDSQ = (float*)(P.ws + W_SSDSQ);
    const int g = h >> 1;
    const size_t so_ = ((size_t)(l * NB_S + b) * 4 + h) * 8192;
    const float* s0 = P.in(I_SSSD) + so_; float* so = P.out + O_SSSD + so_;
    const float dtb = P.in(I_DTB)[l * 4 + h], aexp = expf(P.in(I_ALOG)[l * 4 + h]), dsk = P.in(I_SSDD)[l * 4 + h];
    const float* cwp = P.in(I_CONVW) + (size_t)l * 4 * 768; const float* cbuf = P.in(I_SCONV) + (size_t)(l * NB_S + b) * 3 * 768;
#pragma unroll 1
    for (int half = 0; half < 2; ++half) {
        float S[64];
#pragma unroll
        for (int n = 0; n < 64; ++n) S[n] = s0[(half * 64 + n) * 64 + lane];
        int ch[3]; ch[0] = h * 64 + lane; ch[1] = 256 + g * 128 + half * 64 + lane; ch[2] = 512 + g * 128 + half * 64 + lane;
        float cw[3][4], cb[3], win[3][3];
#pragma unroll
        for (int c = 0; c < 3; ++c) {
#pragma unroll
            for (int w = 0; w < 4; ++w) cw[c][w] = cwp[w * 768 + ch[c]];
            cb[c] = P.in(I_CONVB)[l * 768 + ch[c]];
#pragma unroll
            for (int w = 0; w < 3; ++w) win[c][w] = bf2f(f2bf(cbuf[w * 768 + ch[c]]));
        }
#pragma unroll 1
        for (int t = 0; t < LEN_S; ++t) {
            const size_t row = (size_t)(T_P + b * LEN_S + t);
            const bf16_t* pr = PROJ + row * NPROJ;
            float cv[3];
#pragma unroll
            for (int c = 0; c < 3; ++c) {
                const float raw = bf2f(pr[C_XBC + ch[c]]);
                cv[c] = siluf_(cb[c] + cw[c][0] * win[c][0] + cw[c][1] * win[c][1] + cw[c][2] * win[c][2] + cw[c][3] * raw);
                win[c][0] = win[c][1]; win[c][1] = win[c][2]; win[c][2] = raw;
            }
            const float dtv = bf2f(pr[C_DT + h]) + dtb;
            const float delta = (dtv > 20.f) ? dtv : log1pf(__expf(dtv));
            const float a = __expf(-delta * aexp);
            const float xc = cv[0], bd = cv[1] * delta;
            float y = 0.f;
#pragma unroll
            for (int n = 0; n < 64; ++n) { const float bn = rdl(bd, n), cn = rdl(cv[2], n); S[n] = fmaf(bn, xc, a * S[n]); y = fmaf(cn, S[n], y); if ((n & 7) == 7) __builtin_amdgcn_sched_barrier(0); }
            if (half == 0) YL[t * 64 + lane] = y;
            else {
                const float z = bf2f(pr[C_SZ + h * 64 + lane]);
                y = (y + YL[t * 64 + lane] + dsk * xc) * siluf_(z);
                MIX[row * DM + 512 + h * 64 + lane] = f2bf(y);
                const float ss = wsum(y * y);
                if (lane == 0) SSDSQ[row * 4 + h] = ss;
            }
        }
#pragma unroll
        for (int n = 0; n < 64; ++n) so[(half * 64 + n) * 64 + lane] = S[n];
    }
    if (h == 0) {
        float* co = P.out + O_SCONV + (size_t)(l * NB_S + b) * 2304;
        for (int idx = lane; idx < 2304; idx += 64) { const int rr = idx / 768, c = idx % 768; co[idx] = bf2f(PROJ[(size_t)(T_P + b * LEN_S + LEN_S - 3 + rr) * NPROJ + C_XBC + c]); }
    }
}

constexpr int N_P1 = 8 * 4 * (NS - 1), N_P1S5 = 8 * 2 * (NS - 1), N_SUB0 = 3 * N_P1 + N_P1S5 + 64 + 64;
constexpr int N_P2 = 8 * 4 * NS, N_P2S5 = 8 * 2 * NS, N_SUB1 = 3 * N_P2 + N_P2S5 + 128;
__device__ __forceinline__ void ssd_norm_block(const Ctx& P, int l, int pm) {
    const int tid_ = pg8::opaque_tid(), wave = tid_ >> 6, lane = tid_ & 63;
    bf16_t* MIX = (bf16_t*)(P.ws + W_MIX); const float* SSDSQ = (const float*)(P.ws + W_SSDSQ);
    const f32x4 nw = *(const f32x4*)(P.in(I_SSDN) + l * 256 + lane * 4);
    const int gq = lane >> 5;
    for (int rb = pm * 256 + wave * 32; rb < pm * 256 + wave * 32 + 32; rb += 4) {
        u32x2 w[4]; float ss[4];
#pragma unroll
        for (int u = 0; u < 4; ++u) { const int row = rb + u; ss[u] = SSDSQ[(size_t)row * 4 + 2 * gq] + SSDSQ[(size_t)row * 4 + 2 * gq + 1]; w[u] = *(const u32x2*)(MIX + (size_t)row * DM + 512 + lane * 4); }
#pragma unroll
        for (int u = 0; u < 4; ++u) { const int row = rb + u;
            const float rstd = rsqrtf(ss[u] * (1.0f / 128.0f) + 1e-6f);
            const float a = __uint_as_float(w[u].x << 16) * rstd * nw[0], b = __uint_as_float(w[u].x & 0xffff0000u) * rstd * nw[1];
            const float c = __uint_as_float(w[u].y << 16) * rstd * nw[2], d = __uint_as_float(w[u].y & 0xffff0000u) * rstd * nw[3];
            u32x2 o; o.x = cvt_pk_bf16(a, b); o.y = cvt_pk_bf16(c, d);
            *(u32x2*)(MIX + (size_t)row * DM + 512 + lane * 4) = o; }
    }
}
constexpr size_t W_DEP = 20480;
__device__ __forceinline__ void mixer_phase(const Ctx& P, int l, ldsp lds) {
    unsigned* ctr = (unsigned*)(P.ws + W_CTL) + l * 32;
    unsigned* dep = (unsigned*)(P.ws + W_CTL + W_DEP) + l * 512;
    LAS int* slot = (LAS int*)(lds + L_QSLOT);
    const int nitems = N_SUB0 + N_SUB1 + 136;
    unsigned* dg = dep + 4 * 64; unsigned* df = dep + 4 * 64 + 68;
    __syncthreads();
    if (threadIdx.x == 0) *slot = (int)atomicAdd(ctr, 1u);
    __syncthreads();
    int id = *slot;
    while (id < nitems) {
        int nxt = 0;
        if (threadIdx.x == 0) nxt = (int)atomicAdd(ctr, 1u);
        int type, a, b2 = 0, c = 1, seg = 0, tb = 0, te = LEN_S, init = 1, full = 1, store = 1;
        const int tailid = id - (N_SUB0 + N_SUB1);
        if (tailid >= 0) id = N_SUB0;
        const int sub = id >= N_SUB0 ? 1 : 0;
        const int qid = sub ? id - N_SUB0 : id;
        { const int nS5 = sub == 0 ? N_P1S5 : N_P2S5, nOth = sub == 0 ? 3 * N_P1 : 3 * N_P2; id = qid < nS5 ? nOth + qid : (qid < nS5 + nOth ? qid - nS5 : qid); }
        if (sub == 0) {
            if (id < 3 * N_P1) { type = id / N_P1; const int j = id % N_P1; a = j / (4 * (NS - 1)); b2 = (j / (NS - 1)) & 3; seg = j % (NS - 1); init = 0; full = 0; store = 2; tb = seg * SL; te = tb + SL; }
            else if (id < 3 * N_P1 + N_P1S5) { type = 3; const int j = id - 3 * N_P1; b2 = j / (2 * (NS - 1)); a = (j / (NS - 1)) & 1; seg = j % (NS - 1); init = 0; full = 0; store = 2; tb = seg * SL; te = tb + SL; }
            else { const int j = id - 3 * N_P1 - N_P1S5;
                if (j < 64) { type = 4; a = j; }
                else { type = 3; a = (j - 64) & 1; b2 = NB_P + ((j - 64) >> 1) * 4; c = 4; } }
        } else {
            if (id < 3 * N_P2) { type = id / N_P2; const int j = id % N_P2; a = j / (4 * NS); b2 = (j / NS) & 3; seg = j % NS; }
            else if (id < 3 * N_P2 + N_P2S5) { type = 3; const int j = id - 3 * N_P2; b2 = j / (2 * NS); a = (j / NS) & 1; seg = j % NS; }
            else { const int j = id - 3 * N_P2 - N_P2S5; type = 5 + j / 64; a = j % 64; }
            if (type < 4) { init = seg > 0 ? 2 : 0; full = 1; store = (seg == NS - 1) ? 1 : 0; tb = seg * SL; te = tb + SL; }
        }
        if (tailid >= 0) { type = tailid < 68 ? 7 : 8; a = tailid < 68 ? tailid : tailid - 68; seg = 0; store = 0; }
        int chain = (type == 3) ? (b2 & 7) * 2 + a : (a & 7) * 4 + b2;
        chain = __builtin_amdgcn_readfirstlane(chain);
        int ptile = -1;
        if (sub == 1 && type == 3) ptile = (b2 & 7) * 8 + seg;
        if (sub == 1 && type == 0) ptile = (a & 7) * 8 + seg;
        if (sub == 0 && type == 3 && store == 1) ptile = 64 + (b2 - NB_P) / 32;
        if (type == 4) ptile = 64 + a / 16;
        if (tailid >= 0) ptile = -1;
        ptile = __builtin_amdgcn_readfirstlane(ptile);
        type = __builtin_amdgcn_readfirstlane(type); a = __builtin_amdgcn_readfirstlane(a); b2 = __builtin_amdgcn_readfirstlane(b2); c = __builtin_amdgcn_readfirstlane(c);
        seg = __builtin_amdgcn_readfirstlane(seg); tb = __builtin_amdgcn_readfirstlane(tb); te = __builtin_amdgcn_readfirstlane(te);
        init = __builtin_amdgcn_readfirstlane(init); full = __builtin_amdgcn_readfirstlane(full); store = __builtin_amdgcn_readfirstlane(store);
        if (sub == 1 && type < 4 && seg > 0) {
            if (threadIdx.x == 0) {
                unsigned* d = dep + type * 64 + chain;
                while (__hip_atomic_load(d, __ATOMIC_RELAXED, __HIP_MEMORY_SCOPE_AGENT) < (unsigned)(NS - 1)) __builtin_amdgcn_s_sleep(2);
                __builtin_amdgcn_fence(__ATOMIC_ACQUIRE, "agent"); asm volatile("s_waitcnt vmcnt(0)" ::: "memory");
            }
            __syncthreads();
        }
        if (type >= 7) {
            if (threadIdx.x == 0) {
                unsigned* d = (type == 7 ? dg : df) + a; const unsigned need = a < 64 ? (type == 7 ? 2u : 4u) : 16u;
                while (__hip_atomic_load(d, __ATOMIC_RELAXED, __HIP_MEMORY_SCOPE_AGENT) < need) __builtin_amdgcn_s_sleep(2);
                __builtin_amdgcn_fence(__ATOMIC_ACQUIRE, "agent"); asm volatile("s_waitcnt vmcnt(0)" ::: "memory");
            }
            __syncthreads();
            if (type == 7) {
                const bf16_t* YP = (const bf16_t*)(P.ws + W_YPRE);
                pg8::Gemm g{YP, (const bf16_t*)(P.ws + W_WGLU) + (size_t)l * 256 * 256, TT, 256, 256}; pg8::OneUnit S1{a, 4};
                pg8::EpiGlu E{YP, (bf16_t*)(P.ws + W_MIX), P.in(I_GLUB) + l * 256};
                pg8::gemm_phase<pg8::EpiGlu, pg8::OneUnit>(lds, g, S1, E, nullptr);
            } else ssd_norm_block(P, l, a);
        }
        if (type >= 4 && type < 7) {
            const int tq = pg8::opaque_tid(), pair = a * 8 + (tq >> 6), sb = pair >> 2, sh = pair & 3, ln = tq & 63;
            if (type == 4) ssd_sample_wave(P, l, sb, sh, ln, (LAS float*)(lds + (tq >> 6) * 2048));
            else rh_sample_wave(P, l, sb, sh, ln, type == 5);
        }
#ifndef SK_SSD
        if (type == 0) ssd_item(P, l, a, b2, tb, te, init, full, store, seg, lds);
#endif
#ifdef DBL_SSD
        if (type == 0) { __syncthreads(); ssd_item(P, l, a, b2, tb, te, init, full, store, seg, lds); }
#endif
#ifndef SK_RET
        if (type == 1) ret_item(P, l, a, b2, tb, te, init, full, store, seg, lds);
#endif
#ifdef DBL_RET
        if (type == 1) { __syncthreads(); ret_item(P, l, a, b2, tb, te, init, full, store, seg, lds); }
#endif
#ifndef SK_HG
        if (type == 2) hgrn_item(P, l, a, b2, tb, te, init, full, store, seg, lds);
#endif
#ifdef DBL_HG
        if (type == 2) { __syncthreads(); hgrn_item(P, l, a, b2, tb, te, init, full, store, seg, lds); }
#endif
#ifndef SK_S5
        if (type == 3) s5_item(P, l, a, b2, c, tb, te, init, full, store, seg, lds);
#endif
#ifdef DBL_S5
        if (type == 3) { __syncthreads(); s5_item(P, l, a, b2, c, tb, te, init, full, store, seg, lds); }
#endif
        if (sub == 0 && store == 2) {
            asm volatile("s_waitcnt vmcnt(0)" ::: "memory");
            __syncthreads();
            if (threadIdx.x == 0) { __builtin_amdgcn_fence(__ATOMIC_RELEASE, "agent"); asm volatile("s_waitcnt vmcnt(0)" ::: "memory");
                __hip_atomic_fetch_add(dep + type * 64 + chain, 1u, __ATOMIC_RELAXED, __HIP_MEMORY_SCOPE_AGENT); }
        }
        if (ptile >= 0) {
            asm volatile("s_waitcnt vmcnt(0)" ::: "memory");
            __syncthreads();
            if (threadIdx.x == 0) { __builtin_amdgcn_fence(__ATOMIC_RELEASE, "agent"); asm volatile("s_waitcnt vmcnt(0)" ::: "memory");
                __hip_atomic_fetch_add(((type == 3) ? dg : df) + ptile, 1u, __ATOMIC_RELAXED, __HIP_MEMORY_SCOPE_AGENT); }
        }
        __syncthreads();
        if (threadIdx.x == 0) *slot = nxt;
        __syncthreads();
        id = *slot;
    }
}

__device__ __forceinline__ void ssd_norm_fix(const Ctx& P, int l) {
    const int tid_ = pg8::opaque_tid(), wave = tid_ >> 6, lane = tid_ & 63;
    bf16_t* MIX = (bf16_t*)(P.ws + W_MIX); const float* SSDSQ = (const float*)(P.ws + W_SSDSQ);
    const f32x4 nw = *(const f32x4*)(P.in(I_SSDN) + l * 256 + lane * 4);
    const int nskip = gridDim.x >= 136 ? 68 : 0;
    if ((int)blockIdx.x < nskip) return;
    const int gq = lane >> 5, stride = (gridDim.x - nskip) * 8;
    for (int rb = ((int)blockIdx.x - nskip) * 8 + wave; rb < TT; rb += 4 * stride) {
        u32x2 w[4]; float ss[4];
#pragma unroll
        for (int u = 0; u < 4; ++u) { const int row = rb + u * stride; ss[u] = 0.f; w[u] = (u32x2){0u, 0u};
            if (row < TT) { ss[u] = SSDSQ[(size_t)row * 4 + 2 * gq] + SSDSQ[(size_t)row * 4 + 2 * gq + 1]; w[u] = *(const u32x2*)(MIX + (size_t)row * DM + 512 + lane * 4); } }
#pragma unroll
        for (int u = 0; u < 4; ++u) { const int row = rb + u * stride;
            if (row < TT) {
                const float rstd = rsqrtf(ss[u] * (1.0f / 128.0f) + 1e-6f);
                const float a = __uint_as_float(w[u].x << 16) * rstd * nw[0], b = __uint_as_float(w[u].x & 0xffff0000u) * rstd * nw[1];
                const float c = __uint_as_float(w[u].y << 16) * rstd * nw[2], d = __uint_as_float(w[u].y & 0xffff0000u) * rstd * nw[3];
                u32x2 o; o.x = cvt_pk_bf16(a, b); o.y = cvt_pk_bf16(c, d);
                *(u32x2*)(MIX + (size_t)row * DM + 512 + lane * 4) = o;
            } }
    }
}
__device__ __forceinline__ void sample_fix(const Ctx& P, const float* slab, int nsplit) {
    const int tid_ = pg8::opaque_tid(), wave = tid_ >> 6, lane = tid_ & 63;
    bf16_t* XB = (bf16_t*)(P.ws + W_XB); float* SSQ = (float*)(P.ws + W_SSQ);
    for (int row = T_P + blockIdx.x * 8 + wave; row < TT; row += gridDim.x * 8) {
        float* xp = P.out + (size_t)row * DM; float s = 0.f;
#pragma unroll
        for (int j = 0; j < 4; ++j) {
            f32x4 v = *(const f32x4*)(xp + j * 256 + lane * 4);
            if (nsplit > 8) {
                const bf16_t* s16 = (const bf16_t*)slab;
                for (int k = 0; k < nsplit; ++k) { const u32x2 w2 = *(const u32x2*)(s16 + ((size_t)k * 1024 + (row - T_P)) * 1024 + j * 256 + lane * 4);
                    v[0] += __uint_as_float(w2.x << 16); v[1] += __uint_as_float(w2.x & 0xffff0000u); v[2] += __uint_as_float(w2.y << 16); v[3] += __uint_as_float(w2.y & 0xffff0000u); }
            } else
            for (int k = 0; k < nsplit; ++k) v += *(const f32x4*)(slab + ((size_t)k * 1024 + (row - T_P)) * 1024 + j * 256 + lane * 4);
            *(f32x4*)(xp + j * 256 + lane * 4) = v;
            s += (v[0] * v[0] + v[1] * v[1]) + (v[2] * v[2] + v[3] * v[3]);
            u32x2 w; w.x = cvt_pk_bf16(v[0], v[1]); w.y = cvt_pk_bf16(v[2], v[3]);
            *(u32x2*)(XB + (size_t)row * DM + j * 256 + lane * 4) = w;
        }
#pragma unroll
        for (int o = 32; o >= 1; o >>= 1) s += __shfl_xor(s, o);
        if (lane < 16) SSQ[(size_t)row * 16 + lane] = (lane == 0) ? s : 0.f;
    }
}
__device__ __forceinline__ void final_norm(const Ctx& P) {
    const int tid_ = pg8::opaque_tid(), wave = tid_ >> 6, lane = tid_ & 63;
    const float* SSQ = (const float*)(P.ws + W_SSQ); const float* nf = P.in(I_NFIN);
    f32x4 wv[4];
#pragma unroll
    for (int j = 0; j < 4; ++j) wv[j] = *(const f32x4*)(nf + j * 256 + lane * 4);
    const int stride = gridDim.x * 8;
    for (int rb = blockIdx.x * 8 + wave; rb < TT; rb += 4 * stride) {
        f32x4 v[4][4]; float sq[4];
#pragma unroll
        for (int u = 0; u < 4; ++u) { const int row = rb + u * stride;
            sq[u] = (row < TT && lane < 16) ? SSQ[(size_t)row * 16 + lane] : 0.f;
#pragma unroll
            for (int j = 0; j < 4; ++j) v[u][j] = (row < TT) ? *(const f32x4*)(P.out + (size_t)row * DM + j * 256 + lane * 4) : (f32x4){0.f, 0.f, 0.f, 0.f}; }
#pragma unroll
        for (int u = 0; u < 4; ++u) { const int row = rb + u * stride;
            float s = sq[u];
#pragma unroll
            for (int o = 8; o >= 1; o >>= 1) s += __shfl_xor(s, o);
            s = __shfl(s, 0);
            const float rstd = rsqrtf(s * (1.0f / 1024.0f) + 1e-6f);
            if (row < TT) {
#pragma unroll
                for (int j = 0; j < 4; ++j) *(f32x4*)(P.out + (size_t)row * DM + j * 256 + lane * 4) = v[u][j] * rstd * wv[j];
            } }
    }
}

__global__ void __launch_bounds__(512, 2) fwd_megakernel(Params P) {
    extern __shared__ __attribute__((aligned(16))) unsigned char lds_raw[];
    cg::grid_group grid = cg::this_grid();
    ldsp lds = (ldsp)lds_raw;
    const int G = gridDim.x, bid = blockIdx.x;
#define PHASE_PTRS unsigned char* ws = P.ws; asm volatile("" : "+s"(ws)); float* X = P.out; asm volatile("" : "+s"(X)); \
    bf16_t* XB = (bf16_t*)(ws + W_XB); bf16_t* MIX = (bf16_t*)(ws + W_MIX); bf16_t* PROJ = (bf16_t*)(ws + W_PROJ); bf16_t* HID = (bf16_t*)(ws + W_HID); bf16_t* YPRE = (bf16_t*)(ws + W_YPRE); float* SSQ = (float*)(ws + W_SSQ); \
    Ctx C; C.out = X; C.ws = ws; (void)XB; (void)MIX; (void)PROJ; (void)HID; (void)YPRE; (void)SSQ; (void)C

    if (threadIdx.x < 2) ((LAS unsigned*)(lds + L_BARST))[threadIdx.x] = 0u;
    __syncthreads();
    (void)xcd_barrier_post((unsigned*)(P.ws + W_BAR), (volatile LAS unsigned*)(lds + L_BARST));
#define XBAR() do { XcdBarrier xb_; xb_.bar = (unsigned*)(P.ws + W_BAR); xb_.x = xb_xcc_id(); xb_.st = (volatile LAS unsigned*)(lds + L_BARST); xcd_barrier(xb_); } while (0)
    phase0(P, lds);
    if (bid == 0) {
#pragma unroll
        for (int i = 0; i < N_IN; ++i) if ((int)threadIdx.x == i) ((const float**)(P.ws + W_TAB))[i] = P.in[i];
    }
    XBAR();
    grid.sync();

#pragma unroll 1
    for (int l = 0; l < 2; ++l) {
        {
            PHASE_PTRS;
            pg8::Gemm g{XB, (const bf16_t*)(ws + W_WIN) + (size_t)l * NPROJ * DM, TT, NPROJ, DM}; pg8::StaticOrder S; S.init(TT, NPROJ, G, bid);
            pg8::EpiScaleBf16<0> E{PROJ, NPROJ, SSQ};
            pg8::gemm_phase<pg8::EpiScaleBf16<0>, pg8::StaticOrder>(lds, g, S, E, nullptr);
        }
        XBAR();
        { PHASE_PTRS; mixer_phase(C, l, lds); }
        XBAR();
        {
            PHASE_PTRS;
            pg8::Gemm g{MIX, (const bf16_t*)(ws + W_WOUT) + (size_t)l * DM * DM, TT, DM, DM}; pg8::SplitOrder S; S.init(T_P, DM, G, bid, DM, 4);
            pg8::EpiRes E{l == 0 ? C.in(I_XP) : X, X + (size_t)T_P * DM, X, XB, SSQ, (float*)HID, 0};
            pg8::gemm_phase<pg8::EpiRes, pg8::SplitOrder>(lds, g, S, E, nullptr);
        }
        XBAR();
        { PHASE_PTRS; sample_fix(C, (const float*)HID, 4); }
        XBAR();
        {
            PHASE_PTRS;
            pg8::Gemm g{XB, (const bf16_t*)(ws + W_WUP) + (size_t)l * DFF * DM, TT, DFF, DM}; pg8::StaticOrder S; S.init(TT, DFF, G, bid);
            pg8::EpiScaleBf16<1> E{HID, DFF, SSQ};
#ifdef REP_UP
#pragma unroll 1
            for (int rep = 0; rep < 3; ++rep)
#endif
            pg8::gemm_phase<pg8::EpiScaleBf16<1>, pg8::StaticOrder>(lds, g, S, E, nullptr);
        }
        XBAR();
        {
            PHASE_PTRS;
            pg8::Gemm g{HID, (const bf16_t*)(ws + W_WDN) + (size_t)l * DM * DFF, TT, DM, DFF}; pg8::SplitOrder S; S.init(T_P, DM, G, bid, DFF, 16);
            pg8::EpiRes E{X, X + (size_t)T_P * DM, X, XB, SSQ, (float*)MIX, 1};
            pg8::gemm_phase<pg8::EpiRes, pg8::SplitOrder>(lds, g, S, E, nullptr);
        }
        XBAR();
        { PHASE_PTRS; sample_fix(C, (const float*)MIX, 16); }
        XBAR();
    }
    { PHASE_PTRS; final_norm(C); }
#undef PHASE_PTRS
}
}

extern "C" void kernel_launch(void* const* d_in, const int* in_sizes, int n_in, void* d_out, int out_size, void* d_ws, size_t ws_size, hipStream_t stream) {
    static int grid_blocks = 0;
    if (grid_blocks == 0) {
        if (n_in != mk::N_IN || (size_t)out_size != mk::O_END || ws_size < mk::W_END) {
            fprintf(stderr, "kernel_launch: unexpected shapes: n_in %d out %d ws %zu (need %zu)\n", n_in, out_size, ws_size, (size_t)mk::W_END); grid_blocks = -1; return; }
        int dev = 0, cus = 0, per_cu = 0;
        (void)hipGetDevice(&dev);
        (void)hipDeviceGetAttribute(&cus, hipDeviceAttributeMultiprocessorCount, dev);
        (void)hipFuncSetAttribute((const void*)mk::fwd_megakernel, hipFuncAttributeMaxDynamicSharedMemorySize, mk::LDS_BYTES);
        (void)hipOccupancyMaxActiveBlocksPerMultiprocessor(&per_cu, (const void*)mk::fwd_megakernel, 512, mk::LDS_BYTES);
        if (per_cu < 1) { fprintf(stderr, "kernel_launch: occupancy query says 0 blocks per CU\n"); per_cu = 1; }
        if (per_cu > 1) per_cu = 1;
        grid_blocks = cus * per_cu;
    }
    if (grid_blocks < 0) return;
    (void)hipMemsetAsync((char*)d_ws + mk::W_CTL, 0, 32768, stream);
    mk::Params p{};
    for (int i = 0; i < mk::N_IN; ++i) p.in[i] = (const float*)d_in[i];
    p.out = (float*)d_out; p.ws = (unsigned char*)d_ws;
    void* args[] = {&p};
    hipError_t e = hipLaunchCooperativeKernel((const void*)mk::fwd_megakernel, dim3(grid_blocks), dim3(512), args, mk::LDS_BYTES, stream);
    if (e != hipSuccess) fprintf(stderr, "cooperative launch failed: %s (grid %d)\n", hipGetErrorString(e), grid_blocks);
}
```

```cpp
#include <hip/hip_cooperative_groups.h>
#include <cstdio>
namespace cg = cooperative_groups;
#include <hip/hip_runtime.h>
namespace pg8 {
#define PG8_LAS __attribute__((address_space(3)))
typedef unsigned short bf16_t;
typedef short bf16x8 __attribute__((ext_vector_type(8)));
typedef float f32x4 __attribute__((ext_vector_type(4)));
typedef unsigned u32x4 __attribute__((ext_vector_type(4)));
constexpr int BM = 256, BK = 64, HALF = 128, HTB = HALF * BK * 2  , STAGE_BYTES = 8 * HTB, NXCD = 8, WGM = 8;

__host__ __device__ __forceinline__ int lds_byte(int r, int c) { const int st = (r >> 4) * 2 + (c >> 5), rr = r & 15, cc = c & 31, ob = rr * 64 + cc * 2; return st * 1024 + (ob ^ (((ob >> 9) & 1) << 5)); }
__host__ __device__ __forceinline__ void stage_rc(int b, int& R, int& C) { const int st = b / 1024, sb = b % 1024, swz = sb ^ (((sb >> 9) & 1) << 5); R = (st >> 1) * 16 + swz / 64; C = (st & 1) * 32 + (swz % 64) / 2; }
__host__ __device__ __forceinline__ int perm32(int rho) { const int n = rho >> 4, i = rho & 15; return 8 * (i >> 2) + 4 * n + (i & 3); }

struct Unit { int pm, pn, ki; __host__ __device__ int kt0() const { return ki & 0xff; } __host__ __device__ int nkt() const { return (ki >> 8) & 0xff; } __host__ __device__ int split() const { return ki >> 16; } };
struct Gemm { const bf16_t* A; const bf16_t* Bt; int M, N, K; };

struct StaticOrder {
    int nM, nN, nwg, G, c, nkt;
    __host__ __device__ void init(int M, int N, int G_, int c_, int K = 1024) { nM = M / BM; nN = N / BM; nwg = nM * nN; G = G_; c = c_; nkt = K / BK; }
    __host__ __device__ bool next(int i, Unit& u) const {
        const long L = (long)i * G + c; if (L >= nwg) return false;
        int wgid = (int)L; { const int q = nwg / NXCD, r = nwg % NXCD, xcd = wgid % NXCD, off = wgid / NXCD; wgid = (xcd < r ? xcd * (q + 1) : r * (q + 1) + (xcd - r) * q) + off; }
        const int nig = WGM * nN, gid = wgid / nig, fm = gid * WGM, gsz = (nM - fm) < WGM ? (nM - fm) : WGM;
        u.pm = fm + ((wgid % nig) % gsz); u.pn = (wgid % nig) / gsz; u.ki = nkt << 8; return true;
    }
    __device__ __forceinline__ void a_ready(const Unit&) const {}
    __device__ __forceinline__ void done(const Unit&) const {}
};
struct SplitOrder {
    StaticOrder P; int nP, nS, SPLIT, nkt_s, nNn;
    __host__ __device__ void init(int Mp, int N, int G_, int c_, int K, int SPLIT_) { P.init(Mp, N, G_, c_, K); nP = P.nwg; nNn = N / BM; SPLIT = SPLIT_; nS = 4 * nNn * SPLIT; nkt_s = K / BK / SPLIT; }
    __host__ __device__ bool next(int i, Unit& u) const {
        const long L = (long)i * P.G + P.c;
        if (L < nP) return P.next(i, u);
        const int s = (int)(L - nP); if (s >= nS) return false;
        const int tile = s / SPLIT, ks = s % SPLIT;
        u.pm = 64 + tile / nNn; u.pn = tile % nNn; u.ki = (ks * nkt_s) | (nkt_s << 8) | (1 << 16); return true;
    }
    __device__ __forceinline__ void a_ready(const Unit&) const {}
    __device__ __forceinline__ void done(const Unit&) const {}
};
struct OneUnit {
    int pm, nkt;
    __host__ __device__ bool next(int i, Unit& u) const { if (i) return false; u.pm = pm; u.pn = 0; u.ki = nkt << 8; return true; }
    __device__ __forceinline__ void a_ready(const Unit&) const {}
    __device__ __forceinline__ void done(const Unit&) const {}
};
typedef __bf16 bf16v2_t __attribute__((ext_vector_type(2)));
__device__ __forceinline__ unsigned cvt_pk_bf16(float lo, float hi) { bf16v2_t v; v.x = (__bf16)lo; v.y = (__bf16)hi; return __builtin_bit_cast(unsigned, v); }
typedef float f32x2 __attribute__((ext_vector_type(2)));
__device__ __forceinline__ int opaque_tid() { int t = (int)threadIdx.x; asm volatile("" : "+v"(t)); return t; }
typedef unsigned u32x2 __attribute__((ext_vector_type(2)));
constexpr int TP_ROWS = 16384;
template <int ACT> struct EpiScaleBf16 {
    static constexpr bool PERM = true, AFTER_DRAIN = false;
    bf16_t* O; int ldc; const float* ssq;
    __device__ __forceinline__ void operator()(const f32x4 (&acc)[2][2][4][2], const Unit& u, int wr, int wc, int fr, int fq) const {
        const int row0 = u.pm * BM + wr * 64 + fr, col0 = u.pn * BM + wc * 32 + 8 * fq;
#pragma unroll
        for (int ai = 0; ai < 2; ++ai)
#pragma unroll
            for (int m = 0; m < 4; ++m) {
                const int row = row0 + ai * HALF + m * 16;
                const f32x4* sp = (const f32x4*)(ssq + (size_t)row * 16);
                const f32x4 s0 = sp[0], s1 = sp[1], s2 = sp[2], s3 = sp[3];
                const float ss = ((s0[0] + s0[1]) + (s0[2] + s0[3])) + ((s1[0] + s1[1]) + (s1[2] + s1[3])) + ((s2[0] + s2[1]) + (s2[2] + s2[3])) + ((s3[0] + s3[1]) + (s3[2] + s3[3]));
                const float rstd = __builtin_amdgcn_rsqf(ss * (1.0f / 1024.0f) + 1e-6f);
                bf16_t* rowp = O + (size_t)row * ldc + col0;
#pragma unroll
                for (int bj = 0; bj < 2; ++bj) {
                    f32x4 v0 = acc[ai][bj][m][0] * rstd, v1 = acc[ai][bj][m][1] * rstd;
                    if (ACT == 1) {
#pragma unroll
                        for (int j = 0; j < 4; ++j) { const float a = fmaxf(v0[j], 0.f), b = fmaxf(v1[j], 0.f); v0[j] = a * a; v1[j] = b * b; }
                    }
                    u32x4 w; w.x = cvt_pk_bf16(v0[0], v0[1]); w.y = cvt_pk_bf16(v0[2], v0[3]); w.z = cvt_pk_bf16(v1[0], v1[1]); w.w = cvt_pk_bf16(v1[2], v1[3]);
                    *(u32x4*)(rowp + bj * HALF) = w;
                }
            }
    }
};
struct EpiRes {
    static constexpr bool PERM = false, AFTER_DRAIN = false;
    const float* base0; const float* base1; float* X; bf16_t* XB; float* ssq; float* slab; int slab16;
    __device__ __forceinline__ void operator()(const f32x4 (&acc)[2][2][4][2], const Unit& u, int wr, int wc, int fr, int fq) const {
        const int row0 = u.pm * BM + wr * 64 + fr, col0 = u.pn * BM + wc * 32 + 4 * fq;
        if (u.split()) {
            const int ks = u.kt0() / u.nkt();
#pragma unroll
            for (int ai = 0; ai < 2; ++ai)
#pragma unroll
                for (int m = 0; m < 4; ++m) {
                    const size_t so_ = ((size_t)ks * 1024 + (size_t)(row0 + ai * HALF + m * 16 - TP_ROWS)) * 1024 + col0;
                    if (slab16) {
                        bf16_t* sp = (bf16_t*)slab + so_;
#pragma unroll
                        for (int bj = 0; bj < 2; ++bj)
#pragma unroll
                            for (int n = 0; n < 2; ++n) { const f32x4 a = acc[ai][bj][m][n]; u32x2 w; w.x = cvt_pk_bf16(a[0], a[1]); w.y = cvt_pk_bf16(a[2], a[3]); *(u32x2*)(sp + bj * HALF + n * 16) = w; }
                    } else {
                        float* sp = slab + so_;
#pragma unroll
                        for (int bj = 0; bj < 2; ++bj)
#pragma unroll
                            for (int n = 0; n < 2; ++n) *(f32x4*)(sp + bj * HALF + n * 16) = acc[ai][bj][m][n];
                    }
                }
            return;
        }
#pragma unroll
        for (int ai = 0; ai < 2; ++ai)
#pragma unroll
            for (int m = 0; m < 4; ++m) {
                const int row = row0 + ai * HALF + m * 16;
                const float* bp = (row < TP_ROWS) ? (base0 + (size_t)row * 1024) : (base1 + (size_t)(row - TP_ROWS) * 1024);
                float s = 0.f;
#pragma unroll
                for (int bj = 0; bj < 2; ++bj)
#pragma unroll
                    for (int n = 0; n < 2; ++n) {
                        const int c = col0 + bj * HALF + n * 16;
                        const f32x4 b = *(const f32x4*)(bp + c);
                        const f32x4 v = b + acc[ai][bj][m][n];
                        *(f32x4*)(X + (size_t)row * 1024 + c) = v;
                        u32x2 w; w.x = cvt_pk_bf16(v[0], v[1]); w.y = cvt_pk_bf16(v[2], v[3]);
                        *(u32x2*)(XB + (size_t)row * 1024 + c) = w;
                        s += (v[0] * v[0] + v[1] * v[1]) + (v[2] * v[2] + v[3] * v[3]);
                    }
                s += __shfl_xor(s, 16); s += __shfl_xor(s, 32);
                if (fq == 0) ssq[(size_t)row * 16 + u.pn * 4 + wc] = s;
                asm volatile("" ::: "memory");
            }
    }
};
struct EpiGlu {
    static constexpr bool PERM = true, AFTER_DRAIN = false;
    const bf16_t* Y; bf16_t* MIX; const float* bias;
    __device__ __forceinline__ void operator()(const f32x4 (&acc)[2][2][4][2], const Unit& u, int wr, int wc, int fr, int fq) const {
        const int row0 = u.pm * BM + wr * 64 + fr, col0 = u.pn * BM + wc * 32 + 8 * fq;
#pragma unroll
        for (int ai = 0; ai < 2; ++ai)
#pragma unroll
            for (int m = 0; m < 4; ++m) {
                const int row = row0 + ai * HALF + m * 16;
#pragma unroll
                for (int bj = 0; bj < 2; ++bj) {
                    const int c = col0 + bj * HALF;
                    const u32x4 yw = *(const u32x4*)(Y + (size_t)row * 256 + c);
                    const f32x4 b0 = *(const f32x4*)(bias + c), b1 = *(const f32x4*)(bias + c + 4);
                    const f32x4 a0 = acc[ai][bj][m][0] + b0, a1 = acc[ai][bj][m][1] + b1;
                    float y[8], o[8];
                    y[0] = __uint_as_float(yw.x << 16); y[1] = __uint_as_float(yw.x & 0xffff0000u); y[2] = __uint_as_float(yw.y << 16); y[3] = __uint_as_float(yw.y & 0xffff0000u);
                    y[4] = __uint_as_float(yw.z << 16); y[5] = __uint_as_float(yw.z & 0xffff0000u); y[6] = __uint_as_float(yw.w << 16); y[7] = __uint_as_float(yw.w & 0xffff0000u);
#pragma unroll
                    for (int j = 0; j < 4; ++j) { o[j] = y[j] / (1.0f + __expf(-a0[j])); o[4 + j] = y[4 + j] / (1.0f + __expf(-a1[j])); }
                    u32x4 w; w.x = cvt_pk_bf16(o[0], o[1]); w.y = cvt_pk_bf16(o[2], o[3]); w.z = cvt_pk_bf16(o[4], o[5]); w.w = cvt_pk_bf16(o[6], o[7]);
                    *(u32x4*)(MIX + (size_t)row * 1024 + 768 + c) = w;
                    asm volatile("" ::: "memory");
                }
            }
    }
};
template <class Epi, class Sched, bool STAMP = false>
__device__ __forceinline__ void gemm_phase(PG8_LAS unsigned char* lds, const Gemm g, const Sched& S, const Epi& E, unsigned long long* stamps) {
    const int tid = opaque_tid(), wid = __builtin_amdgcn_readfirstlane(tid >> 6), lane = tid & 63, wr = wid >> 2, wc = wid & 3, fr = lane & 15, fq = lane >> 4;
    int K_ = g.K; asm volatile("" : "+s"(K_)); const int K = K_, nt = K / BK;
    int ts_lo = 0, ts_hi = 0, nts = 0; const unsigned long long rt_entry = STAMP ? (unsigned long long)wall_clock64() : 0ull;
#define PG8_STAMP() do { if (STAMP && wid == 0 && nts < 64) { const unsigned long long _c = (unsigned long long)clock64(); \
        ts_lo = (lane == nts) ? (int)(unsigned)_c : ts_lo; ts_hi = (lane == nts) ? (int)(unsigned)(_c >> 32) : ts_hi; ++nts; } } while (0)
    PG8_STAMP();
    unsigned voffA[2], voffB[2];
#pragma unroll
    for (int i = 0; i < 2; ++i) { int R, C; stage_rc(tid * 16 + i * 8192, R, C); const int Rb = Epi::PERM ? ((R & ~31) + perm32(R & 31)) : R;
        voffA[i] = (unsigned)(R * K + C) * 2u; voffB[i] = (unsigned)(Rb * K + C) * 2u; }
    const size_t kstep = (size_t)(BK * 2);
    const size_t hstep = (size_t)HALF * K * 2;
    const size_t tstep = 2 * hstep;
    const unsigned ldsw = (unsigned)wid * 1024u;
    const int aoff = lds_byte(wr * 64 + fr, fq * 8), boff = lds_byte(wc * 32 + fr, fq * 8);
#define PG8_SA(b, h) (((b) * 2 + (h)) * HTB)
#define PG8_SB(b, h) ((4 + (b) * 2 + (h)) * HTB)
#define PG8_STAGE(bufoff, gbase, voff) do { _Pragma("unroll") for (int _i = 0; _i < 2; ++_i) \
        __builtin_amdgcn_global_load_lds((const unsigned*)((const char*)(gbase) + (voff)[_i]), (PG8_LAS unsigned*)(lds + (bufoff) + ldsw + _i * 8192), 16, 0, 0); } while (0)
#define PG8_LDA(dst, b, h) do { _Pragma("unroll") for (int m = 0; m < 4; ++m) _Pragma("unroll") for (int k = 0; k < 2; ++k) dst[m][k] = *(const PG8_LAS bf16x8*)(lds + PG8_SA(b, h) + aoff + m * 2048 + k * 1024); } while (0)
#define PG8_LDB(dst, b, h) do { _Pragma("unroll") for (int n = 0; n < 2; ++n) _Pragma("unroll") for (int k = 0; k < 2; ++k) dst[n][k] = *(const PG8_LAS bf16x8*)(lds + PG8_SB(b, h) + boff + n * 2048 + k * 1024); } while (0)
#define PG8_MMA(ai, bj, At, Bt) do { __builtin_amdgcn_s_setprio(1); _Pragma("unroll") for (int m = 0; m < 4; ++m) _Pragma("unroll") for (int n = 0; n < 2; ++n) _Pragma("unroll") for (int k = 0; k < 2; ++k) \
        acc[ai][bj][m][n] = __builtin_amdgcn_mfma_f32_16x16x32_bf16(Bt[n][k], At[m][k], acc[ai][bj][m][n], 0, 0, 0); __builtin_amdgcn_s_setprio(0); } while (0)
#define PG8_WAIT_V(n) asm volatile("s_waitcnt vmcnt(" #n ")" ::: "memory")
#define PG8_WAIT_L(n) asm volatile("s_waitcnt lgkmcnt(" #n ")" ::: "memory")
#define PG8_BAR __builtin_amdgcn_s_barrier()
#define PG8_SCHED __builtin_amdgcn_sched_barrier(0)
    Unit cur, nxt; int ui = 0;
    if (!S.next(0, cur)) return;
    f32x4 acc[2][2][4][2];
#pragma unroll
    for (int a = 0; a < 2; ++a)
#pragma unroll
        for (int b = 0; b < 2; ++b)
#pragma unroll
            for (int m = 0; m < 4; ++m)
#pragma unroll
                for (int n = 0; n < 2; ++n) acc[a][b][m][n] = (f32x4){0.f, 0.f, 0.f, 0.f};
    bf16x8 At[4][2], B0[2][2], B1[2][2];
    const char* cA = (const char*)g.A + (size_t)cur.pm * tstep + (size_t)cur.kt0() * kstep; const char* cB = (const char*)g.Bt + (size_t)cur.pn * tstep + (size_t)cur.kt0() * kstep;
    S.a_ready(cur);
    PG8_STAGE(PG8_SB(0, 0), cB, voffB); PG8_STAGE(PG8_SA(0, 0), cA, voffA); PG8_STAGE(PG8_SB(0, 1), cB + hstep, voffB); PG8_STAGE(PG8_SA(0, 1), cA + hstep, voffA);
    if (wr == 1) PG8_BAR;
    PG8_WAIT_V(4); PG8_BAR;
    PG8_STAGE(PG8_SB(1, 0), cB + kstep, voffB); PG8_STAGE(PG8_SA(1, 0), cA + kstep, voffA); PG8_STAGE(PG8_SB(1, 1), cB + hstep + kstep, voffB);
    PG8_WAIT_V(6); PG8_BAR;
    PG8_STAMP();
    for (;;) {
        const bool has_next = S.next(ui + 1, nxt);
        const char* nA = has_next ? (const char*)g.A + (size_t)nxt.pm * tstep + (size_t)nxt.kt0() * kstep : cA; const char* nB = has_next ? (const char*)g.Bt + (size_t)nxt.pn * tstep + (size_t)nxt.kt0() * kstep : cB;
        const int cnt = cur.nkt();
        for (int t = 0; t < cnt; t += 2) {
            const bool last = (t == cnt - 2);
            const char* a1 = cA + (size_t)(t + 1) * kstep;
            const char* a2 = last ? nA : cA + (size_t)(t + 2) * kstep; const char* b2 = last ? nB : cB + (size_t)(t + 2) * kstep;
            const char* a3 = a2 + kstep; const char* b3 = b2 + kstep;
            if (last && has_next) S.a_ready(nxt);
            PG8_LDB(B0, 0, 0); PG8_SCHED; PG8_LDA(At, 0, 0); PG8_STAGE(PG8_SA(1, 1), a1 + hstep, voffA);
            PG8_WAIT_L(8); PG8_BAR; PG8_WAIT_L(0); PG8_MMA(0, 0, At, B0); PG8_BAR; PG8_SCHED;
            PG8_LDB(B1, 0, 1); PG8_STAGE(PG8_SB(0, 0), b2, voffB);
            PG8_BAR; PG8_WAIT_L(0); PG8_MMA(0, 1, At, B1); PG8_BAR;
            PG8_LDA(At, 0, 1); PG8_STAGE(PG8_SA(0, 0), a2, voffA);
            PG8_BAR; PG8_WAIT_L(0); PG8_MMA(1, 0, At, B0); PG8_BAR; PG8_SCHED;
            PG8_STAGE(PG8_SB(0, 1), b2 + hstep, voffB);
            PG8_WAIT_V(6); PG8_BAR; PG8_MMA(1, 1, At, B1); PG8_BAR;
            PG8_LDB(B0, 1, 0); PG8_SCHED; PG8_LDA(At, 1, 0); PG8_STAGE(PG8_SA(0, 1), a2 + hstep, voffA);
            PG8_WAIT_L(8); PG8_BAR; PG8_WAIT_L(0); PG8_MMA(0, 0, At, B0); PG8_BAR; PG8_SCHED;
            PG8_LDB(B1, 1, 1); PG8_STAGE(PG8_SB(1, 0), b3, voffB);
            PG8_BAR; PG8_WAIT_L(0); PG8_MMA(0, 1, At, B1); PG8_BAR;
            PG8_LDA(At, 1, 1); PG8_STAGE(PG8_SA(1, 0), a3, voffA);
            PG8_BAR; PG8_WAIT_L(0); PG8_MMA(1, 0, At, B0); PG8_BAR; PG8_SCHED;
            PG8_STAGE(PG8_SB(1, 1), b3 + hstep, voffB);
            PG8_WAIT_V(6); PG8_BAR; PG8_MMA(1, 1, At, B1); PG8_BAR;
        }
        PG8_STAMP();
        if constexpr (!Epi::AFTER_DRAIN) { E(acc, cur, wr, wc, fr, fq); S.done(cur); }
        PG8_STAMP();
        if (!has_next) break;
#pragma unroll
        for (int a = 0; a < 2; ++a)
#pragma unroll
            for (int b = 0; b < 2; ++b)
#pragma unroll
                for (int m = 0; m < 4; ++m)
#pragma unroll
                    for (int n = 0; n < 2; ++n) acc[a][b][m][n] = (f32x4){0.f, 0.f, 0.f, 0.f};
        cur = nxt; cA = nA; cB = nB; ++ui;
    }
    PG8_WAIT_V(0);
    if (wr == 0) PG8_BAR;
    PG8_BAR;
    if constexpr (Epi::AFTER_DRAIN) { E.fused(acc, cur, wr, wc, fr, fq, lds, wid, lane); S.done(cur); }
    PG8_STAMP();
    if (STAMP && wid == 0) { stamps[lane] = lane < nts ? (((unsigned long long)(unsigned)ts_hi << 32) | (unsigned)ts_lo) : 0ull;
        if (lane == 62) stamps[62] = rt_entry; if (lane == 63) stamps[63] = (unsigned long long)wall_clock64(); }
#undef PG8_STAMP
#undef PG8_SA
#undef PG8_SB
#undef PG8_STAGE
#undef PG8_LDA
#undef PG8_LDB
#undef PG8_MMA
#undef PG8_WAIT_V
#undef PG8_WAIT_L
#undef PG8_BAR
#undef PG8_SCHED
}
}

namespace mk {
using pg8::bf16_t; using pg8::bf16x8; using pg8::f32x4; using pg8::u32x4; using pg8::u32x2; using pg8::cvt_pk_bf16;
#define LAS PG8_LAS
typedef LAS unsigned char* ldsp;
#define XB_TMO      128
#define XB_XCNT(j)  (256  + 64 * (j))
#define XB_XSUB(j)  (1280 + 64 * (j))
#define XB_XGEN(j)  (2304 + 64 * (j))
#define XB_TOP      3328
#define XB_TOPGEN   3392
#define XCD_BAR_WORDS 3456
#define XB_SPIN_CAP (1u << 18)
__device__ __forceinline__ unsigned xb_ld(unsigned* p)              { return __hip_atomic_load(p, __ATOMIC_RELAXED, __HIP_MEMORY_SCOPE_AGENT); }
__device__ __forceinline__ unsigned xb_add(unsigned* p, unsigned v) { return __hip_atomic_fetch_add(p, v, __ATOMIC_RELAXED, __HIP_MEMORY_SCOPE_AGENT); }
__device__ __forceinline__ unsigned xb_xcc_id() { return (unsigned)__builtin_amdgcn_s_getreg((3 << 11) | 20) & 0xFu; }
#define XB_SPIN(cond, bar) do { unsigned _sp = 0; while (cond) { __builtin_amdgcn_s_sleep(1); \
    if ((++_sp & 255u) == 0u) { if (xb_ld(&(bar)[XB_TMO])) break; if (_sp > XB_SPIN_CAP) { atomicAdd(&(bar)[XB_TMO], 1u); break; } } } } while (0)

struct XcdBarrier {
    unsigned* bar; unsigned x;
    volatile LAS unsigned* st;
};

__device__ __forceinline__ XcdBarrier xcd_barrier_post(unsigned* bar, volatile LAS unsigned* st) {
    XcdBarrier b; b.bar = bar; b.x = xb_xcc_id(); b.st = st;
    if (threadIdx.x == 0) (void)xb_add(&bar[XB_XCNT(b.x)], 1u);
    return b;
}
__device__ __forceinline__ void xcd_barrier_complete(unsigned* bar, unsigned x, unsigned& nloc, unsigned& nx) {
    const unsigned G = gridDim.x * gridDim.y * gridDim.z;
    unsigned sum, cnt, mine, sp = 0u;
    for (;;) {
        sum = 0u; cnt = 0u; mine = 0u;
#pragma unroll
        for (unsigned j = 0; j < 16; ++j) { const unsigned c = xb_ld(&bar[XB_XCNT(j)]); sum += c; cnt += (c > 0u) ? 1u : 0u; mine = (j == x) ? c : mine; }
        if (sum == G) break;
        __builtin_amdgcn_s_sleep(1);
        if ((++sp & 255u) == 0u) { if (xb_ld(&bar[XB_TMO])) break; if (sp > XB_SPIN_CAP) { atomicAdd(&bar[XB_TMO], 1u); break; } }
    }
    nloc = mine > 0u ? mine : 1u; nx = cnt > 0u ? cnt : 1u;
}

__device__ __forceinline__ void xcd_barrier(const XcdBarrier& b) {
    asm volatile("s_waitcnt vmcnt(0)" ::: "memory");
    __syncthreads();
    if (threadIdx.x == 0) {
        unsigned* bar = b.bar;
        __builtin_amdgcn_s_waitcnt(0);
        unsigned nloc = b.st[0], nx = b.st[1];
        if (nloc == 0u) { xcd_barrier_complete(bar, b.x, nloc, nx); b.st[0] = nloc; b.st[1] = nx; }
        const unsigned old = xb_add(&bar[XB_XSUB(b.x)], 1u);
        const unsigned gen = old / nloc;
        if (old + 1u == (gen + 1u) * nloc) {
            __builtin_amdgcn_fence(__ATOMIC_RELEASE, "agent");
            asm volatile("s_waitcnt vmcnt(0)" ::: "memory");
            const unsigned og = xb_add(&bar[XB_TOP], 1u);
            const unsigned tg = og / nx;
            if (og + 1u == (tg + 1u) * nx) xb_add(&bar[XB_TOPGEN], 1u);
            else XB_SPIN(xb_ld(&bar[XB_TOPGEN]) == tg, bar);
            __builtin_amdgcn_fence(__ATOMIC_ACQUIRE, "agent");
            xb_add(&bar[XB_XGEN(b.x)], 1u);
            asm volatile("s_waitcnt vmcnt(0)" ::: "memory");
        } else {
            XB_SPIN(xb_ld(&bar[XB_XGEN(b.x)]) == gen, bar);
            __builtin_amdgcn_fence(__ATOMIC_ACQUIRE, "agent");
            asm volatile("s_waitcnt vmcnt(0)" ::: "memory");
        }
    }
    __syncthreads();
}

constexpr int T_P = 16384, T_S = 1024, TT = 17408, DM = 1024, NPROJ = 3584, DFF = 4096, INC = 3332;
constexpr int LEN_P = 2048, LEN_S = 8, NB_P = 8, NB_S = 128;
constexpr int LDS_BYTES = 138240, L_BARST = 131072;
constexpr int C_RQ = 0, C_RK = 256, C_RV = 512, C_RG = 768, C_HQ = 1024, C_HF = 1280, C_HI = 1536, C_HG = 1792, C_SZ = 2048, C_XBC = 2304, C_U = 3072, C_DT = 3328;
enum { I_XP = 0, I_XS, I_SRET, I_SHG, I_SSSD, I_SCONV, I_S5RE, I_S5IM, I_NMIX, I_WIN, I_WOUT, I_HGLB, I_CONVW, I_CONVB, I_DTB, I_ALOG, I_SSDD, I_SSDN,
       I_S5AR, I_S5AI, I_S5DT, I_S5BR, I_S5BI, I_S5CR, I_S5CI, I_S5D, I_GLUW, I_GLUB, I_NMLP, I_WUP, I_WDOWN, I_NFIN, N_IN };
constexpr size_t O_YP = 0, O_YS = 16777216, O_PRET = O_YS + 1048576, O_PHG = O_PRET + 262144, O_PSSD = O_PHG + 262144, O_PCONV = O_PSSD + 524288, O_PS5R = O_PCONV + 36864, O_PS5I = O_PS5R + 16384,
                 O_SRET = O_PS5I + 16384, O_SHG = O_SRET + 4194304, O_SSSD = O_SHG + 4194304, O_SCONV = O_SSSD + 8388608, O_SS5R = O_SCONV + 589824, O_SS5I = O_SS5R + 262144, O_END = O_SS5I + 262144;
constexpr size_t W_CTL = 0, W_BAR = 4096, W_WIN = 32768, W_WOUT = W_WIN + (size_t)2 * NPROJ * DM * 2, W_WUP = W_WOUT + (size_t)2 * DM * DM * 2, W_WDN = W_WUP + (size_t)2 * DFF * DM * 2, W_WGLU = W_WDN + (size_t)2 * DM * DFF * 2,
                 W_XB = W_WGLU + (size_t)2 * 256 * 256 * 2, W_MIX = W_XB + (size_t)TT * DM * 2, W_SSQ = W_MIX + (size_t)TT * DM * 2, W_SSDSQ = W_SSQ + (size_t)TT * 16 * 4, W_HID = W_SSDSQ + (size_t)TT * 4 * 4,
                 W_END = W_HID + (size_t)TT * DFF * 2;
constexpr size_t W_PROJ = W_HID;
constexpr size_t W_YPRE = W_HID + (size_t)TT * NPROJ * 2;
static_assert(W_YPRE + (size_t)TT * 256 * 2 <= W_END, "ypre fits");
static_assert(W_END <= 268435456ull, "workspace fits 256 MiB");

struct Params { const float* in[N_IN]; float* out; unsigned char* ws; };
constexpr size_t W_TAB = 2048;
struct Ctx { float* out; unsigned char* ws; __device__ __forceinline__ const float* in(int i) const { return ((const float* const*)(ws + W_TAB))[i]; } };

__device__ __forceinline__ float bf2f(unsigned short b) { return __uint_as_float(((unsigned)b) << 16); }
__device__ __forceinline__ unsigned short f2bf(float f) { return __builtin_bit_cast(unsigned short, (__bf16)f); }
__device__ __forceinline__ float sigmoidf_(float x) { return 1.0f / (1.0f + __expf(-x)); }
__device__ __forceinline__ float siluf_(float x) { return x / (1.0f + __expf(-x)); }
__device__ __forceinline__ void unpack8(const u32x4 w, float (&f)[8]) {
    f[0] = __uint_as_float(w.x << 16); f[1] = __uint_as_float(w.x & 0xffff0000u); f[2] = __uint_as_float(w.y << 16); f[3] = __uint_as_float(w.y & 0xffff0000u);
    f[4] = __uint_as_float(w.z << 16); f[5] = __uint_as_float(w.z & 0xffff0000u); f[6] = __uint_as_float(w.w << 16); f[7] = __uint_as_float(w.w & 0xffff0000u);
}
__device__ __forceinline__ u32x4 pack8(const float (&f)[8]) { u32x4 w; w.x = cvt_pk_bf16(f[0], f[1]); w.y = cvt_pk_bf16(f[2], f[3]); w.z = cvt_pk_bf16(f[4], f[5]); w.w = cvt_pk_bf16(f[6], f[7]); return w; }

template <int MODE>
__device__ __forceinline__ void convert_wt(const float* src, int ldsrc, bf16_t* dst, int K, int N, const float* kscale, ldsp lds, int vb, int nvb) {
    LAS float* tile = (LAS float*)lds;
    const int tid = pg8::opaque_tid(), nkt = K / 64, ntile = nkt * (N / 256);
    for (int tl = vb; tl < ntile; tl += nvb) {
        const int k0 = (tl % nkt) * 64, n0 = (tl / nkt) * 256;
#pragma unroll
        for (int i = 0; i < 8; ++i) {
            const int idx = tid + i * 512, kk = idx >> 6, n = n0 + (idx & 63) * 4;
            int sc = n;
            if (MODE == 1) sc = (n < 3072) ? n : (n < 3328 ? n + 4 : (n < 3332 ? n - 256 : -1));
            f32x4 v = {0.f, 0.f, 0.f, 0.f};
            if (sc >= 0) { v = *(const f32x4*)(src + (size_t)(k0 + kk) * ldsrc + sc); if (kscale) v = v * kscale[k0 + kk]; }
            *(LAS f32x4*)(tile + kk * 260 + (idx & 63) * 4) = v;
        }
        __syncthreads();
#pragma unroll
        for (int i = 0; i < 4; ++i) {
            const int idx = tid + i * 512, nl = idx >> 3, k8 = (idx & 7) * 8;
            float f[8];
#pragma unroll
            for (int j = 0; j < 8; ++j) f[j] = tile[(k8 + j) * 260 + nl];
            *(u32x4*)(dst + (size_t)(n0 + nl) * K + k0 + k8) = pack8(f);
        }
        __syncthreads();
    }
}
__device__ __forceinline__ void phase0(const Params& P, ldsp lds) {
    unsigned char* ws = P.ws;
    const int G = gridDim.x, b = blockIdx.x;
    for (int l = 0; l < 2; ++l) {
        convert_wt<1>(P.in[I_WIN] + (size_t)l * DM * INC, INC, (bf16_t*)(ws + W_WIN) + (size_t)l * NPROJ * DM, DM, NPROJ, P.in[I_NMIX] + l * DM, lds, b, G);
        convert_wt<0>(P.in[I_WOUT] + (size_t)l * DM * DM, DM, (bf16_t*)(ws + W_WOUT) + (size_t)l * DM * DM, DM, DM, nullptr, lds, (b + 64) % G, G);
        convert_wt<0>(P.in[I_WUP] + (size_t)l * DM * DFF, DFF, (bf16_t*)(ws + W_WUP) + (size_t)l * DFF * DM, DM, DFF, P.in[I_NMLP] + l * DM, lds, (b + 128) % G, G);
        convert_wt<0>(P.in[I_WDOWN] + (size_t)l * DFF * DM, DM, (bf16_t*)(ws + W_WDN) + (size_t)l * DM * DFF, DFF, DM, nullptr, lds, (b + 192) % G, G);
        convert_wt<0>(P.in[I_GLUW] + (size_t)l * 256 * 256, 256, (bf16_t*)(ws + W_WGLU) + (size_t)l * 256 * 256, 256, 256, nullptr, lds, (b + 32) % G, G);
    }
    const int tid_ = pg8::opaque_tid(), wave = tid_ >> 6, lane = tid_ & 63;
    bf16_t* XB = (bf16_t*)(ws + W_XB); float* SSQ = (float*)(ws + W_SSQ);
    const int stride = G * 8;
    for (int rb = b * 8 + wave; rb < TT; rb += 4 * stride) {
        f32x4 v[4][4];
#pragma unroll
        for (int u = 0; u < 4; ++u) {
            const int row = rb + u * stride;
            const float* xp = (row < T_P) ? (P.in[I_XP] + (size_t)row * DM) : (P.in[I_XS] + (size_t)(row - T_P) * DM);
#pragma unroll
            for (int j = 0; j < 4; ++j) v[u][j] = (row < TT) ? *(const f32x4*)(xp + j * 256 + lane * 4) : (f32x4){0.f, 0.f, 0.f, 0.f};
        }
#pragma unroll
        for (int u = 0; u < 4; ++u) {
            const int row = rb + u * stride;
            if (row < TT) {
                float s = 0.f;
#pragma unroll
                for (int j = 0; j < 4; ++j) {
                    const f32x4 x = v[u][j];
                    s += (x[0] * x[0] + x[1] * x[1]) + (x[2] * x[2] + x[3] * x[3]);
                    u32x2 w; w.x = cvt_pk_bf16(x[0], x[1]); w.y = cvt_pk_bf16(x[2], x[3]);
                    *(u32x2*)(XB + (size_t)row * DM + j * 256 + lane * 4) = w;
                    if (row >= T_P) *(f32x4*)(P.out + (size_t)row * DM + j * 256 + lane * 4) = x;
                }
#pragma unroll
                for (int o = 32; o >= 1; o >>= 1) s += __shfl_xor(s, o);
                if (lane < 16) SSQ[(size_t)row * 16 + lane] = (lane == 0) ? s : 0.f;
            }
        }
    }
}

constexpr int QS = 136, RS = 72, OS = 68;
constexpr int L_QI = 0, L_KI = 17408, L_KDT = 34816, L_VT = 53248, L_ST = 62464, L_FL = 79872, L_P = 83968, L_OB = 93184, L_XT = 110592, L_RAW = L_P, L_QSLOT = 130048;
constexpr int F_B = 0, F_RS = 64, F_CS = 128, F_DL = 256, F_KS = 320, F_SEG = 384;

__device__ __forceinline__ void lds_barrier() { asm volatile("s_waitcnt lgkmcnt(0)" ::: "memory"); __builtin_amdgcn_s_barrier(); asm volatile("" ::: "memory"); }
__device__ __forceinline__ f32x4 mma_tile(const LAS bf16_t* A, int lda, const LAS bf16_t* B, int ldb, int K, f32x4 acc, int r, int q) {
    for (int k0 = 0; k0 < K; k0 += 32) {
        const bf16x8 a = *(const LAS bf16x8*)(A + r * lda + k0 + q * 8);
        const bf16x8 b = *(const LAS bf16x8*)(B + r * ldb + k0 + q * 8);
        acc = __builtin_amdgcn_mfma_f32_16x16x32_bf16(a, b, acc, 0, 0, 0);
    }
    return acc;
}
template <int DK, int DMODE>
__device__ __forceinline__ void la_scores(ldsp lds, int wave, int lane, float lg2) {
    const LAS bf16_t* Qi = (const LAS bf16_t*)(lds + L_QI); const LAS bf16_t* Ki = (const LAS bf16_t*)(lds + L_KI);
    LAS bf16_t* Pm = (LAS bf16_t*)(lds + L_P); const LAS float* FL = (const LAS float*)(lds + L_FL);
    const int r = lane & 15, q = lane >> 4;
#pragma unroll
    for (int i = 0; i < 2; ++i) {
        const int id = wave * 2 + i, tm = id >> 2, tn = id & 3;
        f32x4 acc = {0.f, 0.f, 0.f, 0.f};
        if (tn <= tm) acc = mma_tile(Qi + tm * 16 * QS, QS, Ki + tn * 16 * QS, QS, DK, acc, r, q);
#pragma unroll
        for (int j = 0; j < 4; ++j) {
            const int t = tm * 16 + q * 4 + j, s = tn * 16 + r;
            float v = acc[j];
            if (DMODE == 1) v *= exp2f((float)(t - s) * lg2);
            if (DMODE == 2) v *= __expf(fminf(FL[F_B + t] - FL[F_B + s], 0.f));
            v = (s <= t) ? v : 0.f;
            Pm[t * RS + s] = f2bf(v);
        }
    }
}
template <int DK, bool SEPQC>
__device__ __forceinline__ void la_out(ldsp lds, int wave, int lane) {
    const LAS bf16_t* Qx = (const LAS bf16_t*)(lds + (SEPQC ? L_XT : L_QI)); const LAS bf16_t* Pm = (const LAS bf16_t*)(lds + L_P);
    const LAS bf16_t* Vt = (const LAS bf16_t*)(lds + L_VT); const LAS bf16_t* St = (const LAS bf16_t*)(lds + L_ST);
    LAS float* Ob = (LAS float*)(lds + L_OB); const LAS float* FL = (const LAS float*)(lds + L_FL);
    const int r = lane & 15, q = lane >> 4;
#pragma unroll
    for (int i = 0; i < 2; ++i) {
        const int id = wave * 2 + i, tm = id >> 2, tv = id & 3;
        f32x4 a1 = {0.f, 0.f, 0.f, 0.f}, a2 = {0.f, 0.f, 0.f, 0.f};
        a1 = mma_tile(Pm + tm * 16 * RS, RS, Vt + tv * 16 * RS, RS, 64, a1, r, q);
        a2 = mma_tile(Qx + tm * 16 * QS, QS, St + tv * 16 * QS, QS, DK, a2, r, q);
#pragma unroll
        for (int j = 0; j < 4; ++j) {
            const int t = tm * 16 + q * 4 + j, v = tv * 16 + r;
            Ob[t * OS + v] = a1[j] + (SEPQC ? a2[j] : FL[F_RS + t] * a2[j]);
        }
    }
}
template <int DK>
__device__ __forceinline__ void la_state(ldsp lds, int wave, int lane, f32x4 (&sacc)[DK / 32]) {
    constexpr int NT = DK / 32, TK = DK / 16;
    const LAS bf16_t* Vt = (const LAS bf16_t*)(lds + L_VT); const LAS bf16_t* Kdt = (const LAS bf16_t*)(lds + L_KDT);
    LAS bf16_t* St = (LAS bf16_t*)(lds + L_ST); const LAS float* FL = (const LAS float*)(lds + L_FL);
    const int r = lane & 15, q = lane >> 4;
#pragma unroll
    for (int i = 0; i < NT; ++i) {
        const int id = wave * NT + i, tv = id / TK, tk = id % TK;
        const float sc = FL[F_CS + tk * 16 + r];
        sacc[i] = sacc[i] * sc;
        sacc[i] = mma_tile(Vt + tv * 16 * RS, RS, Kdt + tk * 16 * RS, RS, 64, sacc[i], r, q);
#pragma unroll
        for (int j = 0; j < 4; ++j) St[(tv * 16 + q * 4 + j) * QS + tk * 16 + r] = f2bf(sacc[i][j]);
    }
}
template <int DK>
__device__ __forceinline__ void la_state_init(ldsp lds, int wave, int lane, f32x4 (&sacc)[DK / 32], const float* s0  ) {
    constexpr int NT = DK / 32, TK = DK / 16;
    LAS bf16_t* St = (LAS bf16_t*)(lds + L_ST);
    const int r = lane & 15, q = lane >> 4;
#pragma unroll
    for (int i = 0; i < NT; ++i) {
        const int id = wave * NT + i, tv = id / TK, tk = id % TK;
        f32x4 v = {0.f, 0.f, 0.f, 0.f};
        if (s0) v = *(const f32x4*)(s0 + (size_t)(tk * 16 + r) * 64 + tv * 16 + q * 4);
        sacc[i] = v;
#pragma unroll
        for (int j = 0; j < 4; ++j) St[(tv * 16 + q * 4 + j) * QS + tk * 16 + r] = f2bf(v[j]);
    }
}
template <int DK>
__device__ __forceinline__ void la_state_store(int wave, int lane, const f32x4 (&sacc)[DK / 32], float* so  ) {
    constexpr int NT = DK / 32, TK = DK / 16;
    const int r = lane & 15, q = lane >> 4;
#pragma unroll
    for (int i = 0; i < NT; ++i) {
        const int id = wave * NT + i, tv = id / TK, tk = id % TK;
        *(f32x4*)(so + (size_t)(tk * 16 + r) * 64 + tv * 16 + q * 4) = sacc[i];
    }
}

struct SeqInfo { int L, row0, pos0, b; bool sample; };
__device__ __forceinline__ SeqInfo seq_info(int seq) {
    SeqInfo s;
    if (seq < NB_P) { s.L = LEN_P; s.row0 = seq * LEN_P; s.pos0 = 0; s.b = seq; s.sample = false; }
    else { s.L = LEN_S; s.row0 = T_P + (seq - NB_P) * LEN_S; s.pos0 = 16384; s.b = seq - NB_P; s.sample = true; }
    return s;
}
constexpr int NS = 8, SL = 256;
constexpr size_t SG_RET = 0, SG_HG = SG_RET + (size_t)8 * 4 * NS * 4096 * 4, SG_SSD = SG_HG + (size_t)8 * 4 * NS * 4096 * 4, SG_HGD = SG_SSD + (size_t)8 * 4 * NS * 8192 * 4,
                 SG_SSDD = SG_HGD + (size_t)8 * 4 * NS * 64 * 4, SG_S5 = SG_SSDD + 4096, SG_END = SG_S5 + (size_t)8 * 16 * NS * 64 * 8;
static_assert(SG_END <= (size_t)TT * DM * 2, "segment scratch fits the XB region");

template <int DK, int DMODE>
__device__ __forceinline__ void la_state_scan(ldsp lds, int wave, int lane, f32x4 (&sacc)[DK / 32], const float* segb, int seg, float dsc, const float* dtab) {
    constexpr int NT = DK / 32, TK = DK / 16;
    LAS bf16_t* St = (LAS bf16_t*)(lds + L_ST);
    const int r = lane & 15, q = lane >> 4;
#pragma unroll
    for (int i = 0; i < NT; ++i) sacc[i] = (f32x4){0.f, 0.f, 0.f, 0.f};
#pragma unroll 4
    for (int s = 0; s < seg; ++s) {
#pragma unroll
        for (int i = 0; i < NT; ++i) {
            const int id = wave * NT + i, tv = id / TK, tk = id % TK;
            float sc = dsc;
            if (DMODE == 1) sc = dtab[s * 64 + tk * 16 + r];
            if (DMODE == 2) sc = dtab[s];
            const f32x4 v = *(const f32x4*)(segb + (size_t)s * DK * 64 + (size_t)(tk * 16 + r) * 64 + tv * 16 + q * 4);
            sacc[i] = sacc[i] * sc + v;
        }
    }
#pragma unroll
    for (int i = 0; i < NT; ++i) {
        const int id = wave * NT + i, tv = id / TK, tk = id % TK;
#pragma unroll
        for (int j = 0; j < 4; ++j) St[(tv * 16 + q * 4 + j) * QS + tk * 16 + r] = f2bf(sacc[i][j]);
    }
}

__device__ __forceinline__ void ret_item(const Ctx& P, int l, int seq, int h, int tb, int te, int init, int full, int store, int seg, ldsp lds) {
    const SeqInfo si = seq_info(seq);
    const int tid = pg8::opaque_tid(), wave = tid >> 6, lane = tid & 63;
    const bf16_t* PROJ = (const bf16_t*)(P.ws + W_PROJ); bf16_t* MIX = (bf16_t*)(P.ws + W_MIX);
    LAS bf16_t* Qi = (LAS bf16_t*)(lds + L_QI); LAS bf16_t* Ki = (LAS bf16_t*)(lds + L_KI); LAS bf16_t* Kdt = (LAS bf16_t*)(lds + L_KDT); LAS bf16_t* Vt = (LAS bf16_t*)(lds + L_VT);
    LAS float* FL = (LAS float*)(lds + L_FL); const LAS float* Ob = (const LAS float*)(lds + L_OB);
    const float lg2 = log2f(1.0f - exp2f(-5.0f - (float)h));
    float* segb = (float*)(P.ws + W_XB + SG_RET) + (size_t)((seq & 7) * 4 + h) * NS * 4096;
    f32x4 sacc[2];
    if (init == 2) la_state_scan<64, 0>(lds, wave, lane, sacc, segb, seg, exp2f((float)SL * lg2), nullptr);
    else la_state_init<64>(lds, wave, lane, sacc, init == 1 ? (P.in(I_SRET) + ((size_t)(l * NB_S + si.b) * 4 + h) * 4096) : nullptr);
    const int t = tid >> 3, c0 = (tid & 7) * 8;
    float ang[4];
#pragma unroll
    for (int i = 0; i < 4; ++i) ang[i] = exp2f(-(float)(c0 / 2 + i) * (13.287712379549449f / 31.0f));
    u32x4 rq, rk, rv, rg;
#define RET_LOAD(T0) do { rq = (u32x4){0u, 0u, 0u, 0u}; rk = rq; rv = rq; rg = rq; \
        if ((T0) < te && t < te - (T0)) { const bf16_t* pp_ = PROJ + (size_t)(si.row0 + (T0) + t) * NPROJ + h * 64 + c0; \
            rq = *(const u32x4*)(pp_ + C_RQ); rk = *(const u32x4*)(pp_ + C_RK); rv = *(const u32x4*)(pp_ + C_RV); if (full) rg = *(const u32x4*)(pp_ + C_RG); } } while (0)
    RET_LOAD(tb);
    for (int t0 = tb; t0 < te; t0 += 64) {
        const int nv = min(64, te - t0);
        const bool valid = t < nv;
        const size_t row = (size_t)(si.row0 + t0 + t);
        float qf[8], kf[8], vf[8];
        unpack8(rq, qf); unpack8(rk, kf); unpack8(rv, vf);
        const u32x4 gcur = rg;
        if (valid) {
            const double pos = (double)(si.pos0 + t0 + t);
#pragma unroll
            for (int i = 0; i < 4; ++i) {
                const double tr = pos * (double)ang[i] * 0.15915494309189535;
                const float fr = (float)(tr - floor(tr)) * 6.283185307179586f;
                const float sn = __sinf(fr), cs = __cosf(fr);
                const float q1 = qf[2 * i], q2 = qf[2 * i + 1], k1 = kf[2 * i] * 0.125f, k2 = kf[2 * i + 1] * 0.125f;
                if (full) { qf[2 * i] = q1 * cs - q2 * sn; qf[2 * i + 1] = q1 * sn + q2 * cs; }
                kf[2 * i] = k1 * cs - k2 * sn; kf[2 * i + 1] = k1 * sn + k2 * cs;
            }
        }
        const float gq = exp2f((float)t * lg2), gk = exp2f(-(float)t * lg2);
#pragma unroll
        for (int i = 0; i < 8; ++i) { qf[i] *= gq; kf[i] *= gk; }
        if (full) { *(LAS u32x4*)(Qi + t * QS + c0) = pack8(qf); *(LAS u32x4*)(Ki + t * QS + c0) = pack8(kf); }
        const float kd = exp2f((float)(nv - 1) * lg2);
#pragma unroll
        for (int i = 0; i < 8; ++i) { Kdt[(c0 + i) * RS + t] = f2bf(kf[i] * kd); Vt[(c0 + i) * RS + t] = f2bf(vf[i]); }
        if ((tid & 7) == 0) FL[F_RS + t] = exp2f(lg2);
        if (tid < 64) FL[F_CS + tid] = exp2f((float)nv * lg2);
        RET_LOAD(t0 + 64);
        lds_barrier();
        if (full) {
            la_scores<64, 0>(lds, wave, lane, 0.f);
            lds_barrier();
            la_out<64, false>(lds, wave, lane);
            lds_barrier();
        }
        la_state<64>(lds, wave, lane, sacc);
        if (full) {
            float o[8]; float s = 0.f;
#pragma unroll
            for (int i = 0; i < 8; ++i) { o[i] = Ob[t * OS + c0 + i]; s += o[i]; }
            s += __shfl_xor(s, 1); s += __shfl_xor(s, 2); s += __shfl_xor(s, 4);
            const float mu = s * (1.0f / 64.0f); float vq = 0.f;
#pragma unroll
            for (int i = 0; i < 8; ++i) { o[i] -= mu; vq += o[i] * o[i]; }
            vq += __shfl_xor(vq, 1); vq += __shfl_xor(vq, 2); vq += __shfl_xor(vq, 4);
            const float rstd = rsqrtf(vq * (1.0f / 64.0f) + 1e-6f);
            if (valid) {
                float g[8]; unpack8(gcur, g);
#pragma unroll
                for (int i = 0; i < 8; ++i) o[i] = o[i] * rstd * siluf_(g[i]);
                *(u32x4*)(MIX + row * DM + h * 64 + c0) = pack8(o);
            }
        }
        lds_barrier();
    }
#undef RET_LOAD
    if (store == 1) la_state_store<64>(wave, lane, sacc, P.out + (si.sample ? (O_SRET + ((size_t)(l * NB_S + si.b) * 4 + h) * 4096) : (O_PRET + ((size_t)(l * NB_P + si.b) * 4 + h) * 4096)));
    if (store == 2) la_state_store<64>(wave, lane, sacc, segb + (size_t)seg * 4096);
}

__device__ __forceinline__ void hgrn_item(const Ctx& P, int l, int seq, int h, int tb, int te, int init, int full, int store, int seg, ldsp lds) {
    const SeqInfo si = seq_info(seq);
    const int tid = pg8::opaque_tid(), wave = tid >> 6, lane = tid & 63;
    const bf16_t* PROJ = (const bf16_t*)(P.ws + W_PROJ); bf16_t* MIX = (bf16_t*)(P.ws + W_MIX);
    LAS bf16_t* Qi = (LAS bf16_t*)(lds + L_QI); LAS bf16_t* Ki = (LAS bf16_t*)(lds + L_KI); LAS bf16_t* Kdt = (LAS bf16_t*)(lds + L_KDT); LAS bf16_t* Vt = (LAS bf16_t*)(lds + L_VT);
    LAS bf16_t* Qc = (LAS bf16_t*)(lds + L_XT);
    LAS float* FL = (LAS float*)(lds + L_FL); const LAS float* Ob = (const LAS float*)(lds + L_OB);
    float* segb = (float*)(P.ws + W_XB + SG_HG) + (size_t)((seq & 7) * 4 + h) * NS * 4096;
    float* segd = (float*)(P.ws + W_XB + SG_HGD) + (size_t)((seq & 7) * 4 + h) * NS * 64;
    f32x4 sacc[2];
    if (init == 2) la_state_scan<64, 1>(lds, wave, lane, sacc, segb, seg, 1.f, segd);
    else la_state_init<64>(lds, wave, lane, sacc, init == 1 ? (P.in(I_SHG) + ((size_t)(l * NB_S + si.b) * 4 + h) * 4096) : nullptr);
    const int k = lane, sg = wave;
    float lower = 0.f;
    if (l == 1) { const float a0 = P.in(I_HGLB)[h * 64 + k], a1 = P.in(I_HGLB)[256 + h * 64 + k]; lower = 1.0f / (1.0f + expf(a0 - a1)); }
    const int tp = tid >> 3, c0 = (tid & 7) * 8;
    float cumlog = 0.f;
    unsigned short pq[8], pf[8], pi_[8]; u32x4 rg;
#define HG_LOAD(T0) do { rg = (u32x4){0u, 0u, 0u, 0u}; \
        _Pragma("unroll") for (int j = 0; j < 8; ++j) { pq[j] = 0; pf[j] = 0; pi_[j] = 0; const int tt_ = sg * 8 + j; \
            if ((T0) < te && tt_ < te - (T0)) { const size_t b_ = (size_t)(si.row0 + (T0) + tt_) * NPROJ + h * 64 + k; pq[j] = PROJ[b_ + C_HQ]; pf[j] = PROJ[b_ + C_HF]; pi_[j] = PROJ[b_ + C_HI]; } } \
        if (full && (T0) < te && tp < te - (T0)) rg = *(const u32x4*)(PROJ + (size_t)(si.row0 + (T0) + tp) * NPROJ + C_HG + h * 64 + c0); } while (0)
    HG_LOAD(tb);
    for (int t0 = tb; t0 < te; t0 += 64) {
        const int nv = min(64, te - t0);
        float cs[8], ky[8], qs[8], vv[8];
        float run = 0.f;
#pragma unroll
        for (int j = 0; j < 8; ++j) {
            const int t = sg * 8 + j;
            float lf = 0.f; ky[j] = 0.f; qs[j] = 0.f; vv[j] = 0.f;
            if (t < nv) {
                const float qq = bf2f(pq[j]), ff = bf2f(pf[j]), ii = bf2f(pi_[j]);
                const float ef = __expf(-fminf(fmaxf(ff, -30.f), 30.f));
                const float sgm = 1.0f / (1.0f + ef);
                const float forget = lower + (1.0f - lower) * sgm;
                lf = __logf(fmaxf(forget, 1e-30f));
                ky[j] = (1.0f - lower) * ef * sgm;
                if (full) qs[j] = qq / (1.0f + __expf(-qq));
                vv[j] = ii;
            }
            run += lf; cs[j] = run;
        }
        const u32x4 gcur = rg;
        FL[F_SEG + sg * 64 + k] = run;
        HG_LOAD(t0 + 64);
        lds_barrier();
        float pre = 0.f, tot = 0.f, bref = 0.f;
#pragma unroll
        for (int s = 0; s < 8; ++s) { const float x = FL[F_SEG + s * 64 + k]; if (s < sg) pre += x; if (s < 4) bref += x; tot += x; }
        cumlog += tot;
        const float eb = __expf(bref), et = __expf(tot - bref);
        float kdv[8];
#pragma unroll
        for (int j = 0; j < 8; ++j) {
            const int t = sg * 8 + j; const float b = pre + cs[j];
            if (full) {
                const float e1 = __expf(fminf(fmaxf(b - bref, -80.f), 80.f)), r1 = __builtin_amdgcn_rcpf(e1);
                Qi[t * QS + k] = f2bf(qs[j] * e1);
                Ki[t * QS + k] = f2bf(ky[j] * r1);
                Qc[t * QS + k] = f2bf(qs[j] * e1 * eb);
                kdv[j] = ky[j] * r1 * et;
            } else kdv[j] = ky[j] * __expf(tot - b);
        }
        *(LAS u32x4*)(Kdt + k * RS + sg * 8) = pack8(kdv);
        *(LAS u32x4*)(Vt + k * RS + sg * 8) = pack8(vv);
        if (sg == 0) FL[F_CS + k] = __expf(tot);
        lds_barrier();
        if (full) {
            la_scores<64, 0>(lds, wave, lane, 0.f);
            lds_barrier();
            la_out<64, true>(lds, wave, lane);
            lds_barrier();
        }
        la_state<64>(lds, wave, lane, sacc);
        if (full) {
            float o[8]; float s = 0.f;
#pragma unroll
            for (int i = 0; i < 8; ++i) { o[i] = Ob[tp * OS + c0 + i]; s += o[i] * o[i]; }
            s += __shfl_xor(s, 1); s += __shfl_xor(s, 2); s += __shfl_xor(s, 4);
            const float rstd = rsqrtf(s * (1.0f / 64.0f) + 1e-6f);
            if (tp < nv) {
                const size_t row = (size_t)(si.row0 + t0 + tp);
                float g[8]; unpack8(gcur, g);
#pragma unroll
                for (int i = 0; i < 8; ++i) o[i] = o[i] * rstd * siluf_(g[i]);
                *(u32x4*)(MIX + row * DM + 256 + h * 64 + c0) = pack8(o);
            }
        }
        lds_barrier();
    }
#undef HG_LOAD
    if (store == 1) la_state_store<64>(wave, lane, sacc, P.out + (si.sample ? (O_SHG + ((size_t)(l * NB_S + si.b) * 4 + h) * 4096) : (O_PHG + ((size_t)(l * NB_P + si.b) * 4 + h) * 4096)));
    if (store == 2) { la_state_store<64>(wave, lane, sacc, segb + (size_t)seg * 4096); if (sg == 0) segd[seg * 64 + k] = __expf(cumlog); }
}

constexpr int L_CW = 131136;
__device__ __forceinline__ void ssd_item(const Ctx& P, int l, int seq, int h, int tb, int te, int init, int full, int store, int seg, ldsp lds) {
    const SeqInfo si = seq_info(seq);
    const int tid = pg8::opaque_tid(), wave = tid >> 6, lane = tid & 63, g = h >> 1;
    const bf16_t* PROJ = (const bf16_t*)(P.ws + W_PROJ); bf16_t* MIX = (bf16_t*)(P.ws + W_MIX); float* SSDSQ = (float*)(P.ws + W_SSDSQ);
    LAS bf16_t* Qi = (LAS bf16_t*)(lds + L_QI); LAS bf16_t* Ki = (LAS bf16_t*)(lds + L_KI); LAS bf16_t* Kdt = (LAS bf16_t*)(lds + L_KDT); LAS bf16_t* Vt = (LAS bf16_t*)(lds + L_VT);
    LAS bf16_t* RAW = (LAS bf16_t*)(lds + L_RAW);
    LAS float* FL = (LAS float*)(lds + L_FL); const LAS float* Ob = (const LAS float*)(lds + L_OB); LAS float* CW = (LAS float*)(lds + L_CW);
    float* segb = (float*)(P.ws + W_XB + SG_SSD) + (size_t)((seq & 7) * 4 + h) * NS * 8192;
    float* segd = (float*)(P.ws + W_XB + SG_SSDD) + (size_t)((seq & 7) * 4 + h) * NS;
    const float* cbuf = si.sample ? (P.in(I_SCONV) + (size_t)(l * NB_S + si.b) * 3 * 768) : nullptr;
    f32x4 sacc[4];
    if (init == 2) la_state_scan<128, 2>(lds, wave, lane, sacc, segb, seg, 1.f, segd);
    else la_state_init<128>(lds, wave, lane, sacc, init == 1 ? (P.in(I_SSSD) + ((size_t)(l * NB_S + si.b) * 4 + h) * 8192) : nullptr);
    const float dtb = P.in(I_DTB)[l * 4 + h], aexp = expf(P.in(I_ALOG)[l * 4 + h]), dsk = P.in(I_SSDD)[l * 4 + h];
    if (tid < 320) {
        const int cc = (tid < 64) ? (h * 64 + tid) : (tid < 192 ? 256 + g * 128 + (tid - 64) : 512 + g * 128 + (tid - 192));
        const float* cwp = P.in(I_CONVW) + (size_t)l * 4 * 768;
        CW[tid] = cwp[cc]; CW[320 + tid] = cwp[768 + cc]; CW[640 + tid] = cwp[2 * 768 + cc]; CW[960 + tid] = cwp[3 * 768 + cc]; CW[1280 + tid] = P.in(I_CONVB)[l * 768 + cc];
    }
    const int tp = tid >> 3, c0 = (tid & 7) * 8;
    float cumlog = 0.f;
    u32x4 rw[6]; u32x4 rz; unsigned short rdt;
    int stt[6], ssrc[6], slds[6];
#pragma unroll
    for (int i = 0; i < 6; ++i) { const int idx = tid + i * 512, tt = idx / 40, v8 = idx % 40;
        stt[i] = idx < 67 * 40 ? tt : -1000000; slds[i] = tt * 320 + v8 * 8;
        ssrc[i] = (v8 < 8) ? (h * 64 + v8 * 8) : (v8 < 24 ? 256 + g * 128 + (v8 - 8) * 8 : 512 + g * 128 + (v8 - 24) * 8); }
#define SSD_LOAD(T0) do { \
        _Pragma("unroll") for (int i_ = 0; i_ < 6; ++i_) { rw[i_] = (u32x4){0u, 0u, 0u, 0u}; const int ts_ = (T0) - 3 + stt[i_]; \
            if (stt[i_] >= 0 && (T0) < te) { const int sc_ = ssrc[i_]; \
                if (ts_ >= 0 && ts_ < te) rw[i_] = *(const u32x4*)(PROJ + (size_t)(si.row0 + ts_) * NPROJ + C_XBC + sc_); \
                else if (ts_ < 0 && cbuf) { const f32x4 a_ = *(const f32x4*)(cbuf + (ts_ + 3) * 768 + sc_), b_ = *(const f32x4*)(cbuf + (ts_ + 3) * 768 + sc_ + 4); \
                    rw[i_].x = cvt_pk_bf16(a_[0], a_[1]); rw[i_].y = cvt_pk_bf16(a_[2], a_[3]); rw[i_].z = cvt_pk_bf16(b_[0], b_[1]); rw[i_].w = cvt_pk_bf16(b_[2], b_[3]); } } } \
        rdt = 0; if (wave == 7 && (T0) < te && lane < te - (T0)) rdt = PROJ[(size_t)(si.row0 + (T0) + lane) * NPROJ + C_DT + h]; \
        rz = (u32x4){0u, 0u, 0u, 0u}; if (full && (T0) < te && tp < te - (T0)) rz = *(const u32x4*)(PROJ + (size_t)(si.row0 + (T0) + tp) * NPROJ + C_SZ + h * 64 + c0); } while (0)
    SSD_LOAD(tb);
    for (int t0 = tb; t0 < te; t0 += 64) {
        const int nv = min(64, te - t0);
#pragma unroll
        for (int i = 0; i < 6; ++i) { if (stt[i] >= 0) *(LAS u32x4*)(RAW + slds[i]) = rw[i]; }
        const u32x4 zcur = rz;
        if (wave == 7) {
            const int t = lane; float delta = 0.f, la = 0.f;
            if (t < nv) {
                const float dtv = bf2f(rdt) + dtb;
                delta = (dtv > 20.f) ? dtv : log1pf(__expf(dtv));
                la = -delta * aexp;
            }
            float b = la;
#pragma unroll
            for (int o = 1; o < 64; o <<= 1) { const float x = __shfl_up(b, o); if (lane >= o) b += x; }
            const float bl = __shfl(b, 63);
            cumlog += bl;
            FL[F_B + t] = b; FL[F_RS + t] = __expf(b); FL[F_DL + t] = delta; FL[F_KS + t] = delta * __expf(bl - b);
            FL[F_CS + t] = __expf(bl); FL[F_CS + 64 + t] = __expf(bl);
        }
        SSD_LOAD(t0 + 64);
        lds_barrier();
        for (int u = tid; u < 2560; u += 512) {
            const int c = u % 320, oc = u / 320;
            if (!full && c >= 192) continue;
            const float w0 = CW[c], w1 = CW[320 + c], w2 = CW[640 + c], w3 = CW[960 + c], bb = CW[1280 + c];
            float x0 = bf2f(RAW[(oc * 8 + 0) * 320 + c]), x1 = bf2f(RAW[(oc * 8 + 1) * 320 + c]), x2 = bf2f(RAW[(oc * 8 + 2) * 320 + c]);
            float ov[8];
#pragma unroll
            for (int j = 0; j < 8; ++j) {
                const int t = oc * 8 + j;
                const float x3 = bf2f(RAW[(t + 3) * 320 + c]);
                float v = bb + w0 * x0 + w1 * x1 + w2 * x2 + w3 * x3;
                v = siluf_(v);
                if (t >= nv) v = 0.f;
                ov[j] = v;
                x0 = x1; x1 = x2; x2 = x3;
            }
            if (c < 64) *(LAS u32x4*)(Vt + c * RS + oc * 8) = pack8(ov);
            else if (c < 192) {
                const int n = c - 64;
                if (full) {
#pragma unroll
                    for (int j = 0; j < 8; ++j) Ki[(oc * 8 + j) * QS + n] = f2bf(ov[j] * FL[F_DL + oc * 8 + j]);
                }
#pragma unroll
                for (int j = 0; j < 8; ++j) ov[j] *= FL[F_KS + oc * 8 + j];
                *(LAS u32x4*)(Kdt + n * RS + oc * 8) = pack8(ov);
            } else {
                const int n = c - 192;
#pragma unroll
                for (int j = 0; j < 8; ++j) Qi[(oc * 8 + j) * QS + n] = f2bf(ov[j]);
            }
        }
        lds_barrier();
        if (full) {
            la_scores<128, 2>(lds, wave, lane, 0.f);
            lds_barrier();
            la_out<128, false>(lds, wave, lane);
            lds_barrier();
        }
        la_state<128>(lds, wave, lane, sacc);
        if (full) {
            float o[8]; float s = 0.f;
            const size_t row = (size_t)(si.row0 + t0 + tp);
            float z[8]; unpack8(zcur, z);
#pragma unroll
            for (int i = 0; i < 8; ++i) { const float xs = bf2f(Vt[(c0 + i) * RS + tp]); o[i] = (Ob[tp * OS + c0 + i] + dsk * xs) * siluf_(z[i]); s += o[i] * o[i]; }
            s += __shfl_xor(s, 1); s += __shfl_xor(s, 2); s += __shfl_xor(s, 4);
            if (tp < nv) {
                *(u32x4*)(MIX + row * DM + 512 + h * 64 + c0) = pack8(o);
                if ((tid & 7) == 0) SSDSQ[row * 4 + h] = s;
            }
        }
        lds_barrier();
    }
#undef SSD_LOAD
    if (store == 1) la_state_store<128>(wave, lane, sacc, P.out + (si.sample ? (O_SSSD + ((size_t)(l * NB_S + si.b) * 4 + h) * 8192) : (O_PSSD + ((size_t)(l * NB_P + si.b) * 4 + h) * 8192)));
    if (store == 2) { la_state_store<128>(wave, lane, sacc, segb + (size_t)seg * 8192); if (tid == 7 * 64) segd[seg] = __expf(cumlog); }
    if (store == 1 && h == 0) {
        float* co = P.out + (si.sample ? (O_SCONV + (size_t)(l * NB_S + si.b) * 2304) : (O_PCONV + (size_t)(l * NB_P + si.b) * 2304));
        for (int idx = tid; idx < 2304; idx += 512) { const int rr = idx / 768, c = idx % 768; co[idx] = bf2f(PROJ[(size_t)(si.row0 + si.L - 3 + rr) * NPROJ + C_XBC + c]); }
    }
}

constexpr int S5W = 15360, S5_U = 0, S5_SB = 2048, S5_CB = 2048 + 8704, S5S = 136, S5C = 32;
__device__ __forceinline__ void s5_item(const Ctx& P, int l, int oct, int seq_b, int nseq, int tb, int te, int init, int full, int store, int seg, ldsp lds) {
    typedef float f32x2 __attribute__((ext_vector_type(2)));
    const int tid = pg8::opaque_tid(), w = tid >> 6, p = tid & 63, g = oct * 8 + w;
    const bf16_t* PROJ = (const bf16_t*)(P.ws + W_PROJ); bf16_t* YPRE = (bf16_t*)(P.ws + W_YPRE);
    LAS float* U = (LAS float*)(lds + w * S5W + S5_U); LAS bf16_t* Sb = (LAS bf16_t*)(lds + w * S5W + S5_SB); LAS bf16_t* Cb = (LAS bf16_t*)(lds + w * S5W + S5_CB);
    const int lg = l * 16 + g;
    const float are = P.in(I_S5AR)[lg * 64 + p], aim = P.in(I_S5AI)[lg * 64 + p], step = expf(P.in(I_S5DT)[lg]);
    const float mag = expf(are * step), angr = aim * step;
    const float abr = mag * cosf(angr), abi = mag * sinf(angr);
    const float d2 = are * are + aim * aim, nr = abr - 1.0f;
    const float cr = (nr * are + abi * aim) / d2, ci = (abi * are - nr * aim) / d2;
    f32x2 bb[16];
    {
        const f32x4* br = (const f32x4*)(P.in(I_S5BR) + ((size_t)lg * 64 + p) * 16); const f32x4* bi = (const f32x4*)(P.in(I_S5BI) + ((size_t)lg * 64 + p) * 16);
#pragma unroll
        for (int q4 = 0; q4 < 4; ++q4) { const f32x4 a = br[q4], b = bi[q4];
#pragma unroll
            for (int j = 0; j < 4; ++j) bb[q4 * 4 + j] = (f32x2){cr * a[j] - ci * b[j], cr * b[j] + ci * a[j]}; }
    }
#pragma unroll
    for (int hh = 0; hh < 16; ++hh)
        *(LAS unsigned*)(Cb + hh * S5S + 2 * p) = cvt_pk_bf16(P.in(I_S5CR)[((size_t)lg * 16 + hh) * 64 + p], -P.in(I_S5CI)[((size_t)lg * 16 + hh) * 64 + p]);
    const int r = p & 15, q = p >> 4;
    const float dk = P.in(I_S5D)[l * 256 + g * 16 + r];
    const int ut = p >> 1, uc = (p & 1) * 8;
    for (int sq = seq_b; sq < seq_b + nseq; ++sq) {
        const SeqInfo si = seq_info(sq);
        float sr = 0.f, sim = 0.f;
        if (init == 1) { sr = P.in(I_S5RE)[((size_t)(l * NB_S + si.b) * 16 + g) * 64 + p]; sim = P.in(I_S5IM)[((size_t)(l * NB_S + si.b) * 16 + g) * 64 + p]; }
        f32x2* segs = (f32x2*)(P.ws + W_XB + SG_S5) + (size_t)((sq & 7) * 16 + g) * NS * 64;
        if (init == 2) {
            float qr = abr, qi = abi;
            for (int s = 1; s < SL; s <<= 1) { const float nr_ = qr * qr - qi * qi, ni_ = 2.f * qr * qi; qr = nr_; qi = ni_; }
            for (int s = 0; s < seg; ++s) { const f32x2 e = segs[s * 64 + p]; const float nr_ = qr * sr - qi * sim + e.x, ni_ = qr * sim + qi * sr + e.y; sr = nr_; sim = ni_; }
        }
        u32x4 ru;
#define S5_LOAD(T0) do { ru = (u32x4){0u, 0u, 0u, 0u}; if ((T0) < te && ut < te - (T0)) ru = *(const u32x4*)(PROJ + (size_t)(si.row0 + (T0) + ut) * NPROJ + C_U + g * 16 + uc); } while (0)
        S5_LOAD(tb);
        for (int t0 = tb; t0 < te; t0 += S5C) {
            const int nv = min(S5C, te - t0);
            { float uf[8]; unpack8(ru, uf);
              *(LAS f32x4*)(U + ut * 16 + uc) = (f32x4){uf[0], uf[1], uf[2], uf[3]}; *(LAS f32x4*)(U + ut * 16 + uc + 4) = (f32x4){uf[4], uf[5], uf[6], uf[7]}; }
            S5_LOAD(t0 + S5C);
            asm volatile("s_waitcnt lgkmcnt(0)" ::: "memory"); __builtin_amdgcn_wave_barrier();
            float xr = sr, xi = sim;
            const int nvr = (nv + 3) & ~3;
#pragma unroll 4
            for (int t = 0; t < nvr; ++t) {
                const LAS f32x4* up = (const LAS f32x4*)(U + t * 16);
                f32x2 bu = {0.f, 0.f};
#pragma unroll
                for (int q4 = 0; q4 < 4; ++q4) { const f32x4 u4 = up[q4];
#pragma unroll
                    for (int e = 0; e < 4; ++e) bu += bb[q4 * 4 + e] * u4[e]; }
                const float nxr = abr * xr - abi * xi + bu.x, nxi = abr * xi + abi * xr + bu.y;
                xr = nxr; xi = nxi;
                if (full) *(LAS unsigned*)(Sb + t * S5S + 2 * p) = cvt_pk_bf16(xr, xi);
            }
            sr = xr; sim = xi;
            if (full) {
                asm volatile("s_waitcnt lgkmcnt(0)" ::: "memory"); __builtin_amdgcn_wave_barrier();
#pragma unroll
                for (int m = 0; m < 2; ++m) {
                    if (m * 16 >= nv) break;
                    f32x4 acc = {0.f, 0.f, 0.f, 0.f};
                    acc = mma_tile(Sb + m * 16 * S5S, S5S, Cb, S5S, 128, acc, r, q);
#pragma unroll
                    for (int j = 0; j < 4; ++j) {
                        const int t = m * 16 + q * 4 + j;
                        const float y = acc[j] + dk * U[t * 16 + r];
                        const float z = 0.7978845608028654f * (y + 0.044715f * y * y * y);
                        const float gl = y * (1.0f - 1.0f / (__expf(2.0f * z) + 1.0f));
                        if (t < nv) YPRE[(size_t)(si.row0 + t0 + t) * 256 + g * 16 + r] = f2bf(gl);
                    }
                }
                asm volatile("s_waitcnt lgkmcnt(0)" ::: "memory"); __builtin_amdgcn_wave_barrier();
            }
        }
#undef S5_LOAD
        if (store == 1) {
            float* ore = P.out + (si.sample ? (O_SS5R + ((size_t)(l * NB_S + si.b) * 16 + g) * 64) : (O_PS5R + ((size_t)(l * NB_P + si.b) * 16 + g) * 64));
            float* oim = P.out + (si.sample ? (O_SS5I + ((size_t)(l * NB_S + si.b) * 16 + g) * 64) : (O_PS5I + ((size_t)(l * NB_P + si.b) * 16 + g) * 64));
            ore[p] = sr; oim[p] = sim;
        }
        if (store == 2) segs[seg * 64 + p] = (f32x2){sr, sim};
    }
}

__device__ __forceinline__ float rdl(float x, int k) { return __uint_as_float((unsigned)__builtin_amdgcn_readlane((int)__float_as_uint(x), k)); }
__device__ __forceinline__ float wsum(float x) {
#pragma unroll
    for (int o = 32; o >= 1; o >>= 1) x += __shfl_xor(x, o);
    return x;
}
__device__ __forceinline__ void rh_sample_wave(const Ctx& P, int l, int b, int h, int lane, int isret) {
    const bf16_t* PROJ = (const bf16_t*)(P.ws + W_PROJ); bf16_t* MIX = (bf16_t*)(P.ws + W_MIX);
    const size_t so_ = ((size_t)(l * NB_S + b) * 4 + h) * 4096;
    const float* s0 = P.in(isret ? I_SRET : I_SHG) + so_; float* so = P.out + (isret ? O_SRET : O_SHG) + so_;
    float S[64];
#pragma unroll
    for (int k = 0; k < 64; ++k) S[k] = s0[k * 64 + lane];
    const float gam = 1.0f - exp2f(-5.0f - (float)h);
    const float angk = exp2f(-(float)(lane >> 1) * (13.287712379549449f / 31.0f)) * 0.15915494309189535f;
    float lower = 0.f;
    if (!isret && l == 1) { const float a0 = P.in(I_HGLB)[h * 64 + lane], a1 = P.in(I_HGLB)[256 + h * 64 + lane]; lower = 1.0f / (1.0f + expf(a0 - a1)); }
    const int cb = isret ? 0 : C_HQ;
#pragma unroll 1
    for (int t = 0; t < LEN_S; ++t) {
        const size_t row = (size_t)(T_P + b * LEN_S + t);
        const bf16_t* pp = PROJ + row * NPROJ + cb + h * 64 + lane;
        const float x0 = bf2f(pp[0]), x1 = bf2f(pp[256]), val = bf2f(pp[512]), g = bf2f(pp[768]);
        float dec, key, qry;
        if (isret) {
            const float tr = (float)(16384 + t) * angk;
            const float fr = (tr - floorf(tr)) * 6.283185307179586f;
            const float sn = __sinf(fr), cs = __cosf(fr);
            const float qp = __shfl_xor(x0, 1), kp = __shfl_xor(x1, 1);
            qry = (lane & 1) ? (qp * sn + x0 * cs) : (x0 * cs - qp * sn);
            key = ((lane & 1) ? (kp * sn + x1 * cs) : (x1 * cs - kp * sn)) * 0.125f;
            dec = gam;
        } else {
            const float ef = __expf(-fminf(fmaxf(x1, -30.f), 30.f)), sgm = 1.0f / (1.0f + ef);
            dec = fmaxf(lower + (1.0f - lower) * sgm, 1e-30f); key = (1.0f - lower) * ef * sgm; qry = x0 / (1.0f + __expf(-x0));
        }
        float o = 0.f;
#pragma unroll
        for (int kk = 0; kk < 64; ++kk) { const float dk = rdl(dec, kk), kyk = rdl(key, kk), qk = rdl(qry, kk); S[kk] = fmaf(kyk, val, dk * S[kk]); o = fmaf(qk, S[kk], o); if ((kk & 7) == 7) __builtin_amdgcn_sched_barrier(0); }
        const float mu = isret ? wsum(o) * (1.0f / 64.0f) : 0.f, d = o - mu;
        const float var = wsum(d * d) * (1.0f / 64.0f);
        MIX[row * DM + (isret ? 0 : 256) + h * 64 + lane] = f2bf(d * rsqrtf(var + 1e-6f) * siluf_(g));
    }
#pragma unroll
    for (int k = 0; k < 64; ++k) so[k * 64 + lane] = S[k];
}
__device__ __forceinline__ void ssd_sample_wave(const Ctx& P, int l, int b, int h, int lane, LAS float* YL  ) {
    const bf16_t* PROJ = (const bf16_t*)(P.ws + W_PROJ); bf16_t* MIX = (bf16_t*)(P.ws + W_MIX); float* SSDSQ = (float*)(P.ws + W_SSDSQ);
    const int g = h >> 1;
    const size_t so_ = ((size_t)(l * NB_S + b) * 4 + h) * 8192;
    const float* s0 = P.in(I_SSSD) + so_; float* so = P.out + O_SSSD + so_;
    const float dtb = P.in(I_DTB)[l * 4 + h], aexp = expf(P.in(I_ALOG)[l * 4 + h]), dsk = P.in(I_SSDD)[l * 4 + h];
    const float* cwp = P.in(I_CONVW) + (size_t)l * 4 * 768; const float* cbuf = P.in(I_SCONV) + (size_t)(l * NB_S + b) * 3 * 768;
#pragma unroll 1
    for (int half = 0; half < 2; ++half) {
        float S[64];
#pragma unroll
        for (int n = 0; n < 64; ++n) S[n] = s0[(half * 64 + n) * 64 + lane];
        int ch[3]; ch[0] = h * 64 + lane; ch[1] = 256 + g * 128 + half * 64 + lane; ch[2] = 512 + g * 128 + half * 64 + lane;
        float cw[3][4], cb[3], win[3][3];
#pragma unroll
        for (int c = 0; c < 3; ++c) {
#pragma unroll
            for (int w = 0; w < 4; ++w) cw[c][w] = cwp[w * 768 + ch[c]];
            cb[c] = P.in(I_CONVB)[l * 768 + ch[c]];
#pragma unroll
            for (int w = 0; w < 3; ++w) win[c][w] = bf2f(f2bf(cbuf[w * 768 + ch[c]]));
        }
#pragma unroll 1
        for (int t = 0; t < LEN_S; ++t) {
            const size_t row = (size_t)(T_P + b * LEN_S + t);
            const bf16_t* pr = PROJ + row * NPROJ;
            float cv[3];
#pragma unroll
            for (int c = 0; c < 3; ++c) {
                const float raw = bf2f(pr[C_XBC + ch[c]]);
                cv[c] = siluf_(cb[c] + cw[c][0] * win[c][0] + cw[c][1] * win[c][1] + cw[c][2] * win[c][2] + cw[c][3] * raw);
                win[c][0] = win[c][1]; win[c][1] = win[c][2]; win[c][2] = raw;
            }
            const float dtv = bf2f(pr[C_DT + h]) + dtb;
            const float delta = (dtv > 20.f) ? dtv : log1pf(__expf(dtv));
            const float a = __expf(-delta * aexp);
            const float xc = cv[0], bd = cv[1] * delta;
            float y = 0.f;
#pragma unroll
            for (int n = 0; n < 64; ++n) { const float bn = rdl(bd, n), cn = rdl(cv[2], n); S[n] = fmaf(bn, xc, a * S[n]); y = fmaf(cn, S[n], y); if ((n & 7) == 7) __builtin_amdgcn_sched_barrier(0); }
            if (half == 0) YL[t * 64 + lane] = y;
            else {
                const float z = bf2f(pr[C_SZ + h * 64 + lane]);
                y = (y + YL[t * 64 + lane] + dsk * xc) * siluf_(z);
                MIX[row * DM + 512 + h * 64 + lane] = f2bf(y);
                const float ss = wsum(y * y);
                if (lane == 0) SSDSQ[row * 4 + h] = ss;
            }
        }
#pragma unroll
        for (int n = 0; n < 64; ++n) so[(half * 64 + n) * 64 + lane] = S[n];
    }
    if (h == 0) {
        float* co = P.out + O_SCONV + (size_t)(l * NB_S + b) * 2304;
        for (int idx = lane; idx < 2304; idx += 64) { const int rr = idx / 768, c = idx % 768; co[idx] = bf2f(PROJ[(size_t)(T_P + b * LEN_S + LEN_S - 3 + rr) * NPROJ + C_XBC + c]); }
    }
}

constexpr int N_P1 = 8 * 4 * (NS - 1), N_P1S5 = 8 * 2 * (NS - 1), N_SUB0 = 3 * N_P1 + N_P1S5 + 64 + 64;
constexpr int N_P2 = 8 * 4 * NS, N_P2S5 = 8 * 2 * NS, N_SUB1 = 3 * N_P2 + N_P2S5 + 128;
__device__ __forceinline__ void ssd_norm_block(const Ctx& P, int l, int pm) {
    const int tid_ = pg8::opaque_tid(), wave = tid_ >> 6, lane = tid_ & 63;
    bf16_t* MIX = (bf16_t*)(P.ws + W_MIX); const float* SSDSQ = (const float*)(P.ws + W_SSDSQ);
    const f32x4 nw = *(const f32x4*)(P.in(I_SSDN) + l * 256 + lane * 4);
    const int gq = lane >> 5;
    for (int rb = pm * 256 + wave * 32; rb < pm * 256 + wave * 32 + 32; rb += 4) {
        u32x2 w[4]; float ss[4];
#pragma unroll
        for (int u = 0; u < 4; ++u) { const int row = rb + u; ss[u] = SSDSQ[(size_t)row * 4 + 2 * gq] + SSDSQ[(size_t)row * 4 + 2 * gq + 1]; w[u] = *(const u32x2*)(MIX + (size_t)row * DM + 512 + lane * 4); }
#pragma unroll
        for (int u = 0; u < 4; ++u) { const int row = rb + u;
            const float rstd = rsqrtf(ss[u] * (1.0f / 128.0f) + 1e-6f);
            const float a = __uint_as_float(w[u].x << 16) * rstd * nw[0], b = __uint_as_float(w[u].x & 0xffff0000u) * rstd * nw[1];
            const float c = __uint_as_float(w[u].y << 16) * rstd * nw[2], d = __uint_as_float(w[u].y & 0xffff0000u) * rstd * nw[3];
            u32x2 o; o.x = cvt_pk_bf16(a, b); o.y = cvt_pk_bf16(c, d);
            *(u32x2*)(MIX + (size_t)row * DM + 512 + lane * 4) = o; }
    }
}
constexpr size_t W_DEP = 20480;
__device__ __forceinline__ void mixer_phase(const Ctx& P, int l, ldsp lds) {
    unsigned* ctr = (unsigned*)(P.ws + W_CTL) + l * 32;
    unsigned* dep = (unsigned*)(P.ws + W_CTL + W_DEP) + l * 512;
    LAS int* slot = (LAS int*)(lds + L_QSLOT);
    const int nitems = N_SUB0 + N_SUB1 + 136;
    unsigned* dg = dep + 4 * 64; unsigned* df = dep + 4 * 64 + 68;
    __syncthreads();
    if (threadIdx.x == 0) *slot = (int)atomicAdd(ctr, 1u);
    __syncthreads();
    int id = *slot;
    while (id < nitems) {
        int nxt = 0;
        if (threadIdx.x == 0) nxt = (int)atomicAdd(ctr, 1u);
        int type, a, b2 = 0, c = 1, seg = 0, tb = 0, te = LEN_S, init = 1, full = 1, store = 1;
        const int tailid = id - (N_SUB0 + N_SUB1);
        if (tailid >= 0) id = N_SUB0;
        const int sub = id >= N_SUB0 ? 1 : 0;
        const int qid = sub ? id - N_SUB0 : id;
        { const int nS5 = sub == 0 ? N_P1S5 : N_P2S5, nOth = sub == 0 ? 3 * N_P1 : 3 * N_P2; id = qid < nS5 ? nOth + qid : (qid < nS5 + nOth ? qid - nS5 : qid); }
        if (sub == 0) {
            if (id < 3 * N_P1) { type = id / N_P1; const int j = id % N_P1; a = j / (4 * (NS - 1)); b2 = (j / (NS - 1)) & 3; seg = j % (NS - 1); init = 0; full = 0; store = 2; tb = seg * SL; te = tb + SL; }
            else if (id < 3 * N_P1 + N_P1S5) { type = 3; const int j = id - 3 * N_P1; b2 = j / (2 * (NS - 1)); a = (j / (NS - 1)) & 1; seg = j % (NS - 1); init = 0; full = 0; store = 2; tb = seg * SL; te = tb + SL; }
            else { const int j = id - 3 * N_P1 - N_P1S5;
                if (j < 64) { type = 4; a = j; }
                else { type = 3; a = (j - 64) & 1; b2 = NB_P + ((j - 64) >> 1) * 4; c = 4; } }
        } else {
            if (id < 3 * N_P2) { type = id / N_P2; const int j = id % N_P2; a = j / (4 * NS); b2 = (j / NS) & 3; seg = j % NS; }
            else if (id < 3 * N_P2 + N_P2S5) { type = 3; const int j = id - 3 * N_P2; b2 = j / (2 * NS); a = (j / NS) & 1; seg = j % NS; }
            else { const int j = id - 3 * N_P2 - N_P2S5; type = 5 + j / 64; a = j % 64; }
            if (type < 4) { init = seg > 0 ? 2 : 0; full = 1; store = (seg == NS - 1) ? 1 : 0; tb = seg * SL; te = tb + SL; }
        }
        if (tailid >= 0) { type = tailid < 68 ? 7 : 8; a = tailid < 68 ? tailid : tailid - 68; seg = 0; store = 0; }
        int chain = (type == 3) ? (b2 & 7) * 2 + a : (a & 7) * 4 + b2;
        chain = __builtin_amdgcn_readfirstlane(chain);
        int ptile = -1;
        if (sub == 1 && type == 3) ptile = (b2 & 7) * 8 + seg;
        if (sub == 1 && type == 0) ptile = (a & 7) * 8 + seg;
        if (sub == 0 && type == 3 && store == 1) ptile = 64 + (b2 - NB_P) / 32;
        if (type == 4) ptile = 64 + a / 16;
        if (tailid >= 0) ptile = -1;
        ptile = __builtin_amdgcn_readfirstlane(ptile);
        type = __builtin_amdgcn_readfirstlane(type); a = __builtin_amdgcn_readfirstlane(a); b2 = __builtin_amdgcn_readfirstlane(b2); c = __builtin_amdgcn_readfirstlane(c);
        seg = __builtin_amdgcn_readfirstlane(seg); tb = __builtin_amdgcn_readfirstlane(tb); te = __builtin_amdgcn_readfirstlane(te);
        init = __builtin_amdgcn_readfirstlane(init); full = __builtin_amdgcn_readfirstlane(full); store = __builtin_amdgcn_readfirstlane(store);
        if (sub == 1 && type < 4 && seg > 0) {
            if (threadIdx.x == 0) {
                unsigned* d = dep + type * 64 + chain;
                while (__hip_atomic_load(d, __ATOMIC_RELAXED, __HIP_MEMORY_SCOPE_AGENT) < (unsigned)(NS - 1)) __builtin_amdgcn_s_sleep(2);
                __builtin_amdgcn_fence(__ATOMIC_ACQUIRE, "agent"); asm volatile("s_waitcnt vmcnt(0)" ::: "memory");
            }
            __syncthreads();
        }
        if (type >= 7) {
            if (threadIdx.x == 0) {
                unsigned* d = (type == 7 ? dg : df) + a; const unsigned need = a < 64 ? (type == 7 ? 2u : 4u) : 16u;
                while (__hip_atomic_load(d, __ATOMIC_RELAXED, __HIP_MEMORY_SCOPE_AGENT) < need) __builtin_amdgcn_s_sleep(2);
                __builtin_amdgcn_fence(__ATOMIC_ACQUIRE, "agent"); asm volatile("s_waitcnt vmcnt(0)" ::: "memory");
            }
            __syncthreads();
            if (type == 7) {
                const bf16_t* YP = (const bf16_t*)(P.ws + W_YPRE);
                pg8::Gemm g{YP, (const bf16_t*)(P.ws + W_WGLU) + (size_t)l * 256 * 256, TT, 256, 256}; pg8::OneUnit S1{a, 4};
                pg8::EpiGlu E{YP, (bf16_t*)(P.ws + W_MIX), P.in(I_GLUB) + l * 256};
                pg8::gemm_phase<pg8::EpiGlu, pg8::OneUnit>(lds, g, S1, E, nullptr);
            } else ssd_norm_block(P, l, a);
        }
        if (type >= 4 && type < 7) {
            const int tq = pg8::opaque_tid(), pair = a * 8 + (tq >> 6), sb = pair >> 2, sh = pair & 3, ln = tq & 63;
            if (type == 4) ssd_sample_wave(P, l, sb, sh, ln, (LAS float*)(lds + (tq >> 6) * 2048));
            else rh_sample_wave(P, l, sb, sh, ln, type == 5);
        }
#ifndef SK_SSD
        if (type == 0) ssd_item(P, l, a, b2, tb, te, init, full, store, seg, lds);
#endif
#ifdef DBL_SSD
        if (type == 0) { __syncthreads(); ssd_item(P, l, a, b2, tb, te, init, full, store, seg, lds); }
#endif
#ifndef SK_RET
        if (type == 1) ret_item(P, l, a, b2, tb, te, init, full, store, seg, lds);
#endif
#ifdef DBL_RET
        if (type == 1) { __syncthreads(); ret_item(P, l, a, b2, tb, te, init, full, store, seg, lds); }
#endif
#ifndef SK_HG
        if (type == 2) hgrn_item(P, l, a, b2, tb, te, init, full, store, seg, lds);
#endif
#ifdef DBL_HG
        if (type == 2) { __syncthreads(); hgrn_item(P, l, a, b2, tb, te, init, full, store, seg, lds); }
#endif
#ifndef SK_S5
        if (type == 3) s5_item(P, l, a, b2, c, tb, te, init, full, store, seg, lds);
#endif
#ifdef DBL_S5
        if (type == 3) { __syncthreads(); s5_item(P, l, a, b2, c, tb, te, init, full, store, seg, lds); }
#endif
        if (sub == 0 && store == 2) {
            asm volatile("s_waitcnt vmcnt(0)" ::: "memory");
            __syncthreads();
            if (threadIdx.x == 0) { __builtin_amdgcn_fence(__ATOMIC_RELEASE, "agent"); asm volatile("s_waitcnt vmcnt(0)" ::: "memory");
                __hip_atomic_fetch_add(dep + type * 64 + chain, 1u, __ATOMIC_RELAXED, __HIP_MEMORY_SCOPE_AGENT); }
        }
        if (ptile >= 0) {
            asm volatile("s_waitcnt vmcnt(0)" ::: "memory");
            __syncthreads();
            if (threadIdx.x == 0) { __builtin_amdgcn_fence(__ATOMIC_RELEASE, "agent"); asm volatile("s_waitcnt vmcnt(0)" ::: "memory");
                __hip_atomic_fetch_add(((type == 3) ? dg : df) + ptile, 1u, __ATOMIC_RELAXED, __HIP_MEMORY_SCOPE_AGENT); }
        }
        __syncthreads();
        if (threadIdx.x == 0) *slot = nxt;
        __syncthreads();
        id = *slot;
    }
}

__device__ __forceinline__ void ssd_norm_fix(const Ctx& P, int l) {
    const int tid_ = pg8::opaque_tid(), wave = tid_ >> 6, lane = tid_ & 63;
    bf16_t* MIX = (bf16_t*)(P.ws + W_MIX); const float* SSDSQ = (const float*)(P.ws + W_SSDSQ);
    const f32x4 nw = *(const f32x4*)(P.in(I_SSDN) + l * 256 + lane * 4);
    const int nskip = gridDim.x >= 136 ? 68 : 0;
    if ((int)blockIdx.x < nskip) return;
    const int gq = lane >> 5, stride = (gridDim.x - nskip) * 8;
    for (int rb = ((int)blockIdx.x - nskip) * 8 + wave; rb < TT; rb += 4 * stride) {
        u32x2 w[4]; float ss[4];
#pragma unroll
        for (int u = 0; u < 4; ++u) { const int row = rb + u * stride; ss[u] = 0.f; w[u] = (u32x2){0u, 0u};
            if (row < TT) { ss[u] = SSDSQ[(size_t)row * 4 + 2 * gq] + SSDSQ[(size_t)row * 4 + 2 * gq + 1]; w[u] = *(const u32x2*)(MIX + (size_t)row * DM + 512 + lane * 4); } }
#pragma unroll
        for (int u = 0; u < 4; ++u) { const int row = rb + u * stride;
            if (row < TT) {
                const float rstd = rsqrtf(ss[u] * (1.0f / 128.0f) + 1e-6f);
                const float a = __uint_as_float(w[u].x << 16) * rstd * nw[0], b = __uint_as_float(w[u].x & 0xffff0000u) * rstd * nw[1];
                const float c = __uint_as_float(w[u].y << 16) * rstd * nw[2], d = __uint_as_float(w[u].y & 0xffff0000u) * rstd * nw[3];
                u32x2 o; o.x = cvt_pk_bf16(a, b); o.y = cvt_pk_bf16(c, d);
                *(u32x2*)(MIX + (size_t)row * DM + 512 + lane * 4) = o;
            } }
    }
}
__device__ __forceinline__ void sample_fix(const Ctx& P, const float* slab, int nsplit) {
    const int tid_ = pg8::opaque_tid(), wave = tid_ >> 6, lane = tid_ & 63;
    bf16_t* XB = (bf16_t*)(P.ws + W_XB); float* SSQ = (float*)(P.ws + W_SSQ);
    for (int row = T_P + blockIdx.x * 8 + wave; row < TT; row += gridDim.x * 8) {
        float* xp = P.out + (size_t)row * DM; float s = 0.f;
#pragma unroll
        for (int j = 0; j < 4; ++j) {
            f32x4 v = *(const f32x4*)(xp + j * 256 + lane * 4);
            if (nsplit > 8) {
                const bf16_t* s16 = (const bf16_t*)slab;
                for (int k = 0; k < nsplit; ++k) { const u32x2 w2 = *(const u32x2*)(s16 + ((size_t)k * 1024 + (row - T_P)) * 1024 + j * 256 + lane * 4);
                    v[0] += __uint_as_float(w2.x << 16); v[1] += __uint_as_float(w2.x & 0xffff0000u); v[2] += __uint_as_float(w2.y << 16); v[3] += __uint_as_float(w2.y & 0xffff0000u); }
            } else
            for (int k = 0; k < nsplit; ++k) v += *(const f32x4*)(slab + ((size_t)k * 1024 + (row - T_P)) * 1024 + j * 256 + lane * 4);
            *(f32x4*)(xp + j * 256 + lane * 4) = v;
            s += (v[0] * v[0] + v[1] * v[1]) + (v[2] * v[2] + v[3] * v[3]);
            u32x2 w; w.x = cvt_pk_bf16(v[0], v[1]); w.y = cvt_pk_bf16(v[2], v[3]);
            *(u32x2*)(XB + (size_t)row * DM + j * 256 + lane * 4) = w;
        }
#pragma unroll
        for (int o = 32; o >= 1; o >>= 1) s += __shfl_xor(s, o);
        if (lane < 16) SSQ[(size_t)row * 16 + lane] = (lane == 0) ? s : 0.f;
    }
}
__device__ __forceinline__ void final_norm(const Ctx& P) {
    const int tid_ = pg8::opaque_tid(), wave = tid_ >> 6, lane = tid_ & 63;
    const float* SSQ = (const float*)(P.ws + W_SSQ); const float* nf = P.in(I_NFIN);
    f32x4 wv[4];
#pragma unroll
    for (int j = 0; j < 4; ++j) wv[j] = *(const f32x4*)(nf + j * 256 + lane * 4);
    const int stride = gridDim.x * 8;
    for (int rb = blockIdx.x * 8 + wave; rb < TT; rb += 4 * stride) {
        f32x4 v[4][4]; float sq[4];
#pragma unroll
        for (int u = 0; u < 4; ++u) { const int row = rb + u * stride;
            sq[u] = (row < TT && lane < 16) ? SSQ[(size_t)row * 16 + lane] : 0.f;
#pragma unroll
            for (int j = 0; j < 4; ++j) v[u][j] = (row < TT) ? *(const f32x4*)(P.out + (size_t)row * DM + j * 256 + lane * 4) : (f32x4){0.f, 0.f, 0.f, 0.f}; }
#pragma unroll
        for (int u = 0; u < 4; ++u) { const int row = rb + u * stride;
            float s = sq[u];
#pragma unroll
            for (int o = 8; o >= 1; o >>= 1) s += __shfl_xor(s, o);
            s = __shfl(s, 0);
            const float rstd = rsqrtf(s * (1.0f / 1024.0f) + 1e-6f);
            if (row < TT) {
#pragma unroll
                for (int j = 0; j < 4; ++j) *(f32x4*)(P.out + (size_t)row * DM + j * 256 + lane * 4) = v[u][j] * rstd * wv[j];
            } }
    }
}

__global__ void __launch_bounds__(512, 2) fwd_megakernel(Params P) {
    extern __shared__ __attribute__((aligned(16))) unsigned char lds_raw[];
    cg::grid_group grid = cg::this_grid();
    ldsp lds = (ldsp)lds_raw;
    const int G = gridDim.x, bid = blockIdx.x;
#define PHASE_PTRS unsigned char* ws = P.ws; asm volatile("" : "+s"(ws)); float* X = P.out; asm volatile("" : "+s"(X)); \
    bf16_t* XB = (bf16_t*)(ws + W_XB); bf16_t* MIX = (bf16_t*)(ws + W_MIX); bf16_t* PROJ = (bf16_t*)(ws + W_PROJ); bf16_t* HID = (bf16_t*)(ws + W_HID); bf16_t* YPRE = (bf16_t*)(ws + W_YPRE); float* SSQ = (float*)(ws + W_SSQ); \
    Ctx C; C.out = X; C.ws = ws; (void)XB; (void)MIX; (void)PROJ; (void)HID; (void)YPRE; (void)SSQ; (void)C

    if (threadIdx.x < 2) ((LAS unsigned*)(lds + L_BARST))[threadIdx.x] = 0u;
    __syncthreads();
    (void)xcd_barrier_post((unsigned*)(P.ws + W_BAR), (volatile LAS unsigned*)(lds + L_BARST));
#define XBAR() do { XcdBarrier xb_; xb_.bar = (unsigned*)(P.ws + W_BAR); xb_.x = xb_xcc_id(); xb_.st = (volatile LAS unsigned*)(lds + L_BARST); xcd_barrier(xb_); } while (0)
    phase0(P, lds);
    if (bid == 0) {
#pragma unroll
        for (int i = 0; i < N_IN; ++i) if ((int)threadIdx.x == i) ((const float**)(P.ws + W_TAB))[i] = P.in[i];
    }
    XBAR();
    grid.sync();

#pragma unroll 1
    for (int l = 0; l < 2; ++l) {
        {
            PHASE_PTRS;
            pg8::Gemm g{XB, (const bf16_t*)(ws + W_WIN) + (size_t)l * NPROJ * DM, TT, NPROJ, DM}; pg8::StaticOrder S; S.init(TT, NPROJ, G, bid);
            pg8::EpiScaleBf16<0> E{PROJ, NPROJ, SSQ};
            pg8::gemm_phase<pg8::EpiScaleBf16<0>, pg8::StaticOrder>(lds, g, S, E, nullptr);
        }
        XBAR();
        { PHASE_PTRS; mixer_phase(C, l, lds); }
        XBAR();
        {
            PHASE_PTRS;
            pg8::Gemm g{MIX, (const bf16_t*)(ws + W_WOUT) + (size_t)l * DM * DM, TT, DM, DM}; pg8::SplitOrder S; S.init(T_P, DM, G, bid, DM, 4);
            pg8::EpiRes E{l == 0 ? C.in(I_XP) : X, X + (size_t)T_P * DM, X, XB, SSQ, (float*)HID, 0};
            pg8::gemm_phase<pg8::EpiRes, pg8::SplitOrder>(lds, g, S, E, nullptr);
        }
        XBAR();
        { PHASE_PTRS; sample_fix(C, (const float*)HID, 4); }
        XBAR();
        {
            PHASE_PTRS;
            pg8::Gemm g{XB, (const bf16_t*)(ws + W_WUP) + (size_t)l * DFF * DM, TT, DFF, DM}; pg8::StaticOrder S; S.init(TT, DFF, G, bid);
            pg8::EpiScaleBf16<1> E{HID, DFF, SSQ};
#ifdef REP_UP
#pragma unroll 1
            for (int rep = 0; rep < 3; ++rep)
#endif
            pg8::gemm_phase<pg8::EpiScaleBf16<1>, pg8::StaticOrder>(lds, g, S, E, nullptr);
        }
        XBAR();
        {
            PHASE_PTRS;
            pg8::Gemm g{HID, (const bf16_t*)(ws + W_WDN) + (size_t)l * DM * DFF, TT, DM, DFF}; pg8::SplitOrder S; S.init(T_P, DM, G, bid, DFF, 16);
            pg8::EpiRes E{X, X + (size_t)T_P * DM, X, XB, SSQ, (float*)MIX, 1};
            pg8::gemm_phase<pg8::EpiRes, pg8::SplitOrder>(lds, g, S, E, nullptr);
        }
        XBAR();
        { PHASE_PTRS; sample_fix(C, (const float*)MIX, 16); }
        XBAR();
    }
    { PHASE_PTRS; final_norm(C); }
#undef PHASE_PTRS
}
}

extern "C" void kernel_launch(void* const* d_in, const int* in_sizes, int n_in, void* d_out, int out_size, void* d_ws, size_t ws_size, hipStream_t stream) {
    static int grid_blocks = 0;
    if (grid_blocks == 0) {
        if (n_in != mk::N_IN || (size_t)out_size != mk::O_END || ws_size < mk::W_END) {
            fprintf(stderr, "kernel_launch: unexpected shapes: n_in %d out %d ws %zu (need %zu)\n", n_in, out_size, ws_size, (size_t)mk::W_END); grid_blocks = -1; return; }
        int dev = 0, cus = 0, per_cu = 0;
        (void)hipGetDevice(&dev);
        (void)hipDeviceGetAttribute(&cus, hipDeviceAttributeMultiprocessorCount, dev);
        (void)hipFuncSetAttribute((const void*)mk::fwd_megakernel, hipFuncAttributeMaxDynamicSharedMemorySize, mk::LDS_BYTES);
        (void)hipOccupancyMaxActiveBlocksPerMultiprocessor(&per_cu, (const void*)mk::fwd_megakernel, 512, mk::LDS_BYTES);
        if (per_cu < 1) { fprintf(stderr, "kernel_launch: occupancy query says 0 blocks per CU\n"); per_cu = 1; }
        if (per_cu > 1) per_cu = 1;
        grid_blocks = cus * per_cu;
    }
    if (grid_blocks < 0) return;
    (void)hipMemsetAsync((char*)d_ws + mk::W_CTL, 0, 32768, stream);
    mk::Params p{};
    for (int i = 0; i < mk::N_IN; ++i) p.in[i] = (const float*)d_in[i];
    p.out = (float*)d_out; p.ws = (unsigned char*)d_ws;
    void* args[] = {&p};
    hipError_t e = hipLaunchCooperativeKernel((const void*)mk::fwd_megakernel, dim3(grid_blocks), dim3(512), args, mk::LDS_BYTES, stream);
    if (e != hipSuccess) fprintf(stderr, "cooperative launch failed: %s (grid %d)\n", hipGetErrorString(e), grid_blocks);
}
```

```cpp
#include <hip/hip_cooperative_groups.h>
#include <cstdio>
namespace cg = cooperative_groups;
#include <hip/hip_runtime.h>
namespace pg8 {
#define PG8_LAS __attribute__((address_space(3)))
typedef unsigned short bf16_t;
typedef short bf16x8 __attribute__((ext_vector_type(8)));
typedef float f32x4 __attribute__((ext_vector_type(4)));
typedef unsigned u32x4 __attribute__((ext_vector_type(4)));
constexpr int BM = 256, BK = 64, HALF = 128, HTB = HALF * BK * 2  , STAGE_BYTES = 8 * HTB, NXCD = 8, WGM = 8;

__host__ __device__ __forceinline__ int lds_byte(int r, int c) { const int st = (r >> 4) * 2 + (c >> 5), rr = r & 15, cc = c & 31, ob = rr * 64 + cc * 2; return st * 1024 + (ob ^ (((ob >> 9) & 1) << 5)); }
__host__ __device__ __forceinline__ void stage_rc(int b, int& R, int& C) { const int st = b / 1024, sb = b % 1024, swz = sb ^ (((sb >> 9) & 1) << 5); R = (st >> 1) * 16 + swz / 64; C = (st & 1) * 32 + (swz % 64) / 2; }
__host__ __device__ __forceinline__ int perm32(int rho) { const int n = rho >> 4, i = rho & 15; return 8 * (i >> 2) + 4 * n + (i & 3); }

struct Unit { int pm, pn, ki; __host__ __device__ int kt0() const { return ki & 0xff; } __host__ __device__ int nkt() const { return (ki >> 8) & 0xff; } __host__ __device__ int split() const { return ki >> 16; } };
struct Gemm { const bf16_t* A; const bf16_t* Bt; int M, N, K; };

struct StaticOrder {
    int nM, nN, nwg, G, c, nkt;
    __host__ __device__ void init(int M, int N, int G_, int c_, int K = 1024) { nM = M / BM; nN = N / BM; nwg = nM * nN; G = G_; c = c_; nkt = K / BK; }
    __host__ __device__ bool next(int i, Unit& u) const {
        const long L = (long)i * G + c; if (L >= nwg) return false;
        int wgid = (int)L; { const int q = nwg / NXCD, r = nwg % NXCD, xcd = wgid % NXCD, off = wgid / NXCD; wgid = (xcd < r ? xcd * (q + 1) : r * (q + 1) + (xcd - r) * q) + off; }
        const int nig = WGM * nN, gid = wgid / nig, fm = gid * WGM, gsz = (nM - fm) < WGM ? (nM - fm) : WGM;
        u.pm = fm + ((wgid % nig) % gsz); u.pn = (wgid % nig) / gsz; u.ki = nkt << 8; return true;
    }
    __device__ __forceinline__ void a_ready(const Unit&) const {}
    __device__ __forceinline__ void done(const Unit&) const {}
};
struct SplitOrder {
    StaticOrder P; int nP, nS, SPLIT, nkt_s, nNn;
    __host__ __device__ void init(int Mp, int N, int G_, int c_, int K, int SPLIT_) { P.init(Mp, N, G_, c_, K); nP = P.nwg; nNn = N / BM; SPLIT = SPLIT_; nS = 4 * nNn * SPLIT; nkt_s = K / BK / SPLIT; }
    __host__ __device__ bool next(int i, Unit& u) const {
        const long L = (long)i * P.G + P.c;
        if (L < nP) return P.next(i, u);
        const int s = (int)(L - nP); if (s >= nS) return false;
        const int tile = s / SPLIT, ks = s % SPLIT;
        u.pm = 64 + tile / nNn; u.pn = tile % nNn; u.ki = (ks * nkt_s) | (nkt_s << 8) | (1 << 16); return true;
    }
    __device__ __forceinline__ void a_ready(const Unit&) const {}
    __device__ __forceinline__ void done(const Unit&) const {}
};
struct OneUnit {
    int pm, nkt;
    __host__ __device__ bool next(int i, Unit& u) const { if (i) return false; u.pm = pm; u.pn = 0; u.ki = nkt << 8; return true; }
    __device__ __forceinline__ void a_ready(const Unit&) const {}
    __device__ __forceinline__ void done(const Unit&) const {}
};
typedef __bf16 bf16v2_t __attribute__((ext_vector_type(2)));
__device__ __forceinline__ unsigned cvt_pk_bf16(float lo, float hi) { bf16v2_t v; v.x = (__bf16)lo; v.y = (__bf16)hi; return __builtin_bit_cast(unsigned, v); }
typedef float f32x2 __attribute__((ext_vector_type(2)));
__device__ __forceinline__ int opaque_tid() { int t = (int)threadIdx.x; asm volatile("" : "+v"(t)); return t; }
typedef unsigned u32x2 __attribute__((ext_vector_type(2)));
constexpr int TP_ROWS = 16384;
template <int ACT> struct EpiScaleBf16 {
    static constexpr bool PERM = true, AFTER_DRAIN = false;
    bf16_t* O; int ldc; const float* rstdp;
    __device__ __forceinline__ void operator()(const f32x4 (&acc)[2][2][4][2], const Unit& u, int wr, int wc, int fr, int fq) const {
        const int row0 = u.pm * BM + wr * 64 + fr, col0 = u.pn * BM + wc * 32 + 8 * fq;
        float rs[8];
#pragma unroll
        for (int i = 0; i < 8; ++i) rs[i] = rstdp[row0 + (i >> 2) * HALF + (i & 3) * 16];
#pragma unroll
        for (int ai = 0; ai < 2; ++ai)
#pragma unroll
            for (int m = 0; m < 4; ++m) {
                const int row = row0 + ai * HALF + m * 16;
                const float rstd = rs[ai * 4 + m];
                bf16_t* rowp = O + (size_t)row * ldc + col0;
#pragma unroll
                for (int bj = 0; bj < 2; ++bj) {
                    f32x4 v0 = acc[ai][bj][m][0] * rstd, v1 = acc[ai][bj][m][1] * rstd;
                    if (ACT == 1) {
#pragma unroll
                        for (int j = 0; j < 4; ++j) { const float a = fmaxf(v0[j], 0.f), b = fmaxf(v1[j], 0.f); v0[j] = a * a; v1[j] = b * b; }
                    }
                    u32x4 w; w.x = cvt_pk_bf16(v0[0], v0[1]); w.y = cvt_pk_bf16(v0[2], v0[3]); w.z = cvt_pk_bf16(v1[0], v1[1]); w.w = cvt_pk_bf16(v1[2], v1[3]);
                    *(u32x4*)(rowp + bj * HALF) = w;
                }
            }
    }
};
struct EpiRes {
    static constexpr bool PERM = false, AFTER_DRAIN = false;
    const float* base0; const float* base1; float* X; bf16_t* XB; float* ssq; float* slab; int slab16;
    __device__ __forceinline__ void operator()(const f32x4 (&acc)[2][2][4][2], const Unit& u, int wr, int wc, int fr, int fq) const {
        const int row0 = u.pm * BM + wr * 64 + fr, col0 = u.pn * BM + wc * 32 + 4 * fq;
        if (u.split()) {
            const int ks = u.kt0() / u.nkt();
#pragma unroll
            for (int ai = 0; ai < 2; ++ai)
#pragma unroll
                for (int m = 0; m < 4; ++m) {
                    const size_t so_ = ((size_t)ks * 1024 + (size_t)(row0 + ai * HALF + m * 16 - TP_ROWS)) * 1024 + col0;
                    if (slab16) {
                        bf16_t* sp = (bf16_t*)slab + so_;
#pragma unroll
                        for (int bj = 0; bj < 2; ++bj)
#pragma unroll
                            for (int n = 0; n < 2; ++n) { const f32x4 a = acc[ai][bj][m][n]; u32x2 w; w.x = cvt_pk_bf16(a[0], a[1]); w.y = cvt_pk_bf16(a[2], a[3]); *(u32x2*)(sp + bj * HALF + n * 16) = w; }
                    } else {
                        float* sp = slab + so_;
#pragma unroll
                        for (int bj = 0; bj < 2; ++bj)
#pragma unroll
                            for (int n = 0; n < 2; ++n) *(f32x4*)(sp + bj * HALF + n * 16) = acc[ai][bj][m][n];
                    }
                }
            return;
        }
#pragma unroll
        for (int ai = 0; ai < 2; ++ai)
#pragma unroll
            for (int m = 0; m < 4; ++m) {
                const int row = row0 + ai * HALF + m * 16;
                const float* bp = (row < TP_ROWS) ? (base0 + (size_t)row * 1024) : (base1 + (size_t)(row - TP_ROWS) * 1024);
                float s = 0.f;
#pragma unroll
                for (int bj = 0; bj < 2; ++bj)
#pragma unroll
                    for (int n = 0; n < 2; ++n) {
                        const int c = col0 + bj * HALF + n * 16;
                        const f32x4 b = *(const f32x4*)(bp + c);
                        const f32x4 v = b + acc[ai][bj][m][n];
                        *(f32x4*)(X + (size_t)row * 1024 + c) = v;
                        u32x2 w; w.x = cvt_pk_bf16(v[0], v[1]); w.y = cvt_pk_bf16(v[2], v[3]);
                        *(u32x2*)(XB + (size_t)row * 1024 + c) = w;
                        s += (v[0] * v[0] + v[1] * v[1]) + (v[2] * v[2] + v[3] * v[3]);
                    }
                s += __shfl_xor(s, 16); s += __shfl_xor(s, 32);
                if (fq == 0) ssq[(size_t)row * 16 + u.pn * 4 + wc] = s;
                asm volatile("" ::: "memory");
            }
    }
};
struct EpiGlu {
    static constexpr bool PERM = true, AFTER_DRAIN = false;
    const bf16_t* Y; bf16_t* MIX; const float* bias;
    __device__ __forceinline__ void operator()(const f32x4 (&acc)[2][2][4][2], const Unit& u, int wr, int wc, int fr, int fq) const {
        const int row0 = u.pm * BM + wr * 64 + fr, col0 = u.pn * BM + wc * 32 + 8 * fq;
#pragma unroll
        for (int ai = 0; ai < 2; ++ai)
#pragma unroll
            for (int m = 0; m < 4; ++m) {
                const int row = row0 + ai * HALF + m * 16;
#pragma unroll
                for (int bj = 0; bj < 2; ++bj) {
                    const int c = col0 + bj * HALF;
                    const u32x4 yw = *(const u32x4*)(Y + (size_t)row * 256 + c);
                    const f32x4 b0 = *(const f32x4*)(bias + c), b1 = *(const f32x4*)(bias + c + 4);
                    const f32x4 a0 = acc[ai][bj][m][0] + b0, a1 = acc[ai][bj][m][1] + b1;
                    float y[8], o[8];
                    y[0] = __uint_as_float(yw.x << 16); y[1] = __uint_as_float(yw.x & 0xffff0000u); y[2] = __uint_as_float(yw.y << 16); y[3] = __uint_as_float(yw.y & 0xffff0000u);
                    y[4] = __uint_as_float(yw.z << 16); y[5] = __uint_as_float(yw.z & 0xffff0000u); y[6] = __uint_as_float(yw.w << 16); y[7] = __uint_as_float(yw.w & 0xffff0000u);
#pragma unroll
                    for (int j = 0; j < 4; ++j) { o[j] = y[j] / (1.0f + __expf(-a0[j])); o[4 + j] = y[4 + j] / (1.0f + __expf(-a1[j])); }
                    u32x4 w; w.x = cvt_pk_bf16(o[0], o[1]); w.y = cvt_pk_bf16(o[2], o[3]); w.z = cvt_pk_bf16(o[4], o[5]); w.w = cvt_pk_bf16(o[6], o[7]);
                    *(u32x4*)(MIX + (size_t)row * 1024 + 768 + c) = w;
                    asm volatile("" ::: "memory");
                }
            }
    }
};
template <class Epi, class Sched, bool STAMP = false>
__device__ __forceinline__ void gemm_phase(PG8_LAS unsigned char* lds, const Gemm g, const Sched& S, const Epi& E, unsigned long long* stamps) {
    const int tid = opaque_tid(), wid = __builtin_amdgcn_readfirstlane(tid >> 6), lane = tid & 63, wr = wid >> 2, wc = wid & 3, fr = lane & 15, fq = lane >> 4;
    int K_ = g.K; asm volatile("" : "+s"(K_)); const int K = K_, nt = K / BK;
    int ts_lo = 0, ts_hi = 0, nts = 0; const unsigned long long rt_entry = STAMP ? (unsigned long long)wall_clock64() : 0ull;
#define PG8_STAMP() do { if (STAMP && wid == 0 && nts < 64) { const unsigned long long _c = (unsigned long long)clock64(); \
        ts_lo = (lane == nts) ? (int)(unsigned)_c : ts_lo; ts_hi = (lane == nts) ? (int)(unsigned)(_c >> 32) : ts_hi; ++nts; } } while (0)
    PG8_STAMP();
    unsigned voffA[2], voffB[2];
#pragma unroll
    for (int i = 0; i < 2; ++i) { int R, C; stage_rc(tid * 16 + i * 8192, R, C); const int Rb = Epi::PERM ? ((R & ~31) + perm32(R & 31)) : R;
        voffA[i] = (unsigned)(R * K + C) * 2u; voffB[i] = (unsigned)(Rb * K + C) * 2u; }
    const size_t kstep = (size_t)(BK * 2);
    const size_t hstep = (size_t)HALF * K * 2;
    const size_t tstep = 2 * hstep;
    const unsigned ldsw = (unsigned)wid * 1024u;
    const int aoff = lds_byte(wr * 64 + fr, fq * 8), boff = lds_byte(wc * 32 + fr, fq * 8);
#define PG8_SA(b, h) (((b) * 2 + (h)) * HTB)
#define PG8_SB(b, h) ((4 + (b) * 2 + (h)) * HTB)
#define PG8_STAGE(bufoff, gbase, voff) do { _Pragma("unroll") for (int _i = 0; _i < 2; ++_i) \
        __builtin_amdgcn_global_load_lds((const unsigned*)((const char*)(gbase) + (voff)[_i]), (PG8_LAS unsigned*)(lds + (bufoff) + ldsw + _i * 8192), 16, 0, 0); } while (0)
#define PG8_LDA(dst, b, h) do { _Pragma("unroll") for (int m = 0; m < 4; ++m) _Pragma("unroll") for (int k = 0; k < 2; ++k) dst[m][k] = *(const PG8_LAS bf16x8*)(lds + PG8_SA(b, h) + aoff + m * 2048 + k * 1024); } while (0)
#define PG8_LDB(dst, b, h) do { _Pragma("unroll") for (int n = 0; n < 2; ++n) _Pragma("unroll") for (int k = 0; k < 2; ++k) dst[n][k] = *(const PG8_LAS bf16x8*)(lds + PG8_SB(b, h) + boff + n * 2048 + k * 1024); } while (0)
#define PG8_MMA(ai, bj, At, Bt) do { __builtin_amdgcn_s_setprio(1); _Pragma("unroll") for (int m = 0; m < 4; ++m) _Pragma("unroll") for (int n = 0; n < 2; ++n) _Pragma("unroll") for (int k = 0; k < 2; ++k) \
        acc[ai][bj][m][n] = __builtin_amdgcn_mfma_f32_16x16x32_bf16(Bt[n][k], At[m][k], acc[ai][bj][m][n], 0, 0, 0); __builtin_amdgcn_s_setprio(0); } while (0)
#define PG8_WAIT_V(n) asm volatile("s_waitcnt vmcnt(" #n ")" ::: "memory")
#define PG8_WAIT_L(n) asm volatile("s_waitcnt lgkmcnt(" #n ")" ::: "memory")
#define PG8_BAR __builtin_amdgcn_s_barrier()
#define PG8_SCHED __builtin_amdgcn_sched_barrier(0)
    Unit cur, nxt; int ui = 0;
    if (!S.next(0, cur)) return;
    f32x4 acc[2][2][4][2];
#pragma unroll
    for (int a = 0; a < 2; ++a)
#pragma unroll
        for (int b = 0; b < 2; ++b)
#pragma unroll
            for (int m = 0; m < 4; ++m)
#pragma unroll
                for (int n = 0; n < 2; ++n) acc[a][b][m][n] = (f32x4){0.f, 0.f, 0.f, 0.f};
    bf16x8 At[4][2], B0[2][2], B1[2][2];
    const char* cA = (const char*)g.A + (size_t)cur.pm * tstep + (size_t)cur.kt0() * kstep; const char* cB = (const char*)g.Bt + (size_t)cur.pn * tstep + (size_t)cur.kt0() * kstep;
    S.a_ready(cur);
    PG8_STAGE(PG8_SB(0, 0), cB, voffB); PG8_STAGE(PG8_SA(0, 0), cA, voffA); PG8_STAGE(PG8_SB(0, 1), cB + hstep, voffB); PG8_STAGE(PG8_SA(0, 1), cA + hstep, voffA);
    if (wr == 1) PG8_BAR;
    PG8_WAIT_V(4); PG8_BAR;
    PG8_STAGE(PG8_SB(1, 0), cB + kstep, voffB); PG8_STAGE(PG8_SA(1, 0), cA + kstep, voffA); PG8_STAGE(PG8_SB(1, 1), cB + hstep + kstep, voffB);
    PG8_WAIT_V(6); PG8_BAR;
    PG8_STAMP();
    for (;;) {
        const bool has_next = S.next(ui + 1, nxt);
        const char* nA = has_next ? (const char*)g.A + (size_t)nxt.pm * tstep + (size_t)nxt.kt0() * kstep : cA; const char* nB = has_next ? (const char*)g.Bt + (size_t)nxt.pn * tstep + (size_t)nxt.kt0() * kstep : cB;
        const int cnt = cur.nkt();
        for (int t = 0; t < cnt; t += 2) {
            const bool last = (t == cnt - 2);
            const char* a1 = cA + (size_t)(t + 1) * kstep;
            const char* a2 = last ? nA : cA + (size_t)(t + 2) * kstep; const char* b2 = last ? nB : cB + (size_t)(t + 2) * kstep;
            const char* a3 = a2 + kstep; const char* b3 = b2 + kstep;
            if (last && has_next) S.a_ready(nxt);
            PG8_LDB(B0, 0, 0); PG8_SCHED; PG8_LDA(At, 0, 0); PG8_STAGE(PG8_SA(1, 1), a1 + hstep, voffA);
            PG8_WAIT_L(8); PG8_BAR; PG8_WAIT_L(0); PG8_MMA(0, 0, At, B0); PG8_BAR; PG8_SCHED;
            PG8_LDB(B1, 0, 1); PG8_STAGE(PG8_SB(0, 0), b2, voffB);
            PG8_BAR; PG8_WAIT_L(0); PG8_MMA(0, 1, At, B1); PG8_BAR;
            PG8_LDA(At, 0, 1); PG8_STAGE(PG8_SA(0, 0), a2, voffA);
            PG8_BAR; PG8_WAIT_L(0); PG8_MMA(1, 0, At, B0); PG8_BAR; PG8_SCHED;
            PG8_STAGE(PG8_SB(0, 1), b2 + hstep, voffB);
            PG8_WAIT_V(6); PG8_BAR; PG8_MMA(1, 1, At, B1); PG8_BAR;
            PG8_LDB(B0, 1, 0); PG8_SCHED; PG8_LDA(At, 1, 0); PG8_STAGE(PG8_SA(0, 1), a2 + hstep, voffA);
            PG8_WAIT_L(8); PG8_BAR; PG8_WAIT_L(0); PG8_MMA(0, 0, At, B0); PG8_BAR; PG8_SCHED;
            PG8_LDB(B1, 1, 1); PG8_STAGE(PG8_SB(1, 0), b3, voffB);
            PG8_BAR; PG8_WAIT_L(0); PG8_MMA(0, 1, At, B1); PG8_BAR;
            PG8_LDA(At, 1, 1); PG8_STAGE(PG8_SA(1, 0), a3, voffA);
            PG8_BAR; PG8_WAIT_L(0); PG8_MMA(1, 0, At, B0); PG8_BAR; PG8_SCHED;
            PG8_STAGE(PG8_SB(1, 1), b3 + hstep, voffB);
            PG8_WAIT_V(6); PG8_BAR; PG8_MMA(1, 1, At, B1); PG8_BAR;
        }
        PG8_STAMP();
        if constexpr (!Epi::AFTER_DRAIN) { E(acc, cur, wr, wc, fr, fq); S.done(cur); }
        PG8_STAMP();
        if (!has_next) break;
#pragma unroll
        for (int a = 0; a < 2; ++a)
#pragma unroll
            for (int b = 0; b < 2; ++b)
#pragma unroll
                for (int m = 0; m < 4; ++m)
#pragma unroll
                    for (int n = 0; n < 2; ++n) acc[a][b][m][n] = (f32x4){0.f, 0.f, 0.f, 0.f};
        cur = nxt; cA = nA; cB = nB; ++ui;
    }
    PG8_WAIT_V(0);
    if (wr == 0) PG8_BAR;
    PG8_BAR;
    if constexpr (Epi::AFTER_DRAIN) { E.fused(acc, cur, wr, wc, fr, fq, lds, wid, lane); S.done(cur); }
    PG8_STAMP();
    if (STAMP && wid == 0) { stamps[lane] = lane < nts ? (((unsigned long long)(unsigned)ts_hi << 32) | (unsigned)ts_lo) : 0ull;
        if (lane == 62) stamps[62] = rt_entry; if (lane == 63) stamps[63] = (unsigned long long)wall_clock64(); }
#undef PG8_STAMP
#undef PG8_SA
#undef PG8_SB
#undef PG8_STAGE
#undef PG8_LDA
#undef PG8_LDB
#undef PG8_MMA
#undef PG8_WAIT_V
#undef PG8_WAIT_L
#undef PG8_BAR
#undef PG8_SCHED
}
}

namespace mk {
using pg8::bf16_t; using pg8::bf16x8; using pg8::f32x4; using pg8::u32x4; using pg8::u32x2; using pg8::cvt_pk_bf16;
#define LAS PG8_LAS
typedef LAS unsigned char* ldsp;
#define XB_TMO      128
#define XB_XCNT(j)  (256  + 64 * (j))
#define XB_XSUB(j)  (1280 + 64 * (j))
#define XB_XGEN(j)  (2304 + 64 * (j))
#define XB_TOP      3328
#define XB_TOPGEN   3392
#define XCD_BAR_WORDS 3456
#define XB_SPIN_CAP (1u << 18)
__device__ __forceinline__ unsigned xb_ld(unsigned* p)              { return __hip_atomic_load(p, __ATOMIC_RELAXED, __HIP_MEMORY_SCOPE_AGENT); }
__device__ __forceinline__ unsigned xb_add(unsigned* p, unsigned v) { return __hip_atomic_fetch_add(p, v, __ATOMIC_RELAXED, __HIP_MEMORY_SCOPE_AGENT); }
__device__ __forceinline__ unsigned xb_xcc_id() { return (unsigned)__builtin_amdgcn_s_getreg((3 << 11) | 20) & 0xFu; }
#define XB_SPIN(cond, bar) do { unsigned _sp = 0; while (cond) { __builtin_amdgcn_s_sleep(1); \
    if ((++_sp & 255u) == 0u) { if (xb_ld(&(bar)[XB_TMO])) break; if (_sp > XB_SPIN_CAP) { atomicAdd(&(bar)[XB_TMO], 1u); break; } } } } while (0)

struct XcdBarrier {
    unsigned* bar; unsigned x;
    volatile LAS unsigned* st;
};

__device__ __forceinline__ XcdBarrier xcd_barrier_post(unsigned* bar, volatile LAS unsigned* st) {
    XcdBarrier b; b.bar = bar; b.x = xb_xcc_id(); b.st = st;
    if (threadIdx.x == 0) (void)xb_add(&bar[XB_XCNT(b.x)], 1u);
    return b;
}
__device__ __forceinline__ void xcd_barrier_complete(unsigned* bar, unsigned x, unsigned& nloc, unsigned& nx) {
    const unsigned G = gridDim.x * gridDim.y * gridDim.z;
    unsigned sum, cnt, mine, sp = 0u;
    for (;;) {
        sum = 0u; cnt = 0u; mine = 0u;
#pragma unroll
        for (unsigned j = 0; j < 16; ++j) { const unsigned c = xb_ld(&bar[XB_XCNT(j)]); sum += c; cnt += (c > 0u) ? 1u : 0u; mine = (j == x) ? c : mine; }
        if (sum == G) break;
        __builtin_amdgcn_s_sleep(1);
        if ((++sp & 255u) == 0u) { if (xb_ld(&bar[XB_TMO])) break; if (sp > XB_SPIN_CAP) { atomicAdd(&bar[XB_TMO], 1u); break; } }
    }
    nloc = mine > 0u ? mine : 1u; nx = cnt > 0u ? cnt : 1u;
}

__device__ __forceinline__ void xcd_barrier(const XcdBarrier& b) {
    asm volatile("s_waitcnt vmcnt(0)" ::: "memory");
    __syncthreads();
    if (threadIdx.x == 0) {
        unsigned* bar = b.bar;
        __builtin_amdgcn_s_waitcnt(0);
        unsigned nloc = b.st[0], nx = b.st[1];
        if (nloc == 0u) { xcd_barrier_complete(bar, b.x, nloc, nx); b.st[0] = nloc; b.st[1] = nx; }
        const unsigned old = xb_add(&bar[XB_XSUB(b.x)], 1u);
        const unsigned gen = old / nloc;
        if (old + 1u == (gen + 1u) * nloc) {
            __builtin_amdgcn_fence(__ATOMIC_RELEASE, "agent");
            asm volatile("s_waitcnt vmcnt(0)" ::: "memory");
            const unsigned og = xb_add(&bar[XB_TOP], 1u);
            const unsigned tg = og / nx;
            if (og + 1u == (tg + 1u) * nx) xb_add(&bar[XB_TOPGEN], 1u);
            else XB_SPIN(xb_ld(&bar[XB_TOPGEN]) == tg, bar);
            __builtin_amdgcn_fence(__ATOMIC_ACQUIRE, "agent");
            xb_add(&bar[XB_XGEN(b.x)], 1u);
            asm volatile("s_waitcnt vmcnt(0)" ::: "memory");
        } else {
            XB_SPIN(xb_ld(&bar[XB_XGEN(b.x)]) == gen, bar);
            __builtin_amdgcn_fence(__ATOMIC_ACQUIRE, "agent");
            asm volatile("s_waitcnt vmcnt(0)" ::: "memory");
        }
    }
    __syncthreads();
}

constexpr int T_P = 16384, T_S = 1024, TT = 17408, DM = 1024, NPROJ = 3584, DFF = 4096, INC = 3332;
constexpr int LEN_P = 2048, LEN_S = 8, NB_P = 8, NB_S = 128;
constexpr int LDS_BYTES = 138240, L_BARST = 131072;
constexpr int C_RQ = 0, C_RK = 256, C_RV = 512, C_RG = 768, C_HQ = 1024, C_HF = 1280, C_HI = 1536, C_HG = 1792, C_SZ = 2048, C_XBC = 2304, C_U = 3072, C_DT = 3328;
enum { I_XP = 0, I_XS, I_SRET, I_SHG, I_SSSD, I_SCONV, I_S5RE, I_S5IM, I_NMIX, I_WIN, I_WOUT, I_HGLB, I_CONVW, I_CONVB, I_DTB, I_ALOG, I_SSDD, I_SSDN,
       I_S5AR, I_S5AI, I_S5DT, I_S5BR, I_S5BI, I_S5CR, I_S5CI, I_S5D, I_GLUW, I_GLUB, I_NMLP, I_WUP, I_WDOWN, I_NFIN, N_IN };
constexpr size_t O_YP = 0, O_YS = 16777216, O_PRET = O_YS + 1048576, O_PHG = O_PRET + 262144, O_PSSD = O_PHG + 262144, O_PCONV = O_PSSD + 524288, O_PS5R = O_PCONV + 36864, O_PS5I = O_PS5R + 16384,
                 O_SRET = O_PS5I + 16384, O_SHG = O_SRET + 4194304, O_SSSD = O_SHG + 4194304, O_SCONV = O_SSSD + 8388608, O_SS5R = O_SCONV + 589824, O_SS5I = O_SS5R + 262144, O_END = O_SS5I + 262144;
constexpr size_t W_CTL = 0, W_BAR = 4096, W_WIN = 32768, W_WOUT = W_WIN + (size_t)2 * NPROJ * DM * 2, W_WUP = W_WOUT + (size_t)2 * DM * DM * 2, W_WDN = W_WUP + (size_t)2 * DFF * DM * 2, W_WGLU = W_WDN + (size_t)2 * DM * DFF * 2,
                 W_XB = W_WGLU + (size_t)2 * 256 * 256 * 2, W_MIX = W_XB + (size_t)TT * DM * 2, W_SSQ = W_MIX + (size_t)TT * DM * 2, W_SSDSQ = W_SSQ + (size_t)TT * 16 * 4, W_RSTD = W_SSDSQ + (size_t)TT * 4 * 4, W_HID = W_RSTD + (size_t)TT * 4,
                 W_END = W_HID + (size_t)TT * DFF * 2;
constexpr size_t W_PROJ = W_HID;
constexpr size_t W_YPRE = W_HID + (size_t)TT * NPROJ * 2;
static_assert(W_YPRE + (size_t)TT * 256 * 2 <= W_END, "ypre fits");
static_assert(W_END <= 268435456ull, "workspace fits 256 MiB");

struct Params { const float* in[N_IN]; float* out; unsigned char* ws; };
constexpr size_t W_TAB = 2048;
struct Ctx { float* out; unsigned char* ws; __device__ __forceinline__ const float* in(int i) const { return ((const float* const*)(ws + W_TAB))[i]; } };

__device__ __forceinline__ float bf2f(unsigned short b) { return __uint_as_float(((unsigned)b) << 16); }
__device__ __forceinline__ unsigned short f2bf(float f) { return __builtin_bit_cast(unsigned short, (__bf16)f); }
__device__ __forceinline__ float sigmoidf_(float x) { return 1.0f / (1.0f + __expf(-x)); }
__device__ __forceinline__ float siluf_(float x) { return x / (1.0f + __expf(-x)); }
__device__ __forceinline__ void unpack8(const u32x4 w, float (&f)[8]) {
    f[0] = __uint_as_float(w.x << 16); f[1] = __uint_as_float(w.x & 0xffff0000u); f[2] = __uint_as_float(w.y << 16); f[3] = __uint_as_float(w.y & 0xffff0000u);
    f[4] = __uint_as_float(w.z << 16); f[5] = __uint_as_float(w.z & 0xffff0000u); f[6] = __uint_as_float(w.w << 16); f[7] = __uint_as_float(w.w & 0xffff0000u);
}
__device__ __forceinline__ u32x4 pack8(const float (&f)[8]) { u32x4 w; w.x = cvt_pk_bf16(f[0], f[1]); w.y = cvt_pk_bf16(f[2], f[3]); w.z = cvt_pk_bf16(f[4], f[5]); w.w = cvt_pk_bf16(f[6], f[7]); return w; }

template <int MODE>
__device__ __forceinline__ void convert_wt(const float* src, int ldsrc, bf16_t* dst, int K, int N, const float* kscale, ldsp lds, int vb, int nvb) {
    LAS float* tile = (LAS float*)lds;
    const int tid = pg8::opaque_tid(), nkt = K / 64, ntile = nkt * (N / 256);
    for (int tl = vb; tl < ntile; tl += nvb) {
        const int k0 = (tl % nkt) * 64, n0 = (tl / nkt) * 256;
#pragma unroll
        for (int i = 0; i < 8; ++i) {
            const int idx = tid + i * 512, kk = idx >> 6, n = n0 + (idx & 63) * 4;
            int sc = n;
            if (MODE == 1) sc = (n < 3072) ? n : (n < 3328 ? n + 4 : (n < 3332 ? n - 256 : -1));
            f32x4 v = {0.f, 0.f, 0.f, 0.f};
            if (sc >= 0) { v = *(const f32x4*)(src + (size_t)(k0 + kk) * ldsrc + sc); if (kscale) v = v * kscale[k0 + kk]; }
            *(LAS f32x4*)(tile + kk * 260 + (idx & 63) * 4) = v;
        }
        __syncthreads();
#pragma unroll
        for (int i = 0; i < 4; ++i) {
            const int idx = tid + i * 512, nl = idx >> 3, k8 = (idx & 7) * 8;
            float f[8];
#pragma unroll
            for (int j = 0; j < 8; ++j) f[j] = tile[(k8 + j) * 260 + nl];
            *(u32x4*)(dst + (size_t)(n0 + nl) * K + k0 + k8) = pack8(f);
        }
        __syncthreads();
    }
}
__device__ __forceinline__ void phase0(const Params& P, ldsp lds) {
    unsigned char* ws = P.ws;
    const int G = gridDim.x, b = blockIdx.x;
    for (int l = 0; l < 2; ++l) {
        convert_wt<1>(P.in[I_WIN] + (size_t)l * DM * INC, INC, (bf16_t*)(ws + W_WIN) + (size_t)l * NPROJ * DM, DM, NPROJ, P.in[I_NMIX] + l * DM, lds, b, G);
        convert_wt<0>(P.in[I_WOUT] + (size_t)l * DM * DM, DM, (bf16_t*)(ws + W_WOUT) + (size_t)l * DM * DM, DM, DM, nullptr, lds, (b + 64) % G, G);
        convert_wt<0>(P.in[I_WUP] + (size_t)l * DM * DFF, DFF, (bf16_t*)(ws + W_WUP) + (size_t)l * DFF * DM, DM, DFF, P.in[I_NMLP] + l * DM, lds, (b + 128) % G, G);
        convert_wt<0>(P.in[I_WDOWN] + (size_t)l * DFF * DM, DM, (bf16_t*)(ws + W_WDN) + (size_t)l * DM * DFF, DFF, DM, nullptr, lds, (b + 192) % G, G);
        convert_wt<0>(P.in[I_GLUW] + (size_t)l * 256 * 256, 256, (bf16_t*)(ws + W_WGLU) + (size_t)l * 256 * 256, 256, 256, nullptr, lds, (b + 32) % G, G);
    }
    const int tid_ = pg8::opaque_tid(), wave = tid_ >> 6, lane = tid_ & 63;
    bf16_t* XB = (bf16_t*)(ws + W_XB); float* SSQ = (float*)(ws + W_SSQ);
    const int stride = G * 8;
    for (int rb = b * 8 + wave; rb < TT; rb += 4 * stride) {
        f32x4 v[4][4];
#pragma unroll
        for (int u = 0; u < 4; ++u) {
            const int row = rb + u * stride;
            const float* xp = (row < T_P) ? (P.in[I_XP] + (size_t)row * DM) : (P.in[I_XS] + (size_t)(row - T_P) * DM);
#pragma unroll
            for (int j = 0; j < 4; ++j) v[u][j] = (row < TT) ? *(const f32x4*)(xp + j * 256 + lane * 4) : (f32x4){0.f, 0.f, 0.f, 0.f};
        }
#pragma unroll
        for (int u = 0; u < 4; ++u) {
            const int row = rb + u * stride;
            if (row < TT) {
                float s = 0.f;
#pragma unroll
                for (int j = 0; j < 4; ++j) {
                    const f32x4 x = v[u][j];
                    s += (x[0] * x[0] + x[1] * x[1]) + (x[2] * x[2] + x[3] * x[3]);
                    u32x2 w; w.x = cvt_pk_bf16(x[0], x[1]); w.y = cvt_pk_bf16(x[2], x[3]);
                    *(u32x2*)(XB + (size_t)row * DM + j * 256 + lane * 4) = w;
                    if (row >= T_P) *(f32x4*)(P.out + (size_t)row * DM + j * 256 + lane * 4) = x;
                }
#pragma unroll
                for (int o = 32; o >= 1; o >>= 1) s += __shfl_xor(s, o);
                if (lane < 16) SSQ[(size_t)row * 16 + lane] = (lane == 0) ? s : 0.f;
                if (lane == 0) ((float*)(ws + W_RSTD))[row] = rsqrtf(s * (1.0f / 1024.0f) + 1e-6f);
            }
        }
    }
}

constexpr int QS = 136, RS = 72, OS = 68;
constexpr int L_QI = 0, L_KI = 17408, L_KDT = 34816, L_VT = 53248, L_ST = 62464, L_FL = 79872, L_P = 83968, L_OB = 93184, L_XT = 110592, L_RAW = L_P, L_QSLOT = 130048;
constexpr int F_B = 0, F_RS = 64, F_CS = 128, F_DL = 256, F_KS = 320, F_SEG = 384;

__device__ __forceinline__ void lds_barrier() { asm volatile("s_waitcnt lgkmcnt(0)" ::: "memory"); __builtin_amdgcn_s_barrier(); asm volatile("" ::: "memory"); }
__device__ __forceinline__ f32x4 mma_tile(const LAS bf16_t* A, int lda, const LAS bf16_t* B, int ldb, int K, f32x4 acc, int r, int q) {
    for (int k0 = 0; k0 < K; k0 += 32) {
        const bf16x8 a = *(const LAS bf16x8*)(A + r * lda + k0 + q * 8);
        const bf16x8 b = *(const LAS bf16x8*)(B + r * ldb + k0 + q * 8);
        acc = __builtin_amdgcn_mfma_f32_16x16x32_bf16(a, b, acc, 0, 0, 0);
    }
    return acc;
}
template <int DK, int DMODE>
__device__ __forceinline__ void la_scores(ldsp lds, int wave, int lane, float lg2) {
    const LAS bf16_t* Qi = (const LAS bf16_t*)(lds + L_QI); const LAS bf16_t* Ki = (const LAS bf16_t*)(lds + L_KI);
    LAS bf16_t* Pm = (LAS bf16_t*)(lds + L_P); const LAS float* FL = (const LAS float*)(lds + L_FL);
    const int r = lane & 15, q = lane >> 4;
#pragma unroll
    for (int i = 0; i < 2; ++i) {
        const int id = wave * 2 + i, tm = id >> 2, tn = id & 3;
        f32x4 acc = {0.f, 0.f, 0.f, 0.f};
        if (tn <= tm) acc = mma_tile(Qi + tm * 16 * QS, QS, Ki + tn * 16 * QS, QS, DK, acc, r, q);
#pragma unroll
        for (int j = 0; j < 4; ++j) {
            const int t = tm * 16 + q * 4 + j, s = tn * 16 + r;
            float v = acc[j];
            if (DMODE == 1) v *= exp2f((float)(t - s) * lg2);
            if (DMODE == 2) v *= __expf(fminf(FL[F_B + t] - FL[F_B + s], 0.f));
            v = (s <= t) ? v : 0.f;
            Pm[t * RS + s] = f2bf(v);
        }
    }
}
template <int DK, bool SEPQC>
__device__ __forceinline__ void la_out(ldsp lds, int wave, int lane) {
    const LAS bf16_t* Qx = (const LAS bf16_t*)(lds + (SEPQC ? L_XT : L_QI)); const LAS bf16_t* Pm = (const LAS bf16_t*)(lds + L_P);
    const LAS bf16_t* Vt = (const LAS bf16_t*)(lds + L_VT); const LAS bf16_t* St = (const LAS bf16_t*)(lds + L_ST);
    LAS float* Ob = (LAS float*)(lds + L_OB); const LAS float* FL = (const LAS float*)(lds + L_FL);
    const int r = lane & 15, q = lane >> 4;
#pragma unroll
    for (int i = 0; i < 2; ++i) {
        const int id = wave * 2 + i, tm = id >> 2, tv = id & 3;
        f32x4 a1 = {0.f, 0.f, 0.f, 0.f}, a2 = {0.f, 0.f, 0.f, 0.f};
        a1 = mma_tile(Pm + tm * 16 * RS, RS, Vt + tv * 16 * RS, RS, 64, a1, r, q);
        a2 = mma_tile(Qx + tm * 16 * QS, QS, St + tv * 16 * QS, QS, DK, a2, r, q);
#pragma unroll
        for (int j = 0; j < 4; ++j) {
            const int t = tm * 16 + q * 4 + j, v = tv * 16 + r;
            Ob[t * OS + v] = a1[j] + (SEPQC ? a2[j] : FL[F_RS + t] * a2[j]);
        }
    }
}
template <int DK>
__device__ __forceinline__ void la_state(ldsp lds, int wave, int lane, f32x4 (&sacc)[DK / 32]) {
    constexpr int NT = DK / 32, TK = DK / 16;
    const LAS bf16_t* Vt = (const LAS bf16_t*)(lds + L_VT); const LAS bf16_t* Kdt = (const LAS bf16_t*)(lds + L_KDT);
    LAS bf16_t* St = (LAS bf16_t*)(lds + L_ST); const LAS float* FL = (const LAS float*)(lds + L_FL);
    const int r = lane & 15, q = lane >> 4;
#pragma unroll
    for (int i = 0; i < NT; ++i) {
        const int id = wave * NT + i, tv = id / TK, tk = id % TK;
        const float sc = FL[F_CS + tk * 16 + r];
        sacc[i] = sacc[i] * sc;
        sacc[i] = mma_tile(Vt + tv * 16 * RS, RS, Kdt + tk * 16 * RS, RS, 64, sacc[i], r, q);
#pragma unroll
        for (int j = 0; j < 4; ++j) St[(tv * 16 + q * 4 + j) * QS + tk * 16 + r] = f2bf(sacc[i][j]);
    }
}
template <int DK>
__device__ __forceinline__ void la_state_init(ldsp lds, int wave, int lane, f32x4 (&sacc)[DK / 32], const float* s0  ) {
    constexpr int NT = DK / 32, TK = DK / 16;
    LAS bf16_t* St = (LAS bf16_t*)(lds + L_ST);
    const int r = lane & 15, q = lane >> 4;
#pragma unroll
    for (int i = 0; i < NT; ++i) {
        const int id = wave * NT + i, tv = id / TK, tk = id % TK;
        f32x4 v = {0.f, 0.f, 0.f, 0.f};
        if (s0) v = *(const f32x4*)(s0 + (size_t)(tk * 16 + r) * 64 + tv * 16 + q * 4);
        sacc[i] = v;
#pragma unroll
        for (int j = 0; j < 4; ++j) St[(tv * 16 + q * 4 + j) * QS + tk * 16 + r] = f2bf(v[j]);
    }
}
template <int DK>
__device__ __forceinline__ void la_state_store(int wave, int lane, const f32x4 (&sacc)[DK / 32], float* so  ) {
    constexpr int NT = DK / 32, TK = DK / 16;
    const int r = lane & 15, q = lane >> 4;
#pragma unroll
    for (int i = 0; i < NT; ++i) {
        const int id = wave * NT + i, tv = id / TK, tk = id % TK;
        *(f32x4*)(so + (size_t)(tk * 16 + r) * 64 + tv * 16 + q * 4) = sacc[i];
    }
}

struct SeqInfo { int L, row0, pos0, b; bool sample; };
__device__ __forceinline__ SeqInfo seq_info(int seq) {
    SeqInfo s;
    if (seq < NB_P) { s.L = LEN_P; s.row0 = seq * LEN_P; s.pos0 = 0; s.b = seq; s.sample = false; }
    else { s.L = LEN_S; s.row0 = T_P + (seq - NB_P) * LEN_S; s.pos0 = 16384; s.b = seq - NB_P; s.sample = true; }
    return s;
}
constexpr int NS = 8, SL = 256;
constexpr size_t SG_RET = 0, SG_HG = SG_RET + (size_t)8 * 4 * NS * 4096 * 4, SG_SSD = SG_HG + (size_t)8 * 4 * NS * 4096 * 4, SG_HGD = SG_SSD + (size_t)8 * 4 * NS * 8192 * 4,
                 SG_SSDD = SG_HGD + (size_t)8 * 4 * NS * 64 * 4, SG_S5 = SG_SSDD + 4096, SG_END = SG_S5 + (size_t)8 * 16 * NS * 64 * 8;
static_assert(SG_END <= (size_t)TT * DM * 2, "segment scratch fits the XB region");

template <int DK, int DMODE>
__device__ __forceinline__ void la_state_scan(ldsp lds, int wave, int lane, f32x4 (&sacc)[DK / 32], const float* segb, int seg, float dsc, const float* dtab) {
    constexpr int NT = DK / 32, TK = DK / 16;
    LAS bf16_t* St = (LAS bf16_t*)(lds + L_ST);
    const int r = lane & 15, q = lane >> 4;
#pragma unroll
    for (int i = 0; i < NT; ++i) sacc[i] = (f32x4){0.f, 0.f, 0.f, 0.f};
#pragma unroll 4
    for (int s = 0; s < seg; ++s) {
#pragma unroll
        for (int i = 0; i < NT; ++i) {
            const int id = wave * NT + i, tv = id / TK, tk = id % TK;
            float sc = dsc;
            if (DMODE == 1) sc = dtab[s * 64 + tk * 16 + r];
            if (DMODE == 2) sc = dtab[s];
            const f32x4 v = *(const f32x4*)(segb + (size_t)s * DK * 64 + (size_t)(tk * 16 + r) * 64 + tv * 16 + q * 4);
            sacc[i] = sacc[i] * sc + v;
        }
    }
#pragma unroll
    for (int i = 0; i < NT; ++i) {
        const int id = wave * NT + i, tv = id / TK, tk = id % TK;
#pragma unroll
        for (int j = 0; j < 4; ++j) St[(tv * 16 + q * 4 + j) * QS + tk * 16 + r] = f2bf(sacc[i][j]);
    }
}

__device__ __forceinline__ void ret_item(const Ctx& P, int l, int seq, int h, int tb, int te, int init, int full, int store, int seg, ldsp lds) {
    const SeqInfo si = seq_info(seq);
    const int tid = pg8::opaque_tid(), wave = tid >> 6, lane = tid & 63;
    const bf16_t* PROJ = (const bf16_t*)(P.ws + W_PROJ); bf16_t* MIX = (bf16_t*)(P.ws + W_MIX);
    LAS bf16_t* Qi = (LAS bf16_t*)(lds + L_QI); LAS bf16_t* Ki = (LAS bf16_t*)(lds + L_KI); LAS bf16_t* Kdt = (LAS bf16_t*)(lds + L_KDT); LAS bf16_t* Vt = (LAS bf16_t*)(lds + L_VT);
    LAS float* FL = (LAS float*)(lds + L_FL); const LAS float* Ob = (const LAS float*)(lds + L_OB);
    const float lg2 = log2f(1.0f - exp2f(-5.0f - (float)h));
    float* segb = (float*)(P.ws + W_XB + SG_RET) + (size_t)((seq & 7) * 4 + h) * NS * 4096;
    f32x4 sacc[2];
    if (init == 2) la_state_scan<64, 0>(lds, wave, lane, sacc, segb, seg, exp2f((float)SL * lg2), nullptr);
    else la_state_init<64>(lds, wave, lane, sacc, init == 1 ? (P.in(I_SRET) + ((size_t)(l * NB_S + si.b) * 4 + h) * 4096) : nullptr);
    const int t = tid >> 3, c0 = (tid & 7) * 8;
    float ang[4];
#pragma unroll
    for (int i = 0; i < 4; ++i) ang[i] = exp2f(-(float)(c0 / 2 + i) * (13.287712379549449f / 31.0f));
    u32x4 rq, rk, rv, rg;
#define RET_LOAD(T0) do { rq = (u32x4){0u, 0u, 0u, 0u}; rk = rq; rv = rq; rg = rq; \
        if ((T0) < te && t < te - (T0)) { const bf16_t* pp_ = PROJ + (size_t)(si.row0 + (T0) + t) * NPROJ + h * 64 + c0; \
            rq = *(const u32x4*)(pp_ + C_RQ); rk = *(const u32x4*)(pp_ + C_RK); rv = *(const u32x4*)(pp_ + C_RV); if (full) rg = *(const u32x4*)(pp_ + C_RG); } } while (0)
    RET_LOAD(tb);
    for (int t0 = tb; t0 < te; t0 += 64) {
        const int nv = min(64, te - t0);
        const bool valid = t < nv;
        const size_t row = (size_t)(si.row0 + t0 + t);
        float qf[8], kf[8], vf[8];
        unpack8(rq, qf); unpack8(rk, kf); unpack8(rv, vf);
        const u32x4 gcur = rg;
        if (valid) {
            const double pos = (double)(si.pos0 + t0 + t);
#pragma unroll
            for (int i = 0; i < 4; ++i) {
                const double tr = pos * (double)ang[i] * 0.15915494309189535;
                const float fr = (float)(tr - floor(tr)) * 6.283185307179586f;
                const float sn = __sinf(fr), cs = __cosf(fr);
                const float q1 = qf[2 * i], q2 = qf[2 * i + 1], k1 = kf[2 * i] * 0.125f, k2 = kf[2 * i + 1] * 0.125f;
                if (full) { qf[2 * i] = q1 * cs - q2 * sn; qf[2 * i + 1] = q1 * sn + q2 * cs; }
                kf[2 * i] = k1 * cs - k2 * sn; kf[2 * i + 1] = k1 * sn + k2 * cs;
            }
        }
        const float gq = exp2f((float)t * lg2), gk = exp2f(-(float)t * lg2);
#pragma unroll
        for (int i = 0; i < 8; ++i) { qf[i] *= gq; kf[i] *= gk; }
        if (full) { *(LAS u32x4*)(Qi + t * QS + c0) = pack8(qf); *(LAS u32x4*)(Ki + t * QS + c0) = pack8(kf); }
        const float kd = exp2f((float)(nv - 1) * lg2);
#pragma unroll
        for (int i = 0; i < 8; ++i) { Kdt[(c0 + i) * RS + t] = f2bf(kf[i] * kd); Vt[(c0 + i) * RS + t] = f2bf(vf[i]); }
        if ((tid & 7) == 0) FL[F_RS + t] = exp2f(lg2);
        if (tid < 64) FL[F_CS + tid] = exp2f((float)nv * lg2);
        RET_LOAD(t0 + 64);
        lds_barrier();
        if (full) {
            la_scores<64, 0>(lds, wave, lane, 0.f);
            lds_barrier();
            la_out<64, false>(lds, wave, lane);
            lds_barrier();
        }
        la_state<64>(lds, wave, lane, sacc);
        if (full) {
            float o[8]; float s = 0.f;
#pragma unroll
            for (int i = 0; i < 8; ++i) { o[i] = Ob[t * OS + c0 + i]; s += o[i]; }
            s += __shfl_xor(s, 1); s += __shfl_xor(s, 2); s += __shfl_xor(s, 4);
            const float mu = s * (1.0f / 64.0f); float vq = 0.f;
#pragma unroll
            for (int i = 0; i < 8; ++i) { o[i] -= mu; vq += o[i] * o[i]; }
            vq += __shfl_xor(vq, 1); vq += __shfl_xor(vq, 2); vq += __shfl_xor(vq, 4);
            const float rstd = rsqrtf(vq * (1.0f / 64.0f) + 1e-6f);
            if (valid) {
                float g[8]; unpack8(gcur, g);
#pragma unroll
                for (int i = 0; i < 8; ++i) o[i] = o[i] * rstd * siluf_(g[i]);
                *(u32x4*)(MIX + row * DM + h * 64 + c0) = pack8(o);
            }
        }
        lds_barrier();
    }
#undef RET_LOAD
    if (store == 1) la_state_store<64>(wave, lane, sacc, P.out + (si.sample ? (O_SRET + ((size_t)(l * NB_S + si.b) * 4 + h) * 4096) : (O_PRET + ((size_t)(l * NB_P + si.b) * 4 + h) * 4096)));
    if (store == 2) la_state_store<64>(wave, lane, sacc, segb + (size_t)seg * 4096);
}

__device__ __forceinline__ void hgrn_item(const Ctx& P, int l, int seq, int h, int tb, int te, int init, int full, int store, int seg, ldsp lds) {
    const SeqInfo si = seq_info(seq);
    const int tid = pg8::opaque_tid(), wave = tid >> 6, lane = tid & 63;
    const bf16_t* PROJ = (const bf16_t*)(P.ws + W_PROJ); bf16_t* MIX = (bf16_t*)(P.ws + W_MIX);
    LAS bf16_t* Qi = (LAS bf16_t*)(lds + L_QI); LAS bf16_t* Ki = (LAS bf16_t*)(lds + L_KI); LAS bf16_t* Kdt = (LAS bf16_t*)(lds + L_KDT); LAS bf16_t* Vt = (LAS bf16_t*)(lds + L_VT);
    LAS bf16_t* Qc = (LAS bf16_t*)(lds + L_XT);
    LAS float* FL = (LAS float*)(lds + L_FL); const LAS float* Ob = (const LAS float*)(lds + L_OB);
    float* segb = (float*)(P.ws + W_XB + SG_HG) + (size_t)((seq & 7) * 4 + h) * NS * 4096;
    float* segd = (float*)(P.ws + W_XB + SG_HGD) + (size_t)((seq & 7) * 4 + h) * NS * 64;
    f32x4 sacc[2];
    if (init == 2) la_state_scan<64, 1>(lds, wave, lane, sacc, segb, seg, 1.f, segd);
    else la_state_init<64>(lds, wave, lane, sacc, init == 1 ? (P.in(I_SHG) + ((size_t)(l * NB_S + si.b) * 4 + h) * 4096) : nullptr);
    const int k = lane, sg = wave;
    float lower = 0.f;
    if (l == 1) { const float a0 = P.in(I_HGLB)[h * 64 + k], a1 = P.in(I_HGLB)[256 + h * 64 + k]; lower = 1.0f / (1.0f + expf(a0 - a1)); }
    const int tp = tid >> 3, c0 = (tid & 7) * 8;
    float cumlog = 0.f;
    unsigned short pq[8], pf[8], pi_[8]; u32x4 rg;
#define HG_LOAD(T0) do { rg = (u32x4){0u, 0u, 0u, 0u}; \
        _Pragma("unroll") for (int j = 0; j < 8; ++j) { pq[j] = 0; pf[j] = 0; pi_[j] = 0; const int tt_ = sg * 8 + j; \
            if ((T0) < te && tt_ < te - (T0)) { const size_t b_ = (size_t)(si.row0 + (T0) + tt_) * NPROJ + h * 64 + k; pq[j] = PROJ[b_ + C_HQ]; pf[j] = PROJ[b_ + C_HF]; pi_[j] = PROJ[b_ + C_HI]; } } \
        if (full && (T0) < te && tp < te - (T0)) rg = *(const u32x4*)(PROJ + (size_t)(si.row0 + (T0) + tp) * NPROJ + C_HG + h * 64 + c0); } while (0)
    HG_LOAD(tb);
    for (int t0 = tb; t0 < te; t0 += 64) {
        const int nv = min(64, te - t0);
        float cs[8], ky[8], qs[8], vv[8];
        float run = 0.f;
#pragma unroll
        for (int j = 0; j < 8; ++j) {
            const int t = sg * 8 + j;
            float lf = 0.f; ky[j] = 0.f; qs[j] = 0.f; vv[j] = 0.f;
            if (t < nv) {
                const float qq = bf2f(pq[j]), ff = bf2f(pf[j]), ii = bf2f(pi_[j]);
                const float ef = __expf(-fminf(fmaxf(ff, -30.f), 30.f));
                const float sgm = 1.0f / (1.0f + ef);
                const float forget = lower + (1.0f - lower) * sgm;
                lf = __logf(fmaxf(forget, 1e-30f));
                ky[j] = (1.0f - lower) * ef * sgm;
                if (full) qs[j] = qq / (1.0f + __expf(-qq));
                vv[j] = ii;
            }
            run += lf; cs[j] = run;
        }
        const u32x4 gcur = rg;
        FL[F_SEG + sg * 64 + k] = run;
        HG_LOAD(t0 + 64);
        lds_barrier();
        float pre = 0.f, tot = 0.f, bref = 0.f;
#pragma unroll
        for (int s = 0; s < 8; ++s) { const float x = FL[F_SEG + s * 64 + k]; if (s < sg) pre += x; if (s < 4) bref += x; tot += x; }
        cumlog += tot;
        const float eb = __expf(bref), et = __expf(tot - bref);
        float kdv[8];
#pragma unroll
        for (int j = 0; j < 8; ++j) {
            const int t = sg * 8 + j; const float b = pre + cs[j];
            if (full) {
                const float e1 = __expf(fminf(fmaxf(b - bref, -80.f), 80.f)), r1 = __builtin_amdgcn_rcpf(e1);
                Qi[t * QS + k] = f2bf(qs[j] * e1);
                Ki[t * QS + k] = f2bf(ky[j] * r1);
                Qc[t * QS + k] = f2bf(qs[j] * e1 * eb);
                kdv[j] = ky[j] * r1 * et;
            } else kdv[j] = ky[j] * __expf(tot - b);
        }
        *(LAS u32x4*)(Kdt + k * RS + sg * 8) = pack8(kdv);
        *(LAS u32x4*)(Vt + k * RS + sg * 8) = pack8(vv);
        if (sg == 0) FL[F_CS + k] = __expf(tot);
        lds_barrier();
        if (full) {
            la_scores<64, 0>(lds, wave, lane, 0.f);
            lds_barrier();
            la_out<64, true>(lds, wave, lane);
            lds_barrier();
        }
        la_state<64>(lds, wave, lane, sacc);
        if (full) {
            float o[8]; float s = 0.f;
#pragma unroll
            for (int i = 0; i < 8; ++i) { o[i] = Ob[tp * OS + c0 + i]; s += o[i] * o[i]; }
            s += __shfl_xor(s, 1); s += __shfl_xor(s, 2); s += __shfl_xor(s, 4);
            const float rstd = rsqrtf(s * (1.0f / 64.0f) + 1e-6f);
            if (tp < nv) {
                const size_t row = (size_t)(si.row0 + t0 + tp);
                float g[8]; unpack8(gcur, g);
#pragma unroll
                for (int i = 0; i < 8; ++i) o[i] = o[i] * rstd * siluf_(g[i]);
                *(u32x4*)(MIX + row * DM + 256 + h * 64 + c0) = pack8(o);
            }
        }
        lds_barrier();
    }
#undef HG_LOAD
    if (store == 1) la_state_store<64>(wave, lane, sacc, P.out + (si.sample ? (O_SHG + ((size_t)(l * NB_S + si.b) * 4 + h) * 4096) : (O_PHG + ((size_t)(l * NB_P + si.b) * 4 + h) * 4096)));
    if (store == 2) { la_state_store<64>(wave, lane, sacc, segb + (size_t)seg * 4096); if (sg == 0) segd[seg * 64 + k] = __expf(cumlog); }
}

constexpr int L_CW = 131136;
__device__ __forceinline__ void ssd_item(const Ctx& P, int l, int seq, int h, int tb, int te, int init, int full, int store, int seg, ldsp lds) {
    const SeqInfo si = seq_info(seq);
    const int tid = pg8::opaque_tid(), wave = tid >> 6, lane = tid & 63, g = h >> 1;
    const bf16_t* PROJ = (const bf16_t*)(P.ws + W_PROJ); bf16_t* MIX = (bf16_t*)(P.ws + W_MIX); float* SSDSQ = (float*)(P.ws + W_SSDSQ);
    LAS bf16_t* Qi = (LAS bf16_t*)(lds + L_QI); LAS bf16_t* Ki = (LAS bf16_t*)(lds + L_KI); LAS bf16_t* Kdt = (LAS bf16_t*)(lds + L_KDT); LAS bf16_t* Vt = (LAS bf16_t*)(lds + L_VT);
    LAS bf16_t* RAW = (LAS bf16_t*)(lds + L_RAW);
    LAS float* FL = (LAS float*)(lds + L_FL); const LAS float* Ob = (const LAS float*)(lds + L_OB); LAS float* CW = (LAS float*)(lds + L_CW);
    float* segb = (float*)(P.ws + W_XB + SG_SSD) + (size_t)((seq & 7) * 4 + h) * NS * 8192;
    float* segd = (float*)(P.ws + W_XB + SG_SSDD) + (size_t)((seq & 7) * 4 + h) * NS;
    const float* cbuf = si.sample ? (P.in(I_SCONV) + (size_t)(l * NB_S + si.b) * 3 * 768) : nullptr;
    f32x4 sacc[4];
    if (init == 2) la_state_scan<128, 2>(lds, wave, lane, sacc, segb, seg, 1.f, segd);
    else la_state_init<128>(lds, wave, lane, sacc, init == 1 ? (P.in(I_SSSD) + ((size_t)(l * NB_S + si.b) * 4 + h) * 8192) : nullptr);
    const float dtb = P.in(I_DTB)[l * 4 + h], aexp = expf(P.in(I_ALOG)[l * 4 + h]), dsk = P.in(I_SSDD)[l * 4 + h];
    if (tid < 320) {
        const int cc = (tid < 64) ? (h * 64 + tid) : (tid < 192 ? 256 + g * 128 + (tid - 64) : 512 + g * 128 + (tid - 192));
        const float* cwp = P.in(I_CONVW) + (size_t)l * 4 * 768;
        CW[tid] = cwp[cc]; CW[320 + tid] = cwp[768 + cc]; CW[640 + tid] = cwp[2 * 768 + cc]; CW[960 + tid] = cwp[3 * 768 + cc]; CW[1280 + tid] = P.in(I_CONVB)[l * 768 + cc];
    }
    const int tp = tid >> 3, c0 = (tid & 7) * 8;
    float cumlog = 0.f;
    u32x4 rw[6]; u32x4 rz; unsigned short rdt;
    int stt[6], ssrc[6], slds[6];
#pragma unroll
    for (int i = 0; i < 6; ++i) { const int idx = tid + i * 512, tt = idx / 40, v8 = idx % 40;
        stt[i] = idx < 67 * 40 ? tt : -1000000; slds[i] = tt * 320 + v8 * 8;
        ssrc[i] = (v8 < 8) ? (h * 64 + v8 * 8) : (v8 < 24 ? 256 + g * 128 + (v8 - 8) * 8 : 512 + g * 128 + (v8 - 24) * 8); }
#define SSD_LOAD(T0) do { \
        _Pragma("unroll") for (int i_ = 0; i_ < 6; ++i_) { rw[i_] = (u32x4){0u, 0u, 0u, 0u}; const int ts_ = (T0) - 3 + stt[i_]; \
            if (stt[i_] >= 0 && (T0) < te) { const int sc_ = ssrc[i_]; \
                if (ts_ >= 0 && ts_ < te) rw[i_] = *(const u32x4*)(PROJ + (size_t)(si.row0 + ts_) * NPROJ + C_XBC + sc_); \
                else if (ts_ < 0 && cbuf) { const f32x4 a_ = *(const f32x4*)(cbuf + (ts_ + 3) * 768 + sc_), b_ = *(const f32x4*)(cbuf + (ts_ + 3) * 768 + sc_ + 4); \
                    rw[i_].x = cvt_pk_bf16(a_[0], a_[1]); rw[i_].y = cvt_pk_bf16(a_[2], a_[3]); rw[i_].z = cvt_pk_bf16(b_[0], b_[1]); rw[i_].w = cvt_pk_bf16(b_[2], b_[3]); } } } \
        rdt = 0; if (wave == 7 && (T0) < te && lane < te - (T0)) rdt = PROJ[(size_t)(si.row0 + (T0) + lane) * NPROJ + C_DT + h]; \
        rz = (u32x4){0u, 0u, 0u, 0u}; if (full && (T0) < te && tp < te - (T0)) rz = *(const u32x4*)(PROJ + (size_t)(si.row0 + (T0) + tp) * NPROJ + C_SZ + h * 64 + c0); } while (0)
    SSD_LOAD(tb);
    for (int t0 = tb; t0 < te; t0 += 64) {
        const int nv = min(64, te - t0);
#pragma unroll
        for (int i = 0; i < 6; ++i) { if (stt[i] >= 0) *(LAS u32x4*)(RAW + slds[i]) = rw[i]; }
        const u32x4 zcur = rz;
        if (wave == 7) {
            const int t = lane; float delta = 0.f, la = 0.f;
            if (t < nv) {
                const float dtv = bf2f(rdt) + dtb;
                delta = (dtv > 20.f) ? dtv : log1pf(__expf(dtv));
                la = -delta * aexp;
            }
            float b = la;
#pragma unroll
            for (int o = 1; o < 64; o <<= 1) { const float x = __shfl_up(b, o); if (lane >= o) b += x; }
            const float bl = __shfl(b, 63);
            cumlog += bl;
            FL[F_B + t] = b; FL[F_RS + t] = __expf(b); FL[F_DL + t] = delta; FL[F_KS + t] = delta * __expf(bl - b);
            FL[F_CS + t] = __expf(bl); FL[F_CS + 64 + t] = __expf(bl);
        }
        SSD_LOAD(t0 + 64);
        lds_barrier();
        for (int u = tid; u < 2560; u += 512) {
            const int c = u % 320, oc = u / 320;
            if (!full && c >= 192) continue;
            const float w0 = CW[c], w1 = CW[320 + c], w2 = CW[640 + c], w3 = CW[960 + c], bb = CW[1280 + c];
            float x0 = bf2f(RAW[(oc * 8 + 0) * 320 + c]), x1 = bf2f(RAW[(oc * 8 + 1) * 320 + c]), x2 = bf2f(RAW[(oc * 8 + 2) * 320 + c]);
            float ov[8];
#pragma unroll
            for (int j = 0; j < 8; ++j) {
                const int t = oc * 8 + j;
                const float x3 = bf2f(RAW[(t + 3) * 320 + c]);
                float v = bb + w0 * x0 + w1 * x1 + w2 * x2 + w3 * x3;
                v = siluf_(v);
                if (t >= nv) v = 0.f;
                ov[j] = v;
                x0 = x1; x1 = x2; x2 = x3;
            }
            if (c < 64) *(LAS u32x4*)(Vt + c * RS + oc * 8) = pack8(ov);
            else if (c < 192) {
                const int n = c - 64;
                if (full) {
#pragma unroll
                    for (int j = 0; j < 8; ++j) Ki[(oc * 8 + j) * QS + n] = f2bf(ov[j] * FL[F_DL + oc * 8 + j]);
                }
#pragma unroll
                for (int j = 0; j < 8; ++j) ov[j] *= FL[F_KS + oc * 8 + j];
                *(LAS u32x4*)(Kdt + n * RS + oc * 8) = pack8(ov);
            } else {
                const int n = c - 192;
#pragma unroll
                for (int j = 0; j < 8; ++j) Qi[(oc * 8 + j) * QS + n] = f2bf(ov[j]);
            }
        }
        lds_barrier();
        if (full) {
            la_scores<128, 2>(lds, wave, lane, 0.f);
            lds_barrier();
            la_out<128, false>(lds, wave, lane);
            lds_barrier();
        }
        la_state<128>(lds, wave, lane, sacc);
        if (full) {
            float o[8]; float s = 0.f;
            const size_t row = (size_t)(si.row0 + t0 + tp);
            float z[8]; unpack8(zcur, z);
#pragma unroll
            for (int i = 0; i < 8; ++i) { const float xs = bf2f(Vt[(c0 + i) * RS + tp]); o[i] = (Ob[tp * OS + c0 + i] + dsk * xs) * siluf_(z[i]); s += o[i] * o[i]; }
            s += __shfl_xor(s, 1); s += __shfl_xor(s, 2); s += __shfl_xor(s, 4);
            if (tp < nv) {
                *(u32x4*)(MIX + row * DM + 512 + h * 64 + c0) = pack8(o);
                if ((tid & 7) == 0) SSDSQ[row * 4 + h] = s;
            }
        }
        lds_barrier();
    }
#undef SSD_LOAD
    if (store == 1) la_state_store<128>(wave, lane, sacc, P.out + (si.sample ? (O_SSSD + ((size_t)(l * NB_S + si.b) * 4 + h) * 8192) : (O_PSSD + ((size_t)(l * NB_P + si.b) * 4 + h) * 8192)));
    if (store == 2) { la_state_store<128>(wave, lane, sacc, segb + (size_t)seg * 8192); if (tid == 7 * 64) segd[seg] = __expf(cumlog); }
    if (store == 1 && h == 0) {
        float* co = P.out + (si.sample ? (O_SCONV + (size_t)(l * NB_S + si.b) * 2304) : (O_PCONV + (size_t)(l * NB_P + si.b) * 2304));
        for (int idx = tid; idx < 2304; idx += 512) { const int rr = idx / 768, c = idx % 768; co[idx] = bf2f(PROJ[(size_t)(si.row0 + si.L - 3 + rr) * NPROJ + C_XBC + c]); }
    }
}

constexpr int S5W = 15360, S5_U = 0, S5_SB = 2048, S5_CB = 2048 + 8704, S5S = 136, S5C = 32;
__device__ __forceinline__ void s5_item(const Ctx& P, int l, int oct, int seq_b, int nseq, int tb, int te, int init, int full, int store, int seg, ldsp lds) {
    typedef float f32x2 __attribute__((ext_vector_type(2)));
    const int tid = pg8::opaque_tid(), w = tid >> 6, p = tid & 63, g = oct * 8 + w;
    const bf16_t* PROJ = (const bf16_t*)(P.ws + W_PROJ); bf16_t* YPRE = (bf16_t*)(P.ws + W_YPRE);
    LAS float* U = (LAS float*)(lds + w * S5W + S5_U); LAS bf16_t* Sb = (LAS bf16_t*)(lds + w * S5W + S5_SB); LAS bf16_t* Cb = (LAS bf16_t*)(lds + w * S5W + S5_CB);
    const int lg = l * 16 + g;
    const float are = P.in(I_S5AR)[lg * 64 + p], aim = P.in(I_S5AI)[lg * 64 + p], step = expf(P.in(I_S5DT)[lg]);
    const float mag = expf(are * step), angr = aim * step;
    const float abr = mag * cosf(angr), abi = mag * sinf(angr);
    const float d2 = are * are + aim * aim, nr = abr - 1.0f;
    const float cr = (nr * are + abi * aim) / d2, ci = (abi * are - nr * aim) / d2;
    f32x2 bb[16];
    {
        const f32x4* br = (const f32x4*)(P.in(I_S5BR) + ((size_t)lg * 64 + p) * 16); const f32x4* bi = (const f32x4*)(P.in(I_S5BI) + ((size_t)lg * 64 + p) * 16);
#pragma unroll
        for (int q4 = 0; q4 < 4; ++q4) { const f32x4 a = br[q4], b = bi[q4];
#pragma unroll
            for (int j = 0; j < 4; ++j) bb[q4 * 4 + j] = (f32x2){cr * a[j] - ci * b[j], cr * b[j] + ci * a[j]}; }
    }
#pragma unroll
    for (int hh = 0; hh < 16; ++hh)
        *(LAS unsigned*)(Cb + hh * S5S + 2 * p) = cvt_pk_bf16(P.in(I_S5CR)[((size_t)lg * 16 + hh) * 64 + p], -P.in(I_S5CI)[((size_t)lg * 16 + hh) * 64 + p]);
    const int r = p & 15, q = p >> 4;
    const float dk = P.in(I_S5D)[l * 256 + g * 16 + r];
    const int ut = p >> 1, uc = (p & 1) * 8;
    for (int sq = seq_b; sq < seq_b + nseq; ++sq) {
        const SeqInfo si = seq_info(sq);
        float sr = 0.f, sim = 0.f;
        if (init == 1) { sr = P.in(I_S5RE)[((size_t)(l * NB_S + si.b) * 16 + g) * 64 + p]; sim = P.in(I_S5IM)[((size_t)(l * NB_S + si.b) * 16 + g) * 64 + p]; }
        f32x2* segs = (f32x2*)(P.ws + W_XB + SG_S5) + (size_t)((sq & 7) * 16 + g) * NS * 64;
        if (init == 2) {
            float qr = abr, qi = abi;
            for (int s = 1; s < SL; s <<= 1) { const float nr_ = qr * qr - qi * qi, ni_ = 2.f * qr * qi; qr = nr_; qi = ni_; }
            for (int s = 0; s < seg; ++s) { const f32x2 e = segs[s * 64 + p]; const float nr_ = qr * sr - qi * sim + e.x, ni_ = qr * sim + qi * sr + e.y; sr = nr_; sim = ni_; }
        }
        u32x4 ru;
#define S5_LOAD(T0) do { ru = (u32x4){0u, 0u, 0u, 0u}; if ((T0) < te && ut < te - (T0)) ru = *(const u32x4*)(PROJ + (size_t)(si.row0 + (T0) + ut) * NPROJ + C_U + g * 16 + uc); } while (0)
        S5_LOAD(tb);
        for (int t0 = tb; t0 < te; t0 += S5C) {
            const int nv = min(S5C, te - t0);
            { float uf[8]; unpack8(ru, uf);
              *(LAS f32x4*)(U + ut * 16 + uc) = (f32x4){uf[0], uf[1], uf[2], uf[3]}; *(LAS f32x4*)(U + ut * 16 + uc + 4) = (f32x4){uf[4], uf[5], uf[6], uf[7]}; }
            S5_LOAD(t0 + S5C);
            asm volatile("s_waitcnt lgkmcnt(0)" ::: "memory"); __builtin_amdgcn_wave_barrier();
            float xr = sr, xi = sim;
            const int nvr = (nv + 3) & ~3;
#pragma unroll 4
            for (int t = 0; t < nvr; ++t) {
                const LAS f32x4* up = (const LAS f32x4*)(U + t * 16);
                f32x2 bu = {0.f, 0.f};
#pragma unroll
                for (int q4 = 0; q4 < 4; ++q4) { const f32x4 u4 = up[q4];
#pragma unroll
                    for (int e = 0; e < 4; ++e) bu += bb[q4 * 4 + e] * u4[e]; }
                const float nxr = abr * xr - abi * xi + bu.x, nxi = abr * xi + abi * xr + bu.y;
                xr = nxr; xi = nxi;
                if (full) *(LAS unsigned*)(Sb + t * S5S + 2 * p) = cvt_pk_bf16(xr, xi);
            }
            sr = xr; sim = xi;
            if (full) {
                asm volatile("s_waitcnt lgkmcnt(0)" ::: "memory"); __builtin_amdgcn_wave_barrier();
#pragma unroll
                for (int m = 0; m < 2; ++m) {
                    if (m * 16 >= nv) break;
                    f32x4 acc = {0.f, 0.f, 0.f, 0.f};
                    acc = mma_tile(Sb + m * 16 * S5S, S5S, Cb, S5S, 128, acc, r, q);
#pragma unroll
                    for (int j = 0; j < 4; ++j) {
                        const int t = m * 16 + q * 4 + j;
                        const float y = acc[j] + dk * U[t * 16 + r];
                        const float z = 0.7978845608028654f * (y + 0.044715f * y * y * y);
                        const float gl = y * (1.0f - 1.0f / (__expf(2.0f * z) + 1.0f));
                        if (t < nv) YPRE[(size_t)(si.row0 + t0 + t) * 256 + g * 16 + r] = f2bf(gl);
                    }
                }
                asm volatile("s_waitcnt lgkmcnt(0)" ::: "memory"); __builtin_amdgcn_wave_barrier();
            }
        }
#undef S5_LOAD
        if (store == 1) {
            float* ore = P.out + (si.sample ? (O_SS5R + ((size_t)(l * NB_S + si.b) * 16 + g) * 64) : (O_PS5R + ((size_t)(l * NB_P + si.b) * 16 + g) * 64));
            float* oim = P.out + (si.sample ? (O_SS5I + ((size_t)(l * NB_S + si.b) * 16 + g) * 64) : (O_PS5I + ((size_t)(l * NB_P + si.b) * 16 + g) * 64));
            ore[p] = sr; oim[p] = sim;
        }
        if (store == 2) segs[seg * 64 + p] = (f32x2){sr, sim};
    }
}

__device__ __forceinline__ float rdl(float x, int k) { return __uint_as_float((unsigned)__builtin_amdgcn_readlane((int)__float_as_uint(x), k)); }
__device__ __forceinline__ float wsum(float x) {
#pragma unroll
    for (int o = 32; o >= 1; o >>= 1) x += __shfl_xor(x, o);
    return x;
}
__device__ __forceinline__ void rh_sample_wave(const Ctx& P, int l, int b, int h, int lane, int isret) {
    const bf16_t* PROJ = (const bf16_t*)(P.ws + W_PROJ); bf16_t* MIX = (bf16_t*)(P.ws + W_MIX);
    const size_t so_ = ((size_t)(l * NB_S + b) * 4 + h) * 4096;
    const float* s0 = P.in(isret ? I_SRET : I_SHG) + so_; float* so = P.out + (isret ? O_SRET : O_SHG) + so_;
    float S[64];
#pragma unroll
    for (int k = 0; k < 64; ++k) S[k] = s0[k * 64 + lane];
    const float gam = 1.0f - exp2f(-5.0f - (float)h);
    const float angk = exp2f(-(float)(lane >> 1) * (13.287712379549449f / 31.0f)) * 0.15915494309189535f;
    float lower = 0.f;
    if (!isret && l == 1) { const float a0 = P.in(I_HGLB)[h * 64 + lane], a1 = P.in(I_HGLB)[256 + h * 64 + lane]; lower = 1.0f / (1.0f + expf(a0 - a1)); }
    const int cb = isret ? 0 : C_HQ;
#pragma unroll 1
    for (int t = 0; t < LEN_S; ++t) {
        const size_t row = (size_t)(T_P + b * LEN_S + t);
        const bf16_t* pp = PROJ + row * NPROJ + cb + h * 64 + lane;
        const float x0 = bf2f(pp[0]), x1 = bf2f(pp[256]), val = bf2f(pp[512]), g = bf2f(pp[768]);
        float dec, key, qry;
        if (isret) {
            const float tr = (float)(16384 + t) * angk;
            const float fr = (tr - floorf(tr)) * 6.283185307179586f;
            const float sn = __sinf(fr), cs = __cosf(fr);
            const float qp = __shfl_xor(x0, 1), kp = __shfl_xor(x1, 1);
            qry = (lane & 1) ? (qp * sn + x0 * cs) : (x0 * cs - qp * sn);
            key = ((lane & 1) ? (kp * sn + x1 * cs) : (x1 * cs - kp * sn)) * 0.125f;
            dec = gam;
        } else {
            const float ef = __expf(-fminf(fmaxf(x1, -30.f), 30.f)), sgm = 1.0f / (1.0f + ef);
            dec = fmaxf(lower + (1.0f - lower) * sgm, 1e-30f); key = (1.0f - lower) * ef * sgm; qry = x0 / (1.0f + __expf(-x0));
        }
        float o = 0.f;
#pragma unroll
        for (int kk = 0; kk < 64; ++kk) { const float dk = rdl(dec, kk), kyk = rdl(key, kk), qk = rdl(qry, kk); S[kk] = fmaf(kyk, val, dk * S[kk]); o = fmaf(qk, S[kk], o); if ((kk & 7) == 7) __builtin_amdgcn_sched_barrier(0); }
        const float mu = isret ? wsum(o) * (1.0f / 64.0f) : 0.f, d = o - mu;
        const float var = wsum(d * d) * (1.0f / 64.0f);
        MIX[row * DM + (isret ? 0 : 256) + h * 64 + lane] = f2bf(d * rsqrtf(var + 1e-6f) * siluf_(g));
    }
#pragma unroll
    for (int k = 0; k < 64; ++k) so[k * 64 + lane] = S[k];
}
__device__ __forceinline__ void ssd_sample_wave(const Ctx& P, int l, int b, int h, int lane, LAS float* YL  ) {
    const bf16_t* PROJ = (const bf16_t*)(P.ws + W_PROJ); bf16_t* MIX = (bf16_t*)(P.ws + W_MIX); float* SSDSQ = (float*)(P.ws + W_SSDSQ);
    const int g = h >> 1;
    const size_t so_ = ((size_t)(l * NB_S + b) * 4 + h) * 8192;
    const float* s0 = P.in(I_SSSD) + so_; float* so = P.out + O_SSSD + so_;
    const float dtb = P.in(I_DTB)[l * 4 + h], aexp = expf(P.in(I_ALOG)[l * 4 + h]), dsk = P.in(I_SSDD)[l * 4 + h];
    const float* cwp = P.in(I_CONVW) + (size_t)l * 4 * 768; const float* cbuf = P.in(I_SCONV) + (size_t)(l * NB_S + b) * 3 * 768;
#pragma unroll 1
    for (int half = 0; half < 2; ++half) {
        float S[64];
#pragma unroll
        for (int n = 0; n < 64; ++n) S[n] = s0[(half * 64 + n) * 64 + lane];
        int ch[3]; ch[0] = h * 64 + lane; ch[1] = 256 + g * 128 + half * 64 + lane; ch[2] = 512 + g * 128 + half * 64 + lane;
        float cw[3][4], cb[3], win[3][3];
#pragma unroll
        for (int c = 0; c < 3; ++c) {
#pragma unroll
            for (int w = 0; w < 4; ++w) cw[c][w] = cwp[w * 768 + ch[c]];
            cb[c] = P.in(I_CONVB)[l * 768 + ch[c]];
#pragma unroll
            for (int w = 0; w < 3; ++w) win[c][w] = bf2f(f2bf(cbuf[w * 768 + ch[c]]));
        }
#pragma unroll 1
        for (int t = 0; t < LEN_S; ++t) {
            const size_t row = (size_t)(T_P + b * LEN_S + t);
            const bf16_t* pr = PROJ + row * NPROJ;
            float cv[3];
#pragma unroll
            for (int c = 0; c < 3; ++c) {
                const float raw = bf2f(pr[C_XBC + ch[c]]);
                cv[c] = siluf_(cb[c] + cw[c][0] * win[c][0] + cw[c][1] * win[c][1] + cw[c][2] * win[c][2] + cw[c][3] * raw);
                win[c][0] = win[c][1]; win[c][1] = win[c][2]; win[c][2] = raw;
            }
            const float dtv = bf2f(pr[C_DT + h]) + dtb;
            const float delta = (dtv > 20.f) ? dtv : log1pf(__expf(dtv));
            const float a = __expf(-delta * aexp);
            const float xc = cv[0], bd = cv[1] * delta;
            float y = 0.f;
#pragma unroll
            for (int n = 0; n < 64; ++n) { const float bn = rdl(bd, n), cn = rdl(cv[2], n); S[n] = fmaf(bn, xc, a * S[n]); y = fmaf(cn, S[n], y); if ((n & 7) == 7) __builtin_amdgcn_sched_barrier(0); }
            if (half == 0) YL[t * 64 + lane] = y;
            else {
                const float z = bf2f(pr[C_SZ + h * 64 + lane]);
                y = (y + YL[t * 64 + lane] + dsk * xc) * siluf_(z);
                MIX[row * DM + 512 + h * 64 + lane] = f2bf(y);
                const float ss = wsum(y * y);
                if (lane == 0) SSDSQ[row * 4 + h] = ss;
            }
        }
#pragma unroll
        for (int n = 0; n < 64; ++n) so[(half * 64 + n) * 64 + lane] = S[n];
    }
    if (h == 0) {
        float* co = P.out + O_SCONV + (size_t)(l * NB_S + b) * 2304;
        for (int idx = lane; idx < 2304; idx += 64) { const int rr = idx / 768, c = idx % 768; co[idx] = bf2f(PROJ[(size_t)(T_P + b * LEN_S + LEN_S - 3 + rr) * NPROJ + C_XBC + c]); }
    }
}

constexpr int N_P1 = 8 * 4 * (NS - 1), N_P1S5 = 8 * 2 * (NS - 1), N_SUB0 = 3 * N_P1 + N_P1S5 + 64 + 64;
constexpr int N_P2 = 8 * 4 * NS, N_P2S5 = 8 * 2 * NS, N_SUB1 = 3 * N_P2 + N_P2S5 + 128;
__device__ __forceinline__ void ssd_norm_block(const Ctx& P, int l, int pm) {
    const int tid_ = pg8::opaque_tid(), wave = tid_ >> 6, lane = tid_ & 63;
    bf16_t* MIX = (bf16_t*)(P.ws + W_MIX); const float* SSDSQ = (const float*)(P.ws + W_SSDSQ);
    const f32x4 nw = *(const f32x4*)(P.in(I_SSDN) + l * 256 + lane * 4);
    const int gq = lane >> 5;
    for (int rb = pm * 256 + wave * 32; rb < pm * 256 + wave * 32 + 32; rb += 4) {
        u32x2 w[4]; float ss[4];
#pragma unroll
        for (int u = 0; u < 4; ++u) { const int row = rb + u; ss[u] = SSDSQ[(size_t)row * 4 + 2 * gq] + SSDSQ[(size_t)row * 4 + 2 * gq + 1]; w[u] = *(const u32x2*)(MIX + (size_t)row * DM + 512 + lane * 4); }
#pragma unroll
        for (int u = 0; u < 4; ++u) { const int row = rb + u;
            const float rstd = rsqrtf(ss[u] * (1.0f / 128.0f) + 1e-6f);
            const float a = __uint_as_float(w[u].x << 16) * rstd * nw[0], b = __uint_as_float(w[u].x & 0xffff0000u) * rstd * nw[1];
            const float c = __uint_as_float(w[u].y << 16) * rstd * nw[2], d = __uint_as_float(w[u].y & 0xffff0000u) * rstd * nw[3];
            u32x2 o; o.x = cvt_pk_bf16(a, b); o.y = cvt_pk_bf16(c, d);
            *(u32x2*)(MIX + (size_t)row * DM + 512 + lane * 4) = o; }
    }
}
constexpr size_t W_DEP = 20480;
__device__ __forceinline__ void mixer_phase(const Ctx& P, int l, ldsp lds) {
    unsigned* ctr = (unsigned*)(P.ws + W_CTL) + l * 32;
    unsigned* dep = (unsigned*)(P.ws + W_CTL + W_DEP) + l * 512;
    LAS int* slot = (LAS int*)(lds + L_QSLOT);
    const int nitems = N_SUB0 + N_SUB1 + 136;
    unsigned* dg = dep + 4 * 64; unsigned* df = dep + 4 * 64 + 68;
    __syncthreads();
    if (threadIdx.x == 0) *slot = (int)atomicAdd(ctr, 1u);
    __syncthreads();
    int id = *slot;
    while (id < nitems) {
        int nxt = 0;
        if (threadIdx.x == 0) nxt = (int)atomicAdd(ctr, 1u);
        int type, a, b2 = 0, c = 1, seg = 0, tb = 0, te = LEN_S, init = 1, full = 1, store = 1;
        const int tailid = id - (N_SUB0 + N_SUB1);
        if (tailid >= 0) id = N_SUB0;
        const int sub = id >= N_SUB0 ? 1 : 0;
        const int qid = sub ? id - N_SUB0 : id;
        { const int nS5 = sub == 0 ? N_P1S5 : N_P2S5, nOth = sub == 0 ? 3 * N_P1 : 3 * N_P2; id = qid < nS5 ? nOth + qid : (qid < nS5 + nOth ? qid - nS5 : qid); }
        if (sub == 0) {
            if (id < 3 * N_P1) { type = id / N_P1; const int j = id % N_P1; a = j / (4 * (NS - 1)); b2 = (j / (NS - 1)) & 3; seg = j % (NS - 1); init = 0; full = 0; store = 2; tb = seg * SL; te = tb + SL; }
            else if (id < 3 * N_P1 + N_P1S5) { type = 3; const int j = id - 3 * N_P1; b2 = j / (2 * (NS - 1)); a = (j / (NS - 1)) & 1; seg = j % (NS - 1); init = 0; full = 0; store = 2; tb = seg * SL; te = tb + SL; }
            else { const int j = id - 3 * N_P1 - N_P1S5;
                if (j < 64) { type = 4; a = j; }
                else { type = 3; a = (j - 64) & 1; b2 = NB_P + ((j - 64) >> 1) * 4; c = 4; } }
        } else {
            if (id < 3 * N_P2) { type = id / N_P2; const int j = id % N_P2; a = j / (4 * NS); b2 = (j / NS) & 3; seg = j % NS; }
            else if (id < 3 * N_P2 + N_P2S5) { type = 3; const int j = id - 3 * N_P2; b2 = j / (2 * NS); a = (j / NS) & 1; seg = j % NS; }
            else { const int j = id - 3 * N_P2 - N_P2S5; type = 5 + j / 64; a = j % 64; }
            if (type < 4) { init = seg > 0 ? 2 : 0; full = 1; store = (seg == NS - 1) ? 1 : 0; tb = seg * SL; te = tb + SL; }
        }
        if (tailid >= 0) { type = tailid < 68 ? 7 : 8; a = tailid < 68 ? tailid : tailid - 68; seg = 0; store = 0; }
        int chain = (type == 3) ? (b2 & 7) * 2 + a : (a & 7) * 4 + b2;
        chain = __builtin_amdgcn_readfirstlane(chain);
        int ptile = -1;
        if (sub == 1 && type == 3) ptile = (b2 & 7) * 8 + seg;
        if (sub == 1 && type == 0) ptile = (a & 7) * 8 + seg;
        if (sub == 0 && type == 3 && store == 1) ptile = 64 + (b2 - NB_P) / 32;
        if (type == 4) ptile = 64 + a / 16;
        if (tailid >= 0) ptile = -1;
        ptile = __builtin_amdgcn_readfirstlane(ptile);
        type = __builtin_amdgcn_readfirstlane(type); a = __builtin_amdgcn_readfirstlane(a); b2 = __builtin_amdgcn_readfirstlane(b2); c = __builtin_amdgcn_readfirstlane(c);
        seg = __builtin_amdgcn_readfirstlane(seg); tb = __builtin_amdgcn_readfirstlane(tb); te = __builtin_amdgcn_readfirstlane(te);
        init = __builtin_amdgcn_readfirstlane(init); full = __builtin_amdgcn_readfirstlane(full); store = __builtin_amdgcn_readfirstlane(store);
        if (sub == 1 && type < 4 && seg > 0) {
            if (threadIdx.x == 0) {
                unsigned* d = dep + type * 64 + chain;
                while (__hip_atomic_load(d, __ATOMIC_RELAXED, __HIP_MEMORY_SCOPE_AGENT) < (unsigned)(NS - 1)) __builtin_amdgcn_s_sleep(2);
                __builtin_amdgcn_fence(__ATOMIC_ACQUIRE, "agent"); asm volatile("s_waitcnt vmcnt(0)" ::: "memory");
            }
            __syncthreads();
        }
        if (type >= 7) {
            if (threadIdx.x == 0) {
                unsigned* d = (type == 7 ? dg : df) + a; const unsigned need = a < 64 ? (type == 7 ? 2u : 4u) : 16u;
                while (__hip_atomic_load(d, __ATOMIC_RELAXED, __HIP_MEMORY_SCOPE_AGENT) < need) __builtin_amdgcn_s_sleep(2);
                __builtin_amdgcn_fence(__ATOMIC_ACQUIRE, "agent"); asm volatile("s_waitcnt vmcnt(0)" ::: "memory");
            }
            __syncthreads();
            if (type == 7) {
                const bf16_t* YP = (const bf16_t*)(P.ws + W_YPRE);
                pg8::Gemm g{YP, (const bf16_t*)(P.ws + W_WGLU) + (size_t)l * 256 * 256, TT, 256, 256}; pg8::OneUnit S1{a, 4};
                pg8::EpiGlu E{YP, (bf16_t*)(P.ws + W_MIX), P.in(I_GLUB) + l * 256};
                pg8::gemm_phase<pg8::EpiGlu, pg8::OneUnit>(lds, g, S1, E, nullptr);
            } else ssd_norm_block(P, l, a);
        }
        if (type >= 4 && type < 7) {
            const int tq = pg8::opaque_tid(), pair = a * 8 + (tq >> 6), sb = pair >> 2, sh = pair & 3, ln = tq & 63;
            if (type == 4) ssd_sample_wave(P, l, sb, sh, ln, (LAS float*)(lds + (tq >> 6) * 2048));
            else rh_sample_wave(P, l, sb, sh, ln, type == 5);
        }
#ifndef SK_SSD
        if (type == 0) ssd_item(P, l, a, b2, tb, te, init, full, store, seg, lds);
#endif
#ifdef DBL_SSD
        if (type == 0) { __syncthreads(); ssd_item(P, l, a, b2, tb, te, init, full, store, seg, lds); }
#endif
#ifndef SK_RET
        if (type == 1) ret_item(P, l, a, b2, tb, te, init, full, store, seg, lds);
#endif
#ifdef DBL_RET
        if (type == 1) { __syncthreads(); ret_item(P, l, a, b2, tb, te, init, full, store, seg, lds); }
#endif
#ifndef SK_HG
        if (type == 2) hgrn_item(P, l, a, b2, tb, te, init, full, store, seg, lds);
#endif
#ifdef DBL_HG
        if (type == 2) { __syncthreads(); hgrn_item(P, l, a, b2, tb, te, init, full, store, seg, lds); }
#endif
#ifndef SK_S5
        if (type == 3) s5_item(P, l, a, b2, c, tb, te, init, full, store, seg, lds);
#endif
#ifdef DBL_S5
        if (type == 3) { __syncthreads(); s5_item(P, l, a, b2, c, tb, te, init, full, store, seg, lds); }
#endif
        if (sub == 0 && store == 2) {
            asm volatile("s_waitcnt vmcnt(0)" ::: "memory");
            __syncthreads();
            if (threadIdx.x == 0) { __builtin_amdgcn_fence(__ATOMIC_RELEASE, "agent"); asm volatile("s_waitcnt vmcnt(0)" ::: "memory");
                __hip_atomic_fetch_add(dep + type * 64 + chain, 1u, __ATOMIC_RELAXED, __HIP_MEMORY_SCOPE_AGENT); }
        }
        if (ptile >= 0) {
            asm volatile("s_waitcnt vmcnt(0)" ::: "memory");
            __syncthreads();
            if (threadIdx.x == 0) { __builtin_amdgcn_fence(__ATOMIC_RELEASE, "agent"); asm volatile("s_waitcnt vmcnt(0)" ::: "memory");
                __hip_atomic_fetch_add(((type == 3) ? dg : df) + ptile, 1u, __ATOMIC_RELAXED, __HIP_MEMORY_SCOPE_AGENT); }
        }
        __syncthreads();
        if (threadIdx.x == 0) *slot = nxt;
        __syncthreads();
        id = *slot;
    }
}

__device__ __forceinline__ void ssd_norm_fix(const Ctx& P, int l) {
    const int tid_ = pg8::opaque_tid(), wave = tid_ >> 6, lane = tid_ & 63;
    bf16_t* MIX = (bf16_t*)(P.ws + W_MIX); const float* SSDSQ = (const float*)(P.ws + W_SSDSQ);
    const f32x4 nw = *(const f32x4*)(P.in(I_SSDN) + l * 256 + lane * 4);
    const int nskip = gridDim.x >= 136 ? 68 : 0;
    if ((int)blockIdx.x < nskip) return;
    const int gq = lane >> 5, stride = (gridDim.x - nskip) * 8;
    for (int rb = ((int)blockIdx.x - nskip) * 8 + wave; rb < TT; rb += 4 * stride) {
        u32x2 w[4]; float ss[4];
#pragma unroll
        for (int u = 0; u < 4; ++u) { const int row = rb + u * stride; ss[u] = 0.f; w[u] = (u32x2){0u, 0u};
            if (row < TT) { ss[u] = SSDSQ[(size_t)row * 4 + 2 * gq] + SSDSQ[(size_t)row * 4 + 2 * gq + 1]; w[u] = *(const u32x2*)(MIX + (size_t)row * DM + 512 + lane * 4); } }
#pragma unroll
        for (int u = 0; u < 4; ++u) { const int row = rb + u * stride;
            if (row < TT) {
                const float rstd = rsqrtf(ss[u] * (1.0f / 128.0f) + 1e-6f);
                const float a = __uint_as_float(w[u].x << 16) * rstd * nw[0], b = __uint_as_float(w[u].x & 0xffff0000u) * rstd * nw[1];
                const float c = __uint_as_float(w[u].y << 16) * rstd * nw[2], d = __uint_as_float(w[u].y & 0xffff0000u) * rstd * nw[3];
                u32x2 o; o.x = cvt_pk_bf16(a, b); o.y = cvt_pk_bf16(c, d);
                *(u32x2*)(MIX + (size_t)row * DM + 512 + lane * 4) = o;
            } }
    }
}
__device__ __forceinline__ void sample_fix(const Ctx& P, const float* slab, int nsplit) {
    const int tid_ = pg8::opaque_tid(), wave = tid_ >> 6, lane = tid_ & 63;
    bf16_t* XB = (bf16_t*)(P.ws + W_XB); float* SSQ = (float*)(P.ws + W_SSQ); float* RSTD = (float*)(P.ws + W_RSTD);
    for (int row = T_P + blockIdx.x * 8 + wave; row < TT; row += gridDim.x * 8) {
        float* xp = P.out + (size_t)row * DM; float s = 0.f;
#pragma unroll
        for (int j = 0; j < 4; ++j) {
            f32x4 v = *(const f32x4*)(xp + j * 256 + lane * 4);
            if (nsplit > 8) {
                const bf16_t* s16 = (const bf16_t*)slab;
                for (int k = 0; k < nsplit; ++k) { const u32x2 w2 = *(const u32x2*)(s16 + ((size_t)k * 1024 + (row - T_P)) * 1024 + j * 256 + lane * 4);
                    v[0] += __uint_as_float(w2.x << 16); v[1] += __uint_as_float(w2.x & 0xffff0000u); v[2] += __uint_as_float(w2.y << 16); v[3] += __uint_as_float(w2.y & 0xffff0000u); }
            } else
            for (int k = 0; k < nsplit; ++k) v += *(const f32x4*)(slab + ((size_t)k * 1024 + (row - T_P)) * 1024 + j * 256 + lane * 4);
            *(f32x4*)(xp + j * 256 + lane * 4) = v;
            s += (v[0] * v[0] + v[1] * v[1]) + (v[2] * v[2] + v[3] * v[3]);
            u32x2 w; w.x = cvt_pk_bf16(v[0], v[1]); w.y = cvt_pk_bf16(v[2], v[3]);
            *(u32x2*)(XB + (size_t)row * DM + j * 256 + lane * 4) = w;
        }
#pragma unroll
        for (int o = 32; o >= 1; o >>= 1) s += __shfl_xor(s, o);
        if (lane < 16) SSQ[(size_t)row * 16 + lane] = (lane == 0) ? s : 0.f;
        if (lane == 0) RSTD[row] = rsqrtf(s * (1.0f / 1024.0f) + 1e-6f);
    }
    for (int r = blockIdx.x * 64 + tid_; tid_ < 64 && r < T_P; r += gridDim.x * 64) {
        const f32x4* sp = (const f32x4*)(SSQ + (size_t)r * 16);
        const f32x4 s0 = sp[0], s1 = sp[1], s2 = sp[2], s3 = sp[3];
        const float ss = ((s0[0] + s0[1]) + (s0[2] + s0[3])) + ((s1[0] + s1[1]) + (s1[2] + s1[3])) + ((s2[0] + s2[1]) + (s2[2] + s2[3])) + ((s3[0] + s3[1]) + (s3[2] + s3[3]));
        RSTD[r] = rsqrtf(ss * (1.0f / 1024.0f) + 1e-6f);
    }
}
__device__ __forceinline__ void final_norm(const Ctx& P) {
    const int tid_ = pg8::opaque_tid(), wave = tid_ >> 6, lane = tid_ & 63;
    const float* SSQ = (const float*)(P.ws + W_SSQ); const float* nf = P.in(I_NFIN);
    f32x4 wv[4];
#pragma unroll
    for (int j = 0; j < 4; ++j) wv[j] = *(const f32x4*)(nf + j * 256 + lane * 4);
    const int stride = gridDim.x * 8;
    for (int rb = blockIdx.x * 8 + wave; rb < TT; rb += 4 * stride) {
        f32x4 v[4][4]; float sq[4];
#pragma unroll
        for (int u = 0; u < 4; ++u) { const int row = rb + u * stride;
            sq[u] = (row < TT && lane < 16) ? SSQ[(size_t)row * 16 + lane] : 0.f;
#pragma unroll
            for (int j = 0; j < 4; ++j) v[u][j] = (row < TT) ? *(const f32x4*)(P.out + (size_t)row * DM + j * 256 + lane * 4) : (f32x4){0.f, 0.f, 0.f, 0.f}; }
#pragma unroll
        for (int u = 0; u < 4; ++u) { const int row = rb + u * stride;
            float s = sq[u];
#pragma unroll
            for (int o = 8; o >= 1; o >>= 1) s += __shfl_xor(s, o);
            s = __shfl(s, 0);
            const float rstd = rsqrtf(s * (1.0f / 1024.0f) + 1e-6f);
            if (row < TT) {
#pragma unroll
                for (int j = 0; j < 4; ++j) *(f32x4*)(P.out + (size_t)row * DM + j * 256 + lane * 4) = v[u][j] * rstd * wv[j];
            } }
    }
}

__global__ void __launch_bounds__(512, 2) fwd_megakernel(Params P) {
    extern __shared__ __attribute__((aligned(16))) unsigned char lds_raw[];
    cg::grid_group grid = cg::this_grid();
    ldsp lds = (ldsp)lds_raw;
    const int G = gridDim.x, bid = blockIdx.x;
#define PHASE_PTRS unsigned char* ws = P.ws; asm volatile("" : "+s"(ws)); float* X = P.out; asm volatile("" : "+s"(X)); \
    bf16_t* XB = (bf16_t*)(ws + W_XB); bf16_t* MIX = (bf16_t*)(ws + W_MIX); bf16_t* PROJ = (bf16_t*)(ws + W_PROJ); bf16_t* HID = (bf16_t*)(ws + W_HID); bf16_t* YPRE = (bf16_t*)(ws + W_YPRE); float* SSQ = (float*)(ws + W_SSQ); \
    Ctx C; C.out = X; C.ws = ws; (void)XB; (void)MIX; (void)PROJ; (void)HID; (void)YPRE; (void)SSQ; (void)C

    if (threadIdx.x < 2) ((LAS unsigned*)(lds + L_BARST))[threadIdx.x] = 0u;
    __syncthreads();
    (void)xcd_barrier_post((unsigned*)(P.ws + W_BAR), (volatile LAS unsigned*)(lds + L_BARST));
#define XBAR() do { XcdBarrier xb_; xb_.bar = (unsigned*)(P.ws + W_BAR); xb_.x = xb_xcc_id(); xb_.st = (volatile LAS unsigned*)(lds + L_BARST); xcd_barrier(xb_); } while (0)
    phase0(P, lds);
    if (bid == 0) {
#pragma unroll
        for (int i = 0; i < N_IN; ++i) if ((int)threadIdx.x == i) ((const float**)(P.ws + W_TAB))[i] = P.in[i];
    }
    XBAR();
    grid.sync();

#pragma unroll 1
    for (int l = 0; l < 2; ++l) {
        {
            PHASE_PTRS;
            pg8::Gemm g{XB, (const bf16_t*)(ws + W_WIN) + (size_t)l * NPROJ * DM, TT, NPROJ, DM}; pg8::StaticOrder S; S.init(TT, NPROJ, G, bid);
            pg8::EpiScaleBf16<0> E{PROJ, NPROJ, (const float*)(ws + W_RSTD)};
            pg8::gemm_phase<pg8::EpiScaleBf16<0>, pg8::StaticOrder>(lds, g, S, E, nullptr);
        }
        XBAR();
        { PHASE_PTRS; mixer_phase(C, l, lds); }
        XBAR();
        {
            PHASE_PTRS;
            pg8::Gemm g{MIX, (const bf16_t*)(ws + W_WOUT) + (size_t)l * DM * DM, TT, DM, DM}; pg8::SplitOrder S; S.init(T_P, DM, G, bid, DM, 4);
            pg8::EpiRes E{l == 0 ? C.in(I_XP) : X, X + (size_t)T_P * DM, X, XB, SSQ, (float*)HID, 0};
            pg8::gemm_phase<pg8::EpiRes, pg8::SplitOrder>(lds, g, S, E, nullptr);
        }
        XBAR();
        { PHASE_PTRS; sample_fix(C, (const float*)HID, 4); }
        XBAR();
        {
            PHASE_PTRS;
            pg8::Gemm g{XB, (const bf16_t*)(ws + W_WUP) + (size_t)l * DFF * DM, TT, DFF, DM}; pg8::StaticOrder S; S.init(TT, DFF, G, bid);
            pg8::EpiScaleBf16<1> E{HID, DFF, (const float*)(ws + W_RSTD)};
#ifdef REP_UP
#pragma unroll 1
            for (int rep = 0; rep < 3; ++rep)
#endif
            pg8::gemm_phase<pg8::EpiScaleBf16<1>, pg8::StaticOrder>(lds, g, S, E, nullptr);
        }
        XBAR();
        {
            PHASE_PTRS;
            pg8::Gemm g{HID, (const bf16_t*)(ws + W_WDN) + (size_t)l * DM * DFF, TT, DM, DFF}; pg8::SplitOrder S; S.init(T_P, DM, G, bid, DFF, 16);
            pg8::EpiRes E{X, X + (size_t)T_P * DM, X, XB, SSQ, (float*)MIX, 1};
            pg8::gemm_phase<pg8::EpiRes, pg8::SplitOrder>(lds, g, S, E, nullptr);
        }
        XBAR();
        { PHASE_PTRS; sample_fix(C, (const float*)MIX, 16); }
        XBAR();
    }
    { PHASE_PTRS; final_norm(C); }
#undef PHASE_PTRS
}
}

extern "C" void kernel_launch(void* const* d_in, const int* in_sizes, int n_in, void* d_out, int out_size, void* d_ws, size_t ws_size, hipStream_t stream) {
    static int grid_blocks = 0;
    if (grid_blocks == 0) {
        if (n_in != mk::N_IN || (size_t)out_size != mk::O_END || ws_size < mk::W_END) {
            fprintf(stderr, "kernel_launch: unexpected shapes: n_in %d out %d ws %zu (need %zu)\n", n_in, out_size, ws_size, (size_t)mk::W_END); grid_blocks = -1; return; }
        int dev = 0, cus = 0, per_cu = 0;
        (void)hipGetDevice(&dev);
        (void)hipDeviceGetAttribute(&cus, hipDeviceAttributeMultiprocessorCount, dev);
        (void)hipFuncSetAttribute((const void*)mk::fwd_megakernel, hipFuncAttributeMaxDynamicSharedMemorySize, mk::LDS_BYTES);
        (void)hipOccupancyMaxActiveBlocksPerMultiprocessor(&per_cu, (const void*)mk::fwd_megakernel, 512, mk::LDS_BYTES);
        if (per_cu < 1) { fprintf(stderr, "kernel_launch: occupancy query says 0 blocks per CU\n"); per_cu = 1; }
        if (per_cu > 1) per_cu = 1;
        grid_blocks = cus * per_cu;
    }
    if (grid_blocks < 0) return;
    (void)hipMemsetAsync((char*)d_ws + mk::W_CTL, 0, 32768, stream);
    mk::Params p{};
    for (int i = 0; i < mk::N_IN; ++i) p.in[i] = (const float*)d_in[i];
    p.out = (float*)d_out; p.ws = (unsigned char*)d_ws;
    void* args[] = {&p};
    hipError_t e = hipLaunchCooperativeKernel((const void*)mk::fwd_megakernel, dim3(grid_blocks), dim3(512), args, mk::LDS_BYTES, stream);
    if (e != hipSuccess) fprintf(stderr, "cooperative launch failed: %s (grid %d)\n", hipGetErrorString(e), grid_blocks);
}
```

```cpp
#include <hip/hip_cooperative_groups.h>
#include <cstdio>
namespace cg = cooperative_groups;
#include <hip/hip_runtime.h>
namespace pg8 {
#define PG8_LAS __attribute__((address_space(3)))
typedef unsigned short bf16_t;
typedef short bf16x8 __attribute__((ext_vector_type(8)));
typedef float f32x4 __attribute__((ext_vector_type(4)));
typedef unsigned u32x4 __attribute__((ext_vector_type(4)));
constexpr int BM = 256, BK = 64, HALF = 128, HTB = HALF * BK * 2  , STAGE_BYTES = 8 * HTB, NXCD = 8, WGM = 8;

__host__ __device__ __forceinline__ int lds_byte(int r, int c) { const int st = (r >> 4) * 2 + (c >> 5), rr = r & 15, cc = c & 31, ob = rr * 64 + cc * 2; return st * 1024 + (ob ^ (((ob >> 9) & 1) << 5)); }
__host__ __device__ __forceinline__ void stage_rc(int b, int& R, int& C) { const int st = b / 1024, sb = b % 1024, swz = sb ^ (((sb >> 9) & 1) << 5); R = (st >> 1) * 16 + swz / 64; C = (st & 1) * 32 + (swz % 64) / 2; }
__host__ __device__ __forceinline__ int perm32(int rho) { const int n = rho >> 4, i = rho & 15; return 8 * (i >> 2) + 4 * n + (i & 3); }

struct Unit { int pm, pn, ki; __host__ __device__ int kt0() const { return ki & 0xff; } __host__ __device__ int nkt() const { return (ki >> 8) & 0xff; } __host__ __device__ int split() const { return ki >> 16; } };
struct Gemm { const bf16_t* A; const bf16_t* Bt; int M, N, K; };

struct StaticOrder {
    int nM, nN, nwg, G, c, nkt;
    __host__ __device__ void init(int M, int N, int G_, int c_, int K = 1024) { nM = M / BM; nN = N / BM; nwg = nM * nN; G = G_; c = c_; nkt = K / BK; }
    __host__ __device__ bool next(int i, Unit& u) const {
        const long L = (long)i * G + c; if (L >= nwg) return false;
        int wgid = (int)L; { const int q = nwg / NXCD, r = nwg % NXCD, xcd = wgid % NXCD, off = wgid / NXCD; wgid = (xcd < r ? xcd * (q + 1) : r * (q + 1) + (xcd - r) * q) + off; }
        const int nig = WGM * nN, gid = wgid / nig, fm = gid * WGM, gsz = (nM - fm) < WGM ? (nM - fm) : WGM;
        u.pm = fm + ((wgid % nig) % gsz); u.pn = (wgid % nig) / gsz; u.ki = nkt << 8; return true;
    }
    __device__ __forceinline__ void a_ready(const Unit&) const {}
    __device__ __forceinline__ void done(const Unit&) const {}
};
struct SplitOrder {
    StaticOrder P; int nP, nS, SPLIT, nkt_s, nNn;
    __host__ __device__ void init(int Mp, int N, int G_, int c_, int K, int SPLIT_) { P.init(Mp, N, G_, c_, K); nP = P.nwg; nNn = N / BM; SPLIT = SPLIT_; nS = 4 * nNn * SPLIT; nkt_s = K / BK / SPLIT; }
    __host__ __device__ bool next(int i, Unit& u) const {
        const long L = (long)i * P.G + P.c;
        if (L < nP) return P.next(i, u);
        const int s = (int)(L - nP); if (s >= nS) return false;
        const int tile = s / SPLIT, ks = s % SPLIT;
        u.pm = 64 + tile / nNn; u.pn = tile % nNn; u.ki = (ks * nkt_s) | (nkt_s << 8) | (1 << 16); return true;
    }
    __device__ __forceinline__ void a_ready(const Unit&) const {}
    __device__ __forceinline__ void done(const Unit&) const {}
};
struct OneUnit {
    int pm, nkt;
    __host__ __device__ bool next(int i, Unit& u) const { if (i) return false; u.pm = pm; u.pn = 0; u.ki = nkt << 8; return true; }
    __device__ __forceinline__ void a_ready(const Unit&) const {}
    __device__ __forceinline__ void done(const Unit&) const {}
};
typedef __bf16 bf16v2_t __attribute__((ext_vector_type(2)));
__device__ __forceinline__ unsigned cvt_pk_bf16(float lo, float hi) { bf16v2_t v; v.x = (__bf16)lo; v.y = (__bf16)hi; return __builtin_bit_cast(unsigned, v); }
typedef float f32x2 __attribute__((ext_vector_type(2)));
__device__ __forceinline__ int opaque_tid() { int t = (int)threadIdx.x; asm volatile("" : "+v"(t)); return t; }
typedef unsigned u32x2 __attribute__((ext_vector_type(2)));
constexpr int TP_ROWS = 16384;
template <int ACT> struct EpiScaleBf16 {
    static constexpr bool PERM = true, AFTER_DRAIN = false;
    bf16_t* O; int ldc; const float* rstdp;
    __device__ __forceinline__ void operator()(const f32x4 (&acc)[2][2][4][2], const Unit& u, int wr, int wc, int fr, int fq) const {
        const int row0 = u.pm * BM + wr * 64 + fr, col0 = u.pn * BM + wc * 32 + 8 * fq;
        float rs[8];
#pragma unroll
        for (int i = 0; i < 8; ++i) rs[i] = rstdp[row0 + (i >> 2) * HALF + (i & 3) * 16];
#pragma unroll
        for (int ai = 0; ai < 2; ++ai)
#pragma unroll
            for (int m = 0; m < 4; ++m) {
                const int row = row0 + ai * HALF + m * 16;
                const float rstd = rs[ai * 4 + m];
                bf16_t* rowp = O + (size_t)row * ldc + col0;
#pragma unroll
                for (int bj = 0; bj < 2; ++bj) {
                    f32x4 v0 = acc[ai][bj][m][0] * rstd, v1 = acc[ai][bj][m][1] * rstd;
                    if (ACT == 1) {
#pragma unroll
                        for (int j = 0; j < 4; ++j) { const float a = fmaxf(v0[j], 0.f), b = fmaxf(v1[j], 0.f); v0[j] = a * a; v1[j] = b * b; }
                    }
                    u32x4 w; w.x = cvt_pk_bf16(v0[0], v0[1]); w.y = cvt_pk_bf16(v0[2], v0[3]); w.z = cvt_pk_bf16(v1[0], v1[1]); w.w = cvt_pk_bf16(v1[2], v1[3]);
                    *(u32x4*)(rowp + bj * HALF) = w;
                }
            }
    }
};
struct EpiRes {
    static constexpr bool PERM = false, AFTER_DRAIN = false;
    const float* base0; const float* base1; float* X; bf16_t* XB; float* ssq; float* slab; int slab16;
    __device__ __forceinline__ void operator()(const f32x4 (&acc)[2][2][4][2], const Unit& u, int wr, int wc, int fr, int fq) const {
        const int row0 = u.pm * BM + wr * 64 + fr, col0 = u.pn * BM + wc * 32 + 4 * fq;
        if (u.split()) {
            const int ks = u.kt0() / u.nkt();
#pragma unroll
            for (int ai = 0; ai < 2; ++ai)
#pragma unroll
                for (int m = 0; m < 4; ++m) {
                    const size_t so_ = ((size_t)ks * 1024 + (size_t)(row0 + ai * HALF + m * 16 - TP_ROWS)) * 1024 + col0;
                    if (slab16) {
                        bf16_t* sp = (bf16_t*)slab + so_;
#pragma unroll
                        for (int bj = 0; bj < 2; ++bj)
#pragma unroll
                            for (int n = 0; n < 2; ++n) { const f32x4 a = acc[ai][bj][m][n]; u32x2 w; w.x = cvt_pk_bf16(a[0], a[1]); w.y = cvt_pk_bf16(a[2], a[3]); *(u32x2*)(sp + bj * HALF + n * 16) = w; }
                    } else {
                        float* sp = slab + so_;
#pragma unroll
                        for (int bj = 0; bj < 2; ++bj)
#pragma unroll
                            for (int n = 0; n < 2; ++n) *(f32x4*)(sp + bj * HALF + n * 16) = acc[ai][bj][m][n];
                    }
                }
            return;
        }
        f32x4 bc[4], bn[4];
        {
            const int row = row0;
            const float* bp = (row < TP_ROWS) ? (base0 + (size_t)row * 1024) : (base1 + (size_t)(row - TP_ROWS) * 1024);
#pragma unroll
            for (int q = 0; q < 4; ++q) bc[q] = *(const f32x4*)(bp + col0 + (q >> 1) * HALF + (q & 1) * 16);
        }
#pragma unroll
        for (int g = 0; g < 8; ++g) {
            const int ai = g >> 2, m = g & 3;
            const int row = row0 + ai * HALF + m * 16;
            if (g < 7) {
                const int rown = row0 + ((g + 1) >> 2) * HALF + ((g + 1) & 3) * 16;
                const float* bp = (rown < TP_ROWS) ? (base0 + (size_t)rown * 1024) : (base1 + (size_t)(rown - TP_ROWS) * 1024);
#pragma unroll
                for (int q = 0; q < 4; ++q) bn[q] = *(const f32x4*)(bp + col0 + (q >> 1) * HALF + (q & 1) * 16);
            }
            float s = 0.f;
#pragma unroll
            for (int bj = 0; bj < 2; ++bj)
#pragma unroll
                for (int n = 0; n < 2; ++n) {
                    const int c = col0 + bj * HALF + n * 16;
                    const f32x4 v = bc[bj * 2 + n] + acc[ai][bj][m][n];
                    *(f32x4*)(X + (size_t)row * 1024 + c) = v;
                    u32x2 w; w.x = cvt_pk_bf16(v[0], v[1]); w.y = cvt_pk_bf16(v[2], v[3]);
                    *(u32x2*)(XB + (size_t)row * 1024 + c) = w;
                    s += (v[0] * v[0] + v[1] * v[1]) + (v[2] * v[2] + v[3] * v[3]);
                }
            s += __shfl_xor(s, 16); s += __shfl_xor(s, 32);
            if (fq == 0) ssq[(size_t)row * 16 + u.pn * 4 + wc] = s;
#pragma unroll
            for (int q = 0; q < 4; ++q) bc[q] = bn[q];
            asm volatile("" ::: "memory");
        }
    }
};
struct EpiGlu {
    static constexpr bool PERM = true, AFTER_DRAIN = false;
    const bf16_t* Y; bf16_t* MIX; const float* bias;
    __device__ __forceinline__ void operator()(const f32x4 (&acc)[2][2][4][2], const Unit& u, int wr, int wc, int fr, int fq) const {
        const int row0 = u.pm * BM + wr * 64 + fr, col0 = u.pn * BM + wc * 32 + 8 * fq;
        u32x4 yw[8][2]; f32x4 bv[2][2];
#pragma unroll
        for (int bj = 0; bj < 2; ++bj) { bv[bj][0] = *(const f32x4*)(bias + col0 + bj * HALF); bv[bj][1] = *(const f32x4*)(bias + col0 + bj * HALF + 4); }
#pragma unroll
        for (int g = 0; g < 8; ++g)
#pragma unroll
            for (int bj = 0; bj < 2; ++bj) yw[g][bj] = *(const u32x4*)(Y + (size_t)(row0 + (g >> 2) * HALF + (g & 3) * 16) * 256 + col0 + bj * HALF);
#pragma unroll
        for (int ai = 0; ai < 2; ++ai)
#pragma unroll
            for (int m = 0; m < 4; ++m) {
                const int row = row0 + ai * HALF + m * 16;
#pragma unroll
                for (int bj = 0; bj < 2; ++bj) {
                    const int c = col0 + bj * HALF;
                    const u32x4 w0 = yw[ai * 4 + m][bj];
                    const f32x4 a0 = acc[ai][bj][m][0] + bv[bj][0], a1 = acc[ai][bj][m][1] + bv[bj][1];
                    float y[8], o[8];
                    y[0] = __uint_as_float(w0.x << 16); y[1] = __uint_as_float(w0.x & 0xffff0000u); y[2] = __uint_as_float(w0.y << 16); y[3] = __uint_as_float(w0.y & 0xffff0000u);
                    y[4] = __uint_as_float(w0.z << 16); y[5] = __uint_as_float(w0.z & 0xffff0000u); y[6] = __uint_as_float(w0.w << 16); y[7] = __uint_as_float(w0.w & 0xffff0000u);
#pragma unroll
                    for (int j = 0; j < 4; ++j) { o[j] = y[j] / (1.0f + __expf(-a0[j])); o[4 + j] = y[4 + j] / (1.0f + __expf(-a1[j])); }
                    u32x4 w; w.x = cvt_pk_bf16(o[0], o[1]); w.y = cvt_pk_bf16(o[2], o[3]); w.z = cvt_pk_bf16(o[4], o[5]); w.w = cvt_pk_bf16(o[6], o[7]);
                    *(u32x4*)(MIX + (size_t)row * 1024 + 768 + c) = w;
                }
            }
    }
};

template <class Epi, class Sched, bool STAMP = false>
__device__ __forceinline__ void gemm_phase(PG8_LAS unsigned char* lds, const Gemm g, const Sched& S, const Epi& E, unsigned long long* stamps) {
    const int tid = opaque_tid(), wid = __builtin_amdgcn_readfirstlane(tid >> 6), lane = tid & 63, wr = wid >> 2, wc = wid & 3, fr = lane & 15, fq = lane >> 4;
    int K_ = g.K; asm volatile("" : "+s"(K_)); const int K = K_, nt = K / BK;
    int ts_lo = 0, ts_hi = 0, nts = 0; const unsigned long long rt_entry = STAMP ? (unsigned long long)wall_clock64() : 0ull;
#define PG8_STAMP() do { if (STAMP && wid == 0 && nts < 64) { const unsigned long long _c = (unsigned long long)clock64(); \
        ts_lo = (lane == nts) ? (int)(unsigned)_c : ts_lo; ts_hi = (lane == nts) ? (int)(unsigned)(_c >> 32) : ts_hi; ++nts; } } while (0)
    PG8_STAMP();
    unsigned voffA[2], voffB[2];
#pragma unroll
    for (int i = 0; i < 2; ++i) { int R, C; stage_rc(tid * 16 + i * 8192, R, C); const int Rb = Epi::PERM ? ((R & ~31) + perm32(R & 31)) : R;
        voffA[i] = (unsigned)(R * K + C) * 2u; voffB[i] = (unsigned)(Rb * K + C) * 2u; }
    const size_t kstep = (size_t)(BK * 2);
    const size_t hstep = (size_t)HALF * K * 2;
    const size_t tstep = 2 * hstep;
    const unsigned ldsw = (unsigned)wid * 1024u;
    const int aoff = lds_byte(wr * 64 + fr, fq * 8), boff = lds_byte(wc * 32 + fr, fq * 8);
#define PG8_SA(b, h) (((b) * 2 + (h)) * HTB)
#define PG8_SB(b, h) ((4 + (b) * 2 + (h)) * HTB)
#define PG8_STAGE(bufoff, gbase, voff) do { _Pragma("unroll") for (int _i = 0; _i < 2; ++_i) \
        __builtin_amdgcn_global_load_lds((const unsigned*)((const char*)(gbase) + (voff)[_i]), (PG8_LAS unsigned*)(lds + (bufoff) + ldsw + _i * 8192), 16, 0, 0); } while (0)
#define PG8_LDA(dst, b, h) do { _Pragma("unroll") for (int m = 0; m < 4; ++m) _Pragma("unroll") for (int k = 0; k < 2; ++k) dst[m][k] = *(const PG8_LAS bf16x8*)(lds + PG8_SA(b, h) + aoff + m * 2048 + k * 1024); } while (0)
#define PG8_LDB(dst, b, h) do { _Pragma("unroll") for (int n = 0; n < 2; ++n) _Pragma("unroll") for (int k = 0; k < 2; ++k) dst[n][k] = *(const PG8_LAS bf16x8*)(lds + PG8_SB(b, h) + boff + n * 2048 + k * 1024); } while (0)
#define PG8_MMA(ai, bj, At, Bt) do { __builtin_amdgcn_s_setprio(1); _Pragma("unroll") for (int m = 0; m < 4; ++m) _Pragma("unroll") for (int n = 0; n < 2; ++n) _Pragma("unroll") for (int k = 0; k < 2; ++k) \
        acc[ai][bj][m][n] = __builtin_amdgcn_mfma_f32_16x16x32_bf16(Bt[n][k], At[m][k], acc[ai][bj][m][n], 0, 0, 0); __builtin_amdgcn_s_setprio(0); } while (0)
#define PG8_WAIT_V(n) asm volatile("s_waitcnt vmcnt(" #n ")" ::: "memory")
#define PG8_WAIT_L(n) asm volatile("s_waitcnt lgkmcnt(" #n ")" ::: "memory")
#define PG8_BAR __builtin_amdgcn_s_barrier()
#define PG8_SCHED __builtin_amdgcn_sched_barrier(0)
    Unit cur, nxt; int ui = 0;
    if (!S.next(0, cur)) return;
    f32x4 acc[2][2][4][2];
#pragma unroll
    for (int a = 0; a < 2; ++a)
#pragma unroll
        for (int b = 0; b < 2; ++b)
#pragma unroll
            for (int m = 0; m < 4; ++m)
#pragma unroll
                for (int n = 0; n < 2; ++n) acc[a][b][m][n] = (f32x4){0.f, 0.f, 0.f, 0.f};
    bf16x8 At[4][2], B0[2][2], B1[2][2];
    const char* cA = (const char*)g.A + (size_t)cur.pm * tstep + (size_t)cur.kt0() * kstep; const char* cB = (const char*)g.Bt + (size_t)cur.pn * tstep + (size_t)cur.kt0() * kstep;
    S.a_ready(cur);
    PG8_STAGE(PG8_SB(0, 0), cB, voffB); PG8_STAGE(PG8_SA(0, 0), cA, voffA); PG8_STAGE(PG8_SB(0, 1), cB + hstep, voffB); PG8_STAGE(PG8_SA(0, 1), cA + hstep, voffA);
    if (wr == 1) PG8_BAR;
    PG8_WAIT_V(4); PG8_BAR;
    PG8_STAGE(PG8_SB(1, 0), cB + kstep, voffB); PG8_STAGE(PG8_SA(1, 0), cA + kstep, voffA); PG8_STAGE(PG8_SB(1, 1), cB + hstep + kstep, voffB);
    PG8_WAIT_V(6); PG8_BAR;
    PG8_STAMP();
    for (;;) {
        const bool has_next = S.next(ui + 1, nxt);
        const char* nA = has_next ? (const char*)g.A + (size_t)nxt.pm * tstep + (size_t)nxt.kt0() * kstep : cA; const char* nB = has_next ? (const char*)g.Bt + (size_t)nxt.pn * tstep + (size_t)nxt.kt0() * kstep : cB;
        const int cnt = cur.nkt();
        for (int t = 0; t < cnt; t += 2) {
            const bool last = (t == cnt - 2);
            const char* a1 = cA + (size_t)(t + 1) * kstep;
            const char* a2 = last ? nA : cA + (size_t)(t + 2) * kstep; const char* b2 = last ? nB : cB + (size_t)(t + 2) * kstep;
            const char* a3 = a2 + kstep; const char* b3 = b2 + kstep;
            if (last && has_next) S.a_ready(nxt);
            PG8_LDB(B0, 0, 0); PG8_SCHED; PG8_LDA(At, 0, 0); PG8_STAGE(PG8_SA(1, 1), a1 + hstep, voffA);
            PG8_WAIT_L(8); PG8_BAR; PG8_WAIT_L(0); PG8_MMA(0, 0, At, B0); PG8_BAR; PG8_SCHED;
            PG8_LDB(B1, 0, 1); PG8_STAGE(PG8_SB(0, 0), b2, voffB);
            PG8_BAR; PG8_WAIT_L(0); PG8_MMA(0, 1, At, B1); PG8_BAR;
            PG8_LDA(At, 0, 1); PG8_STAGE(PG8_SA(0, 0), a2, voffA);
            PG8_BAR; PG8_WAIT_L(0); PG8_MMA(1, 0, At, B0); PG8_BAR; PG8_SCHED;
            PG8_STAGE(PG8_SB(0, 1), b2 + hstep, voffB);
            PG8_WAIT_V(6); PG8_BAR; PG8_MMA(1, 1, At, B1); PG8_BAR;
            PG8_LDB(B0, 1, 0); PG8_SCHED; PG8_LDA(At, 1, 0); PG8_STAGE(PG8_SA(0, 1), a2 + hstep, voffA);
            PG8_WAIT_L(8); PG8_BAR; PG8_WAIT_L(0); PG8_MMA(0, 0, At, B0); PG8_BAR; PG8_SCHED;
            PG8_LDB(B1, 1, 1); PG8_STAGE(PG8_SB(1, 0), b3, voffB);
            PG8_BAR; PG8_WAIT_L(0); PG8_MMA(0, 1, At, B1); PG8_BAR;
            PG8_LDA(At, 1, 1); PG8_STAGE(PG8_SA(1, 0), a3, voffA);
            PG8_BAR; PG8_WAIT_L(0); PG8_MMA(1, 0, At, B0); PG8_BAR; PG8_SCHED;
            PG8_STAGE(PG8_SB(1, 1), b3 + hstep, voffB);
            PG8_WAIT_V(6); PG8_BAR; PG8_MMA(1, 1, At, B1); PG8_BAR;
        }
        PG8_STAMP();
        if constexpr (!Epi::AFTER_DRAIN) { E(acc, cur, wr, wc, fr, fq); S.done(cur); }
        PG8_STAMP();
        if (!has_next) break;
#pragma unroll
        for (int a = 0; a < 2; ++a)
#pragma unroll
            for (int b = 0; b < 2; ++b)
#pragma unroll
                for (int m = 0; m < 4; ++m)
#pragma unroll
                    for (int n = 0; n < 2; ++n) acc[a][b][m][n] = (f32x4){0.f, 0.f, 0.f, 0.f};
        cur = nxt; cA = nA; cB = nB; ++ui;
    }
    PG8_WAIT_V(0);
    if (wr == 0) PG8_BAR;
    PG8_BAR;
    if constexpr (Epi::AFTER_DRAIN) { E.fused(acc, cur, wr, wc, fr, fq, lds, wid, lane); S.done(cur); }
    PG8_STAMP();
    if (STAMP && wid == 0) { stamps[lane] = lane < nts ? (((unsigned long long)(unsigned)ts_hi << 32) | (unsigned)ts_lo) : 0ull;
        if (lane == 62) stamps[62] = rt_entry; if (lane == 63) stamps[63] = (unsigned long long)wall_clock64(); }
#undef PG8_STAMP
#undef PG8_SA
#undef PG8_SB
#undef PG8_STAGE
#undef PG8_LDA
#undef PG8_LDB
#undef PG8_MMA
#undef PG8_WAIT_V
#undef PG8_WAIT_L
#undef PG8_BAR
#undef PG8_SCHED
}
}

namespace mk {
using pg8::bf16_t; using pg8::bf16x8; using pg8::f32x4; using pg8::u32x4; using pg8::u32x2; using pg8::cvt_pk_bf16;
#define LAS PG8_LAS
typedef LAS unsigned char* ldsp;
#define XB_TMO      128
#define XB_XCNT(j)  (256  + 64 * (j))
#define XB_XSUB(j)  (1280 + 64 * (j))
#define XB_XGEN(j)  (2304 + 64 * (j))
#define XB_TOP      3328
#define XB_TOPGEN   3392
#define XCD_BAR_WORDS 3456
#define XB_SPIN_CAP (1u << 18)
__device__ __forceinline__ unsigned xb_ld(unsigned* p)              { return __hip_atomic_load(p, __ATOMIC_RELAXED, __HIP_MEMORY_SCOPE_AGENT); }
__device__ __forceinline__ unsigned xb_add(unsigned* p, unsigned v) { return __hip_atomic_fetch_add(p, v, __ATOMIC_RELAXED, __HIP_MEMORY_SCOPE_AGENT); }
__device__ __forceinline__ unsigned xb_xcc_id() { return (unsigned)__builtin_amdgcn_s_getreg((3 << 11) | 20) & 0xFu; }
#define XB_SPIN(cond, bar) do { unsigned _sp = 0; while (cond) { __builtin_amdgcn_s_sleep(1); \
    if ((++_sp & 255u) == 0u) { if (xb_ld(&(bar)[XB_TMO])) break; if (_sp > XB_SPIN_CAP) { atomicAdd(&(bar)[XB_TMO], 1u); break; } } } } while (0)

struct XcdBarrier {
    unsigned* bar; unsigned x;
    volatile LAS unsigned* st;
};

__device__ __forceinline__ XcdBarrier xcd_barrier_post(unsigned* bar, volatile LAS unsigned* st) {
    XcdBarrier b; b.bar = bar; b.x = xb_xcc_id(); b.st = st;
    if (threadIdx.x == 0) (void)xb_add(&bar[XB_XCNT(b.x)], 1u);
    return b;
}
__device__ __forceinline__ void xcd_barrier_complete(unsigned* bar, unsigned x, unsigned& nloc, unsigned& nx) {
    const unsigned G = gridDim.x * gridDim.y * gridDim.z;
    unsigned sum, cnt, mine, sp = 0u;
    for (;;) {
        sum = 0u; cnt = 0u; mine = 0u;
#pragma unroll
        for (unsigned j = 0; j < 16; ++j) { const unsigned c = xb_ld(&bar[XB_XCNT(j)]); sum += c; cnt += (c > 0u) ? 1u : 0u; mine = (j == x) ? c : mine; }
        if (sum == G) break;
        __builtin_amdgcn_s_sleep(1);
        if ((++sp & 255u) == 0u) { if (xb_ld(&bar[XB_TMO])) break; if (sp > XB_SPIN_CAP) { atomicAdd(&bar[XB_TMO], 1u); break; } }
    }
    nloc = mine > 0u ? mine : 1u; nx = cnt > 0u ? cnt : 1u;
}

__device__ __forceinline__ void xcd_barrier(const XcdBarrier& b) {
    asm volatile("s_waitcnt vmcnt(0)" ::: "memory");
    __syncthreads();
    if (threadIdx.x == 0) {
        unsigned* bar = b.bar;
        __builtin_amdgcn_s_waitcnt(0);
        unsigned nloc = b.st[0], nx = b.st[1];
        if (nloc == 0u) { xcd_barrier_complete(bar, b.x, nloc, nx); b.st[0] = nloc; b.st[1] = nx; }
        const unsigned old = xb_add(&bar[XB_XSUB(b.x)], 1u);
        const unsigned gen = old / nloc;
        if (old + 1u == (gen + 1u) * nloc) {
            __builtin_amdgcn_fence(__ATOMIC_RELEASE, "agent");
            asm volatile("s_waitcnt vmcnt(0)" ::: "memory");
            const unsigned og = xb_add(&bar[XB_TOP], 1u);
            const unsigned tg = og / nx;
            if (og + 1u == (tg + 1u) * nx) xb_add(&bar[XB_TOPGEN], 1u);
            else XB_SPIN(xb_ld(&bar[XB_TOPGEN]) == tg, bar);
            __builtin_amdgcn_fence(__ATOMIC_ACQUIRE, "agent");
            xb_add(&bar[XB_XGEN(b.x)], 1u);
            asm volatile("s_waitcnt vmcnt(0)" ::: "memory");
        } else {
            XB_SPIN(xb_ld(&bar[XB_XGEN(b.x)]) == gen, bar);
            __builtin_amdgcn_fence(__ATOMIC_ACQUIRE, "agent");
            asm volatile("s_waitcnt vmcnt(0)" ::: "memory");
        }
    }
    __syncthreads();
}

constexpr int T_P = 16384, T_S = 1024, TT = 17408, DM = 1024, NPROJ = 3584, DFF = 4096, INC = 3332;
constexpr int LEN_P = 2048, LEN_S = 8, NB_P = 8, NB_S = 128;
constexpr int LDS_BYTES = 138240, L_BARST = 131072;
constexpr int C_RQ = 0, C_RK = 256, C_RV = 512, C_RG = 768, C_HQ = 1024, C_HF = 1280, C_HI = 1536, C_HG = 1792, C_SZ = 2048, C_XBC = 2304, C_U = 3072, C_DT = 3328;
enum { I_XP = 0, I_XS, I_SRET, I_SHG, I_SSSD, I_SCONV, I_S5RE, I_S5IM, I_NMIX, I_WIN, I_WOUT, I_HGLB, I_CONVW, I_CONVB, I_DTB, I_ALOG, I_SSDD, I_SSDN,
       I_S5AR, I_S5AI, I_S5DT, I_S5BR, I_S5BI, I_S5CR, I_S5CI, I_S5D, I_GLUW, I_GLUB, I_NMLP, I_WUP, I_WDOWN, I_NFIN, N_IN };
constexpr size_t O_YP = 0, O_YS = 16777216, O_PRET = O_YS + 1048576, O_PHG = O_PRET + 262144, O_PSSD = O_PHG + 262144, O_PCONV = O_PSSD + 524288, O_PS5R = O_PCONV + 36864, O_PS5I = O_PS5R + 16384,
                 O_SRET = O_PS5I + 16384, O_SHG = O_SRET + 4194304, O_SSSD = O_SHG + 4194304, O_SCONV = O_SSSD + 8388608, O_SS5R = O_SCONV + 589824, O_SS5I = O_SS5R + 262144, O_END = O_SS5I + 262144;
constexpr size_t W_CTL = 0, W_BAR = 4096, W_WIN = 32768, W_WOUT = W_WIN + (size_t)2 * NPROJ * DM * 2, W_WUP = W_WOUT + (size_t)2 * DM * DM * 2, W_WDN = W_WUP + (size_t)2 * DFF * DM * 2, W_WGLU = W_WDN + (size_t)2 * DM * DFF * 2,
                 W_XB = W_WGLU + (size_t)2 * 256 * 256 * 2, W_MIX = W_XB + (size_t)TT * DM * 2, W_SSQ = W_MIX + (size_t)TT * DM * 2, W_SSDSQ = W_SSQ + (size_t)TT * 16 * 4, W_RSTD = W_SSDSQ + (size_t)TT * 4 * 4, W_HID = W_RSTD + (size_t)TT * 4,
                 W_END = W_HID + (size_t)TT * DFF * 2;
constexpr size_t W_PROJ = W_HID;
constexpr size_t W_YPRE = W_HID + (size_t)TT * NPROJ * 2;
static_assert(W_YPRE + (size_t)TT * 256 * 2 <= W_END, "ypre fits");
static_assert(W_END <= 268435456ull, "workspace fits 256 MiB");

struct Params { const float* in[N_IN]; float* out; unsigned char* ws; };
constexpr size_t W_TAB = 2048;
struct Ctx { float* out; unsigned char* ws; __device__ __forceinline__ const float* in(int i) const { return ((const float* const*)(ws + W_TAB))[i]; } };

__device__ __forceinline__ float bf2f(unsigned short b) { return __uint_as_float(((unsigned)b) << 16); }
__device__ __forceinline__ unsigned short f2bf(float f) { return __builtin_bit_cast(unsigned short, (__bf16)f); }
__device__ __forceinline__ float sigmoidf_(float x) { return 1.0f / (1.0f + __expf(-x)); }
__device__ __forceinline__ float siluf_(float x) { return x / (1.0f + __expf(-x)); }
__device__ __forceinline__ void unpack8(const u32x4 w, float (&f)[8]) {
    f[0] = __uint_as_float(w.x << 16); f[1] = __uint_as_float(w.x & 0xffff0000u); f[2] = __uint_as_float(w.y << 16); f[3] = __uint_as_float(w.y & 0xffff0000u);
    f[4] = __uint_as_float(w.z << 16); f[5] = __uint_as_float(w.z & 0xffff0000u); f[6] = __uint_as_float(w.w << 16); f[7] = __uint_as_float(w.w & 0xffff0000u);
}
__device__ __forceinline__ u32x4 pack8(const float (&f)[8]) { u32x4 w; w.x = cvt_pk_bf16(f[0], f[1]); w.y = cvt_pk_bf16(f[2], f[3]); w.z = cvt_pk_bf16(f[4], f[5]); w.w = cvt_pk_bf16(f[6], f[7]); return w; }

template <int MODE>
__device__ __forceinline__ void convert_wt(const float* src, int ldsrc, bf16_t* dst, int K, int N, const float* kscale, ldsp lds, int vb, int nvb) {
    LAS float* tile = (LAS float*)lds;
    const int tid = pg8::opaque_tid(), nkt = K / 64, ntile = nkt * (N / 256);
    for (int tl = vb; tl < ntile; tl += nvb) {
        const int k0 = (tl % nkt) * 64, n0 = (tl / nkt) * 256;
#pragma unroll
        for (int i = 0; i < 8; ++i) {
            const int idx = tid + i * 512, kk = idx >> 6, n = n0 + (idx & 63) * 4;
            int sc = n;
            if (MODE == 1) sc = (n < 3072) ? n : (n < 3328 ? n + 4 : (n < 3332 ? n - 256 : -1));
            f32x4 v = {0.f, 0.f, 0.f, 0.f};
            if (sc >= 0) { v = *(const f32x4*)(src + (size_t)(k0 + kk) * ldsrc + sc); if (kscale) v = v * kscale[k0 + kk]; }
            *(LAS f32x4*)(tile + kk * 260 + (idx & 63) * 4) = v;
        }
        __syncthreads();
#pragma unroll
        for (int i = 0; i < 4; ++i) {
            const int idx = tid + i * 512, nl = idx >> 3, k8 = (idx & 7) * 8;
            float f[8];
#pragma unroll
            for (int j = 0; j < 8; ++j) f[j] = tile[(k8 + j) * 260 + nl];
            *(u32x4*)(dst + (size_t)(n0 + nl) * K + k0 + k8) = pack8(f);
        }
        __syncthreads();
    }
}
__device__ __forceinline__ void phase0(const Params& P, ldsp lds) {
    unsigned char* ws = P.ws;
    const int G = gridDim.x, b = blockIdx.x;
    for (int l = 0; l < 2; ++l) {
        convert_wt<1>(P.in[I_WIN] + (size_t)l * DM * INC, INC, (bf16_t*)(ws + W_WIN) + (size_t)l * NPROJ * DM, DM, NPROJ, P.in[I_NMIX] + l * DM, lds, b, G);
        convert_wt<0>(P.in[I_WOUT] + (size_t)l * DM * DM, DM, (bf16_t*)(ws + W_WOUT) + (size_t)l * DM * DM, DM, DM, nullptr, lds, (b + 64) % G, G);
        convert_wt<0>(P.in[I_WUP] + (size_t)l * DM * DFF, DFF, (bf16_t*)(ws + W_WUP) + (size_t)l * DFF * DM, DM, DFF, P.in[I_NMLP] + l * DM, lds, (b + 128) % G, G);
        convert_wt<0>(P.in[I_WDOWN] + (size_t)l * DFF * DM, DM, (bf16_t*)(ws + W_WDN) + (size_t)l * DM * DFF, DFF, DM, nullptr, lds, (b + 192) % G, G);
        convert_wt<0>(P.in[I_GLUW] + (size_t)l * 256 * 256, 256, (bf16_t*)(ws + W_WGLU) + (size_t)l * 256 * 256, 256, 256, nullptr, lds, (b + 32) % G, G);
    }
    const int tid_ = pg8::opaque_tid(), wave = tid_ >> 6, lane = tid_ & 63;
    bf16_t* XB = (bf16_t*)(ws + W_XB); float* SSQ = (float*)(ws + W_SSQ);
    const int stride = G * 8;
    for (int rb = b * 8 + wave; rb < TT; rb += 4 * stride) {
        f32x4 v[4][4];
#pragma unroll
        for (int u = 0; u < 4; ++u) {
            const int row = rb + u * stride;
            const float* xp = (row < T_P) ? (P.in[I_XP] + (size_t)row * DM) : (P.in[I_XS] + (size_t)(row - T_P) * DM);
#pragma unroll
            for (int j = 0; j < 4; ++j) v[u][j] = (row < TT) ? *(const f32x4*)(xp + j * 256 + lane * 4) : (f32x4){0.f, 0.f, 0.f, 0.f};
        }
#pragma unroll
        for (int u = 0; u < 4; ++u) {
            const int row = rb + u * stride;
            if (row < TT) {
                float s = 0.f;
#pragma unroll
                for (int j = 0; j < 4; ++j) {
                    const f32x4 x = v[u][j];
                    s += (x[0] * x[0] + x[1] * x[1]) + (x[2] * x[2] + x[3] * x[3]);
                    u32x2 w; w.x = cvt_pk_bf16(x[0], x[1]); w.y = cvt_pk_bf16(x[2], x[3]);
                    *(u32x2*)(XB + (size_t)row * DM + j * 256 + lane * 4) = w;
                    if (row >= T_P) *(f32x4*)(P.out + (size_t)row * DM + j * 256 + lane * 4) = x;
                }
#pragma unroll
                for (int o = 32; o >= 1; o >>= 1) s += __shfl_xor(s, o);
                if (lane < 16) SSQ[(size_t)row * 16 + lane] = (lane == 0) ? s : 0.f;
                if (lane == 0) ((float*)(ws + W_RSTD))[row] = rsqrtf(s * (1.0f / 1024.0f) + 1e-6f);
            }
        }
    }
}

constexpr int QS = 136, RS = 72, OS = 68;
constexpr int L_QI = 0, L_KI = 17408, L_KDT = 34816, L_VT = 53248, L_ST = 62464, L_FL = 79872, L_P = 83968, L_OB = 93184, L_XT = 110592, L_RAW = L_P, L_QSLOT = 130048;
constexpr int F_B = 0, F_RS = 64, F_CS = 128, F_DL = 256, F_KS = 320, F_SEG = 384;

__device__ __forceinline__ void lds_barrier() { asm volatile("s_waitcnt lgkmcnt(0)" ::: "memory"); __builtin_amdgcn_s_barrier(); asm volatile("" ::: "memory"); }
__device__ __forceinline__ f32x4 mma_tile(const LAS bf16_t* A, int lda, const LAS bf16_t* B, int ldb, int K, f32x4 acc, int r, int q) {
    for (int k0 = 0; k0 < K; k0 += 32) {
        const bf16x8 a = *(const LAS bf16x8*)(A + r * lda + k0 + q * 8);
        const bf16x8 b = *(const LAS bf16x8*)(B + r * ldb + k0 + q * 8);
        acc = __builtin_amdgcn_mfma_f32_16x16x32_bf16(a, b, acc, 0, 0, 0);
    }
    return acc;
}
template <int DK, int DMODE>
__device__ __forceinline__ void la_scores(ldsp lds, int wave, int lane, float lg2) {
    const LAS bf16_t* Qi = (const LAS bf16_t*)(lds + L_QI); const LAS bf16_t* Ki = (const LAS bf16_t*)(lds + L_KI);
    LAS bf16_t* Pm = (LAS bf16_t*)(lds + L_P); const LAS float* FL = (const LAS float*)(lds + L_FL);
    const int r = lane & 15, q = lane >> 4;
#pragma unroll
    for (int i = 0; i < 2; ++i) {
        const int id = wave * 2 + i, tm = id >> 2, tn = id & 3;
        f32x4 acc = {0.f, 0.f, 0.f, 0.f};
        if (tn <= tm) acc = mma_tile(Qi + tm * 16 * QS, QS, Ki + tn * 16 * QS, QS, DK, acc, r, q);
#pragma unroll
        for (int j = 0; j < 4; ++j) {
            const int t = tm * 16 + q * 4 + j, s = tn * 16 + r;
            float v = acc[j];
            if (DMODE == 1) v *= exp2f((float)(t - s) * lg2);
            if (DMODE == 2) v *= __expf(fminf(FL[F_B + t] - FL[F_B + s], 0.f));
            v = (s <= t) ? v : 0.f;
            Pm[t * RS + s] = f2bf(v);
        }
    }
}
template <int DK, bool SEPQC>
__device__ __forceinline__ void la_out(ldsp lds, int wave, int lane) {
    const LAS bf16_t* Qx = (const LAS bf16_t*)(lds + (SEPQC ? L_XT : L_QI)); const LAS bf16_t* Pm = (const LAS bf16_t*)(lds + L_P);
    const LAS bf16_t* Vt = (const LAS bf16_t*)(lds + L_VT); const LAS bf16_t* St = (const LAS bf16_t*)(lds + L_ST);
    LAS float* Ob = (LAS float*)(lds + L_OB); const LAS float* FL = (const LAS float*)(lds + L_FL);
    const int r = lane & 15, q = lane >> 4;
#pragma unroll
    for (int i = 0; i < 2; ++i) {
        const int id = wave * 2 + i, tm = id >> 2, tv = id & 3;
        f32x4 a1 = {0.f, 0.f, 0.f, 0.f}, a2 = {0.f, 0.f, 0.f, 0.f};
        a1 = mma_tile(Pm + tm * 16 * RS, RS, Vt + tv * 16 * RS, RS, 64, a1, r, q);
        a2 = mma_tile(Qx + tm * 16 * QS, QS, St + tv * 16 * QS, QS, DK, a2, r, q);
#pragma unroll
        for (int j = 0; j < 4; ++j) {
            const int t = tm * 16 + q * 4 + j, v = tv * 16 + r;
            Ob[t * OS + v] = a1[j] + (SEPQC ? a2[j] : FL[F_RS + t] * a2[j]);
        }
    }
}
template <int DK>
__device__ __forceinline__ void la_state(ldsp lds, int wave, int lane, f32x4 (&sacc)[DK / 32]) {
    constexpr int NT = DK / 32, TK = DK / 16;
    const LAS bf16_t* Vt = (const LAS bf16_t*)(lds + L_VT); const LAS bf16_t* Kdt = (const LAS bf16_t*)(lds + L_KDT);
    LAS bf16_t* St = (LAS bf16_t*)(lds + L_ST); const LAS float* FL = (const LAS float*)(lds + L_FL);
    const int r = lane & 15, q = lane >> 4;
#pragma unroll
    for (int i = 0; i < NT; ++i) {
        const int id = wave * NT + i, tv = id / TK, tk = id % TK;
        const float sc = FL[F_CS + tk * 16 + r];
        sacc[i] = sacc[i] * sc;
        sacc[i] = mma_tile(Vt + tv * 16 * RS, RS, Kdt + tk * 16 * RS, RS, 64, sacc[i], r, q);
#pragma unroll
        for (int j = 0; j < 4; ++j) St[(tv * 16 + q * 4 + j) * QS + tk * 16 + r] = f2bf(sacc[i][j]);
    }
}
template <int DK>
__device__ __forceinline__ void la_state_init(ldsp lds, int wave, int lane, f32x4 (&sacc)[DK / 32], const float* s0  ) {
    constexpr int NT = DK / 32, TK = DK / 16;
    LAS bf16_t* St = (LAS bf16_t*)(lds + L_ST);
    const int r = lane & 15, q = lane >> 4;
#pragma unroll
    for (int i = 0; i < NT; ++i) {
        const int id = wave * NT + i, tv = id / TK, tk = id % TK;
        f32x4 v = {0.f, 0.f, 0.f, 0.f};
        if (s0) v = *(const f32x4*)(s0 + (size_t)(tk * 16 + r) * 64 + tv * 16 + q * 4);
        sacc[i] = v;
#pragma unroll
        for (int j = 0; j < 4; ++j) St[(tv * 16 + q * 4 + j) * QS + tk * 16 + r] = f2bf(v[j]);
    }
}
template <int DK>
__device__ __forceinline__ void la_state_store(int wave, int lane, const f32x4 (&sacc)[DK / 32], float* so  ) {
    constexpr int NT = DK / 32, TK = DK / 16;
    const int r = lane & 15, q = lane >> 4;
#pragma unroll
    for (int i = 0; i < NT; ++i) {
        const int id = wave * NT + i, tv = id / TK, tk = id % TK;
        *(f32x4*)(so + (size_t)(tk * 16 + r) * 64 + tv * 16 + q * 4) = sacc[i];
    }
}

struct SeqInfo { int L, row0, pos0, b; bool sample; };
__device__ __forceinline__ SeqInfo seq_info(int seq) {
    SeqInfo s;
    if (seq < NB_P) { s.L = LEN_P; s.row0 = seq * LEN_P; s.pos0 = 0; s.b = seq; s.sample = false; }
    else { s.L = LEN_S; s.row0 = T_P + (seq - NB_P) * LEN_S; s.pos0 = 16384; s.b = seq - NB_P; s.sample = true; }
    return s;
}
constexpr int NS = 8, SL = 256;
constexpr size_t SG_RET = 0, SG_HG = SG_RET + (size_t)8 * 4 * NS * 4096 * 4, SG_SSD = SG_HG + (size_t)8 * 4 * NS * 4096 * 4, SG_HGD = SG_SSD + (size_t)8 * 4 * NS * 8192 * 4,
                 SG_SSDD = SG_HGD + (size_t)8 * 4 * NS * 64 * 4, SG_S5 = SG_SSDD + 4096, SG_END = SG_S5 + (size_t)8 * 16 * NS * 64 * 8;
static_assert(SG_END <= (size_t)TT * DM * 2, "segment scratch fits the XB region");

template <int DK, int DMODE>
__device__ __forceinline__ void la_state_scan(ldsp lds, int wave, int lane, f32x4 (&sacc)[DK / 32], const float* segb, int seg, float dsc, const float* dtab) {
    constexpr int NT = DK / 32, TK = DK / 16;
    LAS bf16_t* St = (LAS bf16_t*)(lds + L_ST);
    const int r = lane & 15, q = lane >> 4;
#pragma unroll
    for (int i = 0; i < NT; ++i) sacc[i] = (f32x4){0.f, 0.f, 0.f, 0.f};
#pragma unroll 4
    for (int s = 0; s < seg; ++s) {
#pragma unroll
        for (int i = 0; i < NT; ++i) {
            const int id = wave * NT + i, tv = id / TK, tk = id % TK;
            float sc = dsc;
            if (DMODE == 1) sc = dtab[s * 64 + tk * 16 + r];
            if (DMODE == 2) sc = dtab[s];
            const f32x4 v = *(const f32x4*)(segb + (size_t)s * DK * 64 + (size_t)(tk * 16 + r) * 64 + tv * 16 + q * 4);
            sacc[i] = sacc[i] * sc + v;
        }
    }
#pragma unroll
    for (int i = 0; i < NT; ++i) {
        const int id = wave * NT + i, tv = id / TK, tk = id % TK;
#pragma unroll
        for (int j = 0; j < 4; ++j) St[(tv * 16 + q * 4 + j) * QS + tk * 16 + r] = f2bf(sacc[i][j]);
    }
}

__device__ __forceinline__ void ret_item(const Ctx& P, int l, int seq, int h, int tb, int te, int init, int full, int store, int seg, ldsp lds) {
    const SeqInfo si = seq_info(seq);
    const int tid = pg8::opaque_tid(), wave = tid >> 6, lane = tid & 63;
    const bf16_t* PROJ = (const bf16_t*)(P.ws + W_PROJ); bf16_t* MIX = (bf16_t*)(P.ws + W_MIX);
    LAS bf16_t* Qi = (LAS bf16_t*)(lds + L_QI); LAS bf16_t* Ki = (LAS bf16_t*)(lds + L_KI); LAS bf16_t* Kdt = (LAS bf16_t*)(lds + L_KDT); LAS bf16_t* Vt = (LAS bf16_t*)(lds + L_VT);
    LAS float* FL = (LAS float*)(lds + L_FL); const LAS float* Ob = (const LAS float*)(lds + L_OB);
    const float lg2 = log2f(1.0f - exp2f(-5.0f - (float)h));
    float* segb = (float*)(P.ws + W_XB + SG_RET) + (size_t)((seq & 7) * 4 + h) * NS * 4096;
    f32x4 sacc[2];
    if (init == 2) la_state_scan<64, 0>(lds, wave, lane, sacc, segb, seg, exp2f((float)SL * lg2), nullptr);
    else la_state_init<64>(lds, wave, lane, sacc, init == 1 ? (P.in(I_SRET) + ((size_t)(l * NB_S + si.b) * 4 + h) * 4096) : nullptr);
    const int t = tid >> 3, c0 = (tid & 7) * 8;
    float ang[4];
#pragma unroll
    for (int i = 0; i < 4; ++i) ang[i] = exp2f(-(float)(c0 / 2 + i) * (13.287712379549449f / 31.0f));
    u32x4 rq, rk, rv, rg;
#define RET_LOAD(T0) do { rq = (u32x4){0u, 0u, 0u, 0u}; rk = rq; rv = rq; rg = rq; \
        if ((T0) < te && t < te - (T0)) { const bf16_t* pp_ = PROJ + (size_t)(si.row0 + (T0) + t) * NPROJ + h * 64 + c0; \
            rq = *(const u32x4*)(pp_ + C_RQ); rk = *(const u32x4*)(pp_ + C_RK); rv = *(const u32x4*)(pp_ + C_RV); if (full) rg = *(const u32x4*)(pp_ + C_RG); } } while (0)
    RET_LOAD(tb);
    for (int t0 = tb; t0 < te; t0 += 64) {
        const int nv = min(64, te - t0);
        const bool valid = t < nv;
        const size_t row = (size_t)(si.row0 + t0 + t);
        float qf[8], kf[8], vf[8];
        unpack8(rq, qf); unpack8(rk, kf); unpack8(rv, vf);
        const u32x4 gcur = rg;
        if (valid) {
            const double pos = (double)(si.pos0 + t0 + t);
#pragma unroll
            for (int i = 0; i < 4; ++i) {
                const double tr = pos * (double)ang[i] * 0.15915494309189535;
                const float fr = (float)(tr - floor(tr)) * 6.283185307179586f;
                const float sn = __sinf(fr), cs = __cosf(fr);
                const float q1 = qf[2 * i], q2 = qf[2 * i + 1], k1 = kf[2 * i] * 0.125f, k2 = kf[2 * i + 1] * 0.125f;
                if (full) { qf[2 * i] = q1 * cs - q2 * sn; qf[2 * i + 1] = q1 * sn + q2 * cs; }
                kf[2 * i] = k1 * cs - k2 * sn; kf[2 * i + 1] = k1 * sn + k2 * cs;
            }
        }
        const float gq = exp2f((float)t * lg2), gk = exp2f(-(float)t * lg2);
#pragma unroll
        for (int i = 0; i < 8; ++i) { qf[i] *= gq; kf[i] *= gk; }
        if (full) { *(LAS u32x4*)(Qi + t * QS + c0) = pack8(qf); *(LAS u32x4*)(Ki + t * QS + c0) = pack8(kf); }
        const float kd = exp2f((float)(nv - 1) * lg2);
#pragma unroll
        for (int i = 0; i < 8; ++i) { Kdt[(c0 + i) * RS + t] = f2bf(kf[i] * kd); Vt[(c0 + i) * RS + t] = f2bf(vf[i]); }
        if ((tid & 7) == 0) FL[F_RS + t] = exp2f(lg2);
        if (tid < 64) FL[F_CS + tid] = exp2f((float)nv * lg2);
        RET_LOAD(t0 + 64);
        lds_barrier();
        if (full) {
            la_scores<64, 0>(lds, wave, lane, 0.f);
            lds_barrier();
            la_out<64, false>(lds, wave, lane);
            lds_barrier();
        }
        la_state<64>(lds, wave, lane, sacc);
        if (full) {
            float o[8]; float s = 0.f;
#pragma unroll
            for (int i = 0; i < 8; ++i) { o[i] = Ob[t * OS + c0 + i]; s += o[i]; }
            s += __shfl_xor(s, 1); s += __shfl_xor(s, 2); s += __shfl_xor(s, 4);
            const float mu = s * (1.0f / 64.0f); float vq = 0.f;
#pragma unroll
            for (int i = 0; i < 8; ++i) { o[i] -= mu; vq += o[i] * o[i]; }
            vq += __shfl_xor(vq, 1); vq += __shfl_xor(vq, 2); vq += __shfl_xor(vq, 4);
            const float rstd = rsqrtf(vq * (1.0f / 64.0f) + 1e-6f);
            if (valid) {
                float g[8]; unpack8(gcur, g);
#pragma unroll
                for (int i = 0; i < 8; ++i) o[i] = o[i] * rstd * siluf_(g[i]);
                *(u32x4*)(MIX + row * DM + h * 64 + c0) = pack8(o);
            }
        }
        lds_barrier();
    }
#undef RET_LOAD
    if (store == 1) la_state_store<64>(wave, lane, sacc, P.out + (si.sample ? (O_SRET + ((size_t)(l * NB_S + si.b) * 4 + h) * 4096) : (O_PRET + ((size_t)(l * NB_P + si.b) * 4 + h) * 4096)));
    if (store == 2) la_state_store<64>(wave, lane, sacc, segb + (size_t)seg * 4096);
}

__device__ __forceinline__ void hgrn_item(const Ctx& P, int l, int seq, int h, int tb, int te, int init, int full, int store, int seg, ldsp lds) {
    const SeqInfo si = seq_info(seq);
    const int tid = pg8::opaque_tid(), wave = tid >> 6, lane = tid & 63;
    const bf16_t* PROJ = (const bf16_t*)(P.ws + W_PROJ); bf16_t* MIX = (bf16_t*)(P.ws + W_MIX);
    LAS bf16_t* Qi = (LAS bf16_t*)(lds + L_QI); LAS bf16_t* Ki = (LAS bf16_t*)(lds + L_KI); LAS bf16_t* Kdt = (LAS bf16_t*)(lds + L_KDT); LAS bf16_t* Vt = (LAS bf16_t*)(lds + L_VT);
    LAS bf16_t* Qc = (LAS bf16_t*)(lds + L_XT);
    LAS float* FL = (LAS float*)(lds + L_FL); const LAS float* Ob = (const LAS float*)(lds + L_OB);
    float* segb = (float*)(P.ws + W_XB + SG_HG) + (size_t)((seq & 7) * 4 + h) * NS * 4096;
    float* segd = (float*)(P.ws + W_XB + SG_HGD) + (size_t)((seq & 7) * 4 + h) * NS * 64;
    f32x4 sacc[2];
    if (init == 2) la_state_scan<64, 1>(lds, wave, lane, sacc, segb, seg, 1.f, segd);
    else la_state_init<64>(lds, wave, lane, sacc, init == 1 ? (P.in(I_SHG) + ((size_t)(l * NB_S + si.b) * 4 + h) * 4096) : nullptr);
    const int k = lane, sg = wave;
    float lower = 0.f;
    if (l == 1) { const float a0 = P.in(I_HGLB)[h * 64 + k], a1 = P.in(I_HGLB)[256 + h * 64 + k]; lower = 1.0f / (1.0f + expf(a0 - a1)); }
    const int tp = tid >> 3, c0 = (tid & 7) * 8;
    float cumlog = 0.f;
    unsigned short pq[8], pf[8], pi_[8]; u32x4 rg;
#define HG_LOAD(T0) do { rg = (u32x4){0u, 0u, 0u, 0u}; \
        _Pragma("unroll") for (int j = 0; j < 8; ++j) { pq[j] = 0; pf[j] = 0; pi_[j] = 0; const int tt_ = sg * 8 + j; \
            if ((T0) < te && tt_ < te - (T0)) { const size_t b_ = (size_t)(si.row0 + (T0) + tt_) * NPROJ + h * 64 + k; pq[j] = PROJ[b_ + C_HQ]; pf[j] = PROJ[b_ + C_HF]; pi_[j] = PROJ[b_ + C_HI]; } } \
        if (full && (T0) < te && tp < te - (T0)) rg = *(const u32x4*)(PROJ + (size_t)(si.row0 + (T0) + tp) * NPROJ + C_HG + h * 64 + c0); } while (0)
    HG_LOAD(tb);
    for (int t0 = tb; t0 < te; t0 += 64) {
        const int nv = min(64, te - t0);
        float cs[8], ky[8], qs[8], vv[8];
        float run = 0.f;
#pragma unroll
        for (int j = 0; j < 8; ++j) {
            const int t = sg * 8 + j;
            float lf = 0.f; ky[j] = 0.f; qs[j] = 0.f; vv[j] = 0.f;
            if (t < nv) {
                const float qq = bf2f(pq[j]), ff = bf2f(pf[j]), ii = bf2f(pi_[j]);
                const float ef = __expf(-fminf(fmaxf(ff, -30.f), 30.f));
                const float sgm = 1.0f / (1.0f + ef);
                const float forget = lower + (1.0f - lower) * sgm;
                lf = __logf(fmaxf(forget, 1e-30f));
                ky[j] = (1.0f - lower) * ef * sgm;
                if (full) qs[j] = qq / (1.0f + __expf(-qq));
                vv[j] = ii;
            }
            run += lf; cs[j] = run;
        }
        const u32x4 gcur = rg;
        FL[F_SEG + sg * 64 + k] = run;
        HG_LOAD(t0 + 64);
        lds_barrier();
        float pre = 0.f, tot = 0.f, bref = 0.f;
#pragma unroll
        for (int s = 0; s < 8; ++s) { const float x = FL[F_SEG + s * 64 + k]; if (s < sg) pre += x; if (s < 4) bref += x; tot += x; }
        cumlog += tot;
        const float eb = __expf(bref), et = __expf(tot - bref);
        float kdv[8];
#pragma unroll
        for (int j = 0; j < 8; ++j) {
            const int t = sg * 8 + j; const float b = pre + cs[j];
            if (full) {
                const float e1 = __expf(fminf(fmaxf(b - bref, -80.f), 80.f)), r1 = __builtin_amdgcn_rcpf(e1);
                Qi[t * QS + k] = f2bf(qs[j] * e1);
                Ki[t * QS + k] = f2bf(ky[j] * r1);
                Qc[t * QS + k] = f2bf(qs[j] * e1 * eb);
                kdv[j] = ky[j] * r1 * et;
            } else kdv[j] = ky[j] * __expf(tot - b);
        }
        *(LAS u32x4*)(Kdt + k * RS + sg * 8) = pack8(kdv);
        *(LAS u32x4*)(Vt + k * RS + sg * 8) = pack8(vv);
        if (sg == 0) FL[F_CS + k] = __expf(tot);
        lds_barrier();
        if (full) {
            la_scores<64, 0>(lds, wave, lane, 0.f);
            lds_barrier();
            la_out<64, true>(lds, wave, lane);
            lds_barrier();
        }
        la_state<64>(lds, wave, lane, sacc);
        if (full) {
            float o[8]; float s = 0.f;
#pragma unroll
            for (int i = 0; i < 8; ++i) { o[i] = Ob[tp * OS + c0 + i]; s += o[i] * o[i]; }
            s += __shfl_xor(s, 1); s += __shfl_xor(s, 2); s += __shfl_xor(s, 4);
            const float rstd = rsqrtf(s * (1.0f / 64.0f) + 1e-6f);
            if (tp < nv) {
                const size_t row = (size_t)(si.row0 + t0 + tp);
                float g[8]; unpack8(gcur, g);
#pragma unroll
                for (int i = 0; i < 8; ++i) o[i] = o[i] * rstd * siluf_(g[i]);
                *(u32x4*)(MIX + row * DM + 256 + h * 64 + c0) = pack8(o);
            }
        }
        lds_barrier();
    }
#undef HG_LOAD
    if (store == 1) la_state_store<64>(wave, lane, sacc, P.out + (si.sample ? (O_SHG + ((size_t)(l * NB_S + si.b) * 4 + h) * 4096) : (O_PHG + ((size_t)(l * NB_P + si.b) * 4 + h) * 4096)));
    if (store == 2) { la_state_store<64>(wave, lane, sacc, segb + (size_t)seg * 4096); if (sg == 0) segd[seg * 64 + k] = __expf(cumlog); }
}

constexpr int L_CW = 131136;
__device__ __forceinline__ void ssd_item(const Ctx& P, int l, int seq, int h, int tb, int te, int init, int full, int store, int seg, ldsp lds) {
    const SeqInfo si = seq_info(seq);
    const int tid = pg8::opaque_tid(), wave = tid >> 6, lane = tid & 63, g = h >> 1;
    const bf16_t* PROJ = (const bf16_t*)(P.ws + W_PROJ); bf16_t* MIX = (bf16_t*)(P.ws + W_MIX); float* SSDSQ = (float*)(P.ws + W_SSDSQ);
    LAS bf16_t* Qi = (LAS bf16_t*)(lds + L_QI); LAS bf16_t* Ki = (LAS bf16_t*)(lds + L_KI); LAS bf16_t* Kdt = (LAS bf16_t*)(lds + L_KDT); LAS bf16_t* Vt = (LAS bf16_t*)(lds + L_VT);
    LAS bf16_t* RAW = (LAS bf16_t*)(lds + L_RAW);
    LAS float* FL = (LAS float*)(lds + L_FL); const LAS float* Ob = (const LAS float*)(lds + L_OB); LAS float* CW = (LAS float*)(lds + L_CW);
    float* segb = (float*)(P.ws + W_XB + SG_SSD) + (size_t)((seq & 7) * 4 + h) * NS * 8192;
    float* segd = (float*)(P.ws + W_XB + SG_SSDD) + (size_t)((seq & 7) * 4 + h) * NS;
    const float* cbuf = si.sample ? (P.in(I_SCONV) + (size_t)(l * NB_S + si.b) * 3 * 768) : nullptr;
    f32x4 sacc[4];
    if (init == 2) la_state_scan<128, 2>(lds, wave, lane, sacc, segb, seg, 1.f, segd);
    else la_state_init<128>(lds, wave, lane, sacc, init == 1 ? (P.in(I_SSSD) + ((size_t)(l * NB_S + si.b) * 4 + h) * 8192) : nullptr);
    const float dtb = P.in(I_DTB)[l * 4 + h], aexp = expf(P.in(I_ALOG)[l * 4 + h]), dsk = P.in(I_SSDD)[l * 4 + h];
    if (tid < 320) {
        const int cc = (tid < 64) ? (h * 64 + tid) : (tid < 192 ? 256 + g * 128 + (tid - 64) : 512 + g * 128 + (tid - 192));
        const float* cwp = P.in(I_CONVW) + (size_t)l * 4 * 768;
        CW[tid] = cwp[cc]; CW[320 + tid] = cwp[768 + cc]; CW[640 + tid] = cwp[2 * 768 + cc]; CW[960 + tid] = cwp[3 * 768 + cc]; CW[1280 + tid] = P.in(I_CONVB)[l * 768 + cc];
    }
    const int tp = tid >> 3, c0 = (tid & 7) * 8;
    float cumlog = 0.f;
    u32x4 rw[6]; u32x4 rz; unsigned short rdt;
    int stt[6], ssrc[6], slds[6];
#pragma unroll
    for (int i = 0; i < 6; ++i) { const int idx = tid + i * 512, tt = idx / 40, v8 = idx % 40;
        stt[i] = idx < 67 * 40 ? tt : -1000000; slds[i] = tt * 320 + v8 * 8;
        ssrc[i] = (v8 < 8) ? (h * 64 + v8 * 8) : (v8 < 24 ? 256 + g * 128 + (v8 - 8) * 8 : 512 + g * 128 + (v8 - 24) * 8); }
#define SSD_LOAD(T0) do { \
        _Pragma("unroll") for (int i_ = 0; i_ < 6; ++i_) { rw[i_] = (u32x4){0u, 0u, 0u, 0u}; const int ts_ = (T0) - 3 + stt[i_]; \
            if (stt[i_] >= 0 && (T0) < te) { const int sc_ = ssrc[i_]; \
                if (ts_ >= 0 && ts_ < te) rw[i_] = *(const u32x4*)(PROJ + (size_t)(si.row0 + ts_) * NPROJ + C_XBC + sc_); \
                else if (ts_ < 0 && cbuf) { const f32x4 a_ = *(const f32x4*)(cbuf + (ts_ + 3) * 768 + sc_), b_ = *(const f32x4*)(cbuf + (ts_ + 3) * 768 + sc_ + 4); \
                    rw[i_].x = cvt_pk_bf16(a_[0], a_[1]); rw[i_].y = cvt_pk_bf16(a_[2], a_[3]); rw[i_].z = cvt_pk_bf16(b_[0], b_[1]); rw[i_].w = cvt_pk_bf16(b_[2], b_[3]); } } } \
        rdt = 0; if (wave == 7 && (T0) < te && lane < te - (T0)) rdt = PROJ[(size_t)(si.row0 + (T0) + lane) * NPROJ + C_DT + h]; \
        rz = (u32x4){0u, 0u, 0u, 0u}; if (full && (T0) < te && tp < te - (T0)) rz = *(const u32x4*)(PROJ + (size_t)(si.row0 + (T0) + tp) * NPROJ + C_SZ + h * 64 + c0); } while (0)
    SSD_LOAD(tb);
    for (int t0 = tb; t0 < te; t0 += 64) {
        const int nv = min(64, te - t0);
#pragma unroll
        for (int i = 0; i < 6; ++i) { if (stt[i] >= 0) *(LAS u32x4*)(RAW + slds[i]) = rw[i]; }
        const u32x4 zcur = rz;
        if (wave == 7) {
            const int t = lane; float delta = 0.f, la = 0.f;
            if (t < nv) {
                const float dtv = bf2f(rdt) + dtb;
                delta = (dtv > 20.f) ? dtv : log1pf(__expf(dtv));
                la = -delta * aexp;
            }
            float b = la;
#pragma unroll
            for (int o = 1; o < 64; o <<= 1) { const float x = __shfl_up(b, o); if (lane >= o) b += x; }
            const float bl = __shfl(b, 63);
            cumlog += bl;
            FL[F_B + t] = b; FL[F_RS + t] = __expf(b); FL[F_DL + t] = delta; FL[F_KS + t] = delta * __expf(bl - b);
            FL[F_CS + t] = __expf(bl); FL[F_CS + 64 + t] = __expf(bl);
        }
        SSD_LOAD(t0 + 64);
        lds_barrier();
        for (int u = tid; u < 2560; u += 512) {
            const int c = u % 320, oc = u / 320;
            if (!full && c >= 192) continue;
            const float w0 = CW[c], w1 = CW[320 + c], w2 = CW[640 + c], w3 = CW[960 + c], bb = CW[1280 + c];
            float x0 = bf2f(RAW[(oc * 8 + 0) * 320 + c]), x1 = bf2f(RAW[(oc * 8 + 1) * 320 + c]), x2 = bf2f(RAW[(oc * 8 + 2) * 320 + c]);
            float ov[8];
#pragma unroll
            for (int j = 0; j < 8; ++j) {
                const int t = oc * 8 + j;
                const float x3 = bf2f(RAW[(t + 3) * 320 + c]);
                float v = bb + w0 * x0 + w1 * x1 + w2 * x2 + w3 * x3;
                v = siluf_(v);
                if (t >= nv) v = 0.f;
                ov[j] = v;
                x0 = x1; x1 = x2; x2 = x3;
            }
            if (c < 64) *(LAS u32x4*)(Vt + c * RS + oc * 8) = pack8(ov);
            else if (c < 192) {
                const int n = c - 64;
                if (full) {
#pragma unroll
                    for (int j = 0; j < 8; ++j) Ki[(oc * 8 + j) * QS + n] = f2bf(ov[j] * FL[F_DL + oc * 8 + j]);
                }
#pragma unroll
                for (int j = 0; j < 8; ++j) ov[j] *= FL[F_KS + oc * 8 + j];
                *(LAS u32x4*)(Kdt + n * RS + oc * 8) = pack8(ov);
            } else {
                const int n = c - 192;
#pragma unroll
                for (int j = 0; j < 8; ++j) Qi[(oc * 8 + j) * QS + n] = f2bf(ov[j]);
            }
        }
        lds_barrier();
        if (full) {
            la_scores<128, 2>(lds, wave, lane, 0.f);
            lds_barrier();
            la_out<128, false>(lds, wave, lane);
            lds_barrier();
        }
        la_state<128>(lds, wave, lane, sacc);
        if (full) {
            float o[8]; float s = 0.f;
            const size_t row = (size_t)(si.row0 + t0 + tp);
            float z[8]; unpack8(zcur, z);
#pragma unroll
            for (int i = 0; i < 8; ++i) { const float xs = bf2f(Vt[(c0 + i) * RS + tp]); o[i] = (Ob[tp * OS + c0 + i] + dsk * xs) * siluf_(z[i]); s += o[i] * o[i]; }
            s += __shfl_xor(s, 1); s += __shfl_xor(s, 2); s += __shfl_xor(s, 4);
            if (tp < nv) {
                *(u32x4*)(MIX + row * DM + 512 + h * 64 + c0) = pack8(o);
                if ((tid & 7) == 0) SSDSQ[row * 4 + h] = s;
            }
        }
        lds_barrier();
    }
#undef SSD_LOAD
    if (store == 1) la_state_store<128>(wave, lane, sacc, P.out + (si.sample ? (O_SSSD + ((size_t)(l * NB_S + si.b) * 4 + h) * 8192) : (O_PSSD + ((size_t)(l * NB_P + si.b) * 4 + h) * 8192)));
    if (store == 2) { la_state_store<128>(wave, lane, sacc, segb + (size_t)seg * 8192); if (tid == 7 * 64) segd[seg] = __expf(cumlog); }
    if (store == 1 && h == 0) {
        float* co = P.out + (si.sample ? (O_SCONV + (size_t)(l * NB_S + si.b) * 2304) : (O_PCONV + (size_t)(l * NB_P + si.b) * 2304));
        for (int idx = tid; idx < 2304; idx += 512) { const int rr = idx / 768, c = idx % 768; co[idx] = bf2f(PROJ[(size_t)(si.row0 + si.L - 3 + rr) * NPROJ + C_XBC + c]); }
    }
}

constexpr int S5W = 15360, S5_U = 0, S5_SB = 2048, S5_CB = 2048 + 8704, S5S = 136, S5C = 32;
__device__ __forceinline__ void s5_item(const Ctx& P, int l, int oct, int seq_b, int nseq, int tb, int te, int init, int full, int store, int seg, ldsp lds) {
    typedef float f32x2 __attribute__((ext_vector_type(2)));
    const int tid = pg8::opaque_tid(), w = tid >> 6, p = tid & 63, g = oct * 8 + w;
    const bf16_t* PROJ = (const bf16_t*)(P.ws + W_PROJ); bf16_t* YPRE = (bf16_t*)(P.ws + W_YPRE);
    LAS float* U = (LAS float*)(lds + w * S5W + S5_U); LAS bf16_t* Sb = (LAS bf16_t*)(lds + w * S5W + S5_SB); LAS bf16_t* Cb = (LAS bf16_t*)(lds + w * S5W + S5_CB);
    const int lg = l * 16 + g;
    const float are = P.in(I_S5AR)[lg * 64 + p], aim = P.in(I_S5AI)[lg * 64 + p], step = expf(P.in(I_S5DT)[lg]);
    const float mag = expf(are * step), angr = aim * step;
    const float abr = mag * cosf(angr), abi = mag * sinf(angr);
    const float d2 = are * are + aim * aim, nr = abr - 1.0f;
    const float cr = (nr * are + abi * aim) / d2, ci = (abi * are - nr * aim) / d2;
    f32x2 bb[16];
    {
        const f32x4* br = (const f32x4*)(P.in(I_S5BR) + ((size_t)lg * 64 + p) * 16); const f32x4* bi = (const f32x4*)(P.in(I_S5BI) + ((size_t)lg * 64 + p) * 16);
#pragma unroll
        for (int q4 = 0; q4 < 4; ++q4) { const f32x4 a = br[q4], b = bi[q4];
#pragma unroll
            for (int j = 0; j < 4; ++j) bb[q4 * 4 + j] = (f32x2){cr * a[j] - ci * b[j], cr * b[j] + ci * a[j]}; }
    }
#pragma unroll
    for (int hh = 0; hh < 16; ++hh)
        *(LAS unsigned*)(Cb + hh * S5S + 2 * p) = cvt_pk_bf16(P.in(I_S5CR)[((size_t)lg * 16 + hh) * 64 + p], -P.in(I_S5CI)[((size_t)lg * 16 + hh) * 64 + p]);
    const int r = p & 15, q = p >> 4;
    const float dk = P.in(I_S5D)[l * 256 + g * 16 + r];
    const int ut = p >> 1, uc = (p & 1) * 8;
    for (int sq = seq_b; sq < seq_b + nseq; ++sq) {
        const SeqInfo si = seq_info(sq);
        float sr = 0.f, sim = 0.f;
        if (init == 1) { sr = P.in(I_S5RE)[((size_t)(l * NB_S + si.b) * 16 + g) * 64 + p]; sim = P.in(I_S5IM)[((size_t)(l * NB_S + si.b) * 16 + g) * 64 + p]; }
        f32x2* segs = (f32x2*)(P.ws + W_XB + SG_S5) + (size_t)((sq & 7) * 16 + g) * NS * 64;
        if (init == 2) {
            float qr = abr, qi = abi;
            for (int s = 1; s < SL; s <<= 1) { const float nr_ = qr * qr - qi * qi, ni_ = 2.f * qr * qi; qr = nr_; qi = ni_; }
            for (int s = 0; s < seg; ++s) { const f32x2 e = segs[s * 64 + p]; const float nr_ = qr * sr - qi * sim + e.x, ni_ = qr * sim + qi * sr + e.y; sr = nr_; sim = ni_; }
        }
        u32x4 ru;
#define S5_LOAD(T0) do { ru = (u32x4){0u, 0u, 0u, 0u}; if ((T0) < te && ut < te - (T0)) ru = *(const u32x4*)(PROJ + (size_t)(si.row0 + (T0) + ut) * NPROJ + C_U + g * 16 + uc); } while (0)
        S5_LOAD(tb);
        for (int t0 = tb; t0 < te; t0 += S5C) {
            const int nv = min(S5C, te - t0);
            { float uf[8]; unpack8(ru, uf);
              *(LAS f32x4*)(U + ut * 16 + uc) = (f32x4){uf[0], uf[1], uf[2], uf[3]}; *(LAS f32x4*)(U + ut * 16 + uc + 4) = (f32x4){uf[4], uf[5], uf[6], uf[7]}; }
            S5_LOAD(t0 + S5C);
            asm volatile("s_waitcnt lgkmcnt(0)" ::: "memory"); __builtin_amdgcn_wave_barrier();
            float xr = sr, xi = sim;
            const int nvr = (nv + 3) & ~3;
#pragma unroll 4
            for (int t = 0; t < nvr; ++t) {
                const LAS f32x4* up = (const LAS f32x4*)(U + t * 16);
                f32x2 bu = {0.f, 0.f};
#pragma unroll
                for (int q4 = 0; q4 < 4; ++q4) { const f32x4 u4 = up[q4];
#pragma unroll
                    for (int e = 0; e < 4; ++e) bu += bb[q4 * 4 + e] * u4[e]; }
                const float nxr = abr * xr - abi * xi + bu.x, nxi = abr * xi + abi * xr + bu.y;
                xr = nxr; xi = nxi;
                if (full) *(LAS unsigned*)(Sb + t * S5S + 2 * p) = cvt_pk_bf16(xr, xi);
            }
            sr = xr; sim = xi;
            if (full) {
                asm volatile("s_waitcnt lgkmcnt(0)" ::: "memory"); __builtin_amdgcn_wave_barrier();
#pragma unroll
                for (int m = 0; m < 2; ++m) {
                    if (m * 16 >= nv) break;
                    f32x4 acc = {0.f, 0.f, 0.f, 0.f};
                    acc = mma_tile(Sb + m * 16 * S5S, S5S, Cb, S5S, 128, acc, r, q);
#pragma unroll
                    for (int j = 0; j < 4; ++j) {
                        const int t = m * 16 + q * 4 + j;
                        const float y = acc[j] + dk * U[t * 16 + r];
                        const float z = 0.7978845608028654f * (y + 0.044715f * y * y * y);
                        const float gl = y * (1.0f - 1.0f / (__expf(2.0f * z) + 1.0f));
                        if (t < nv) YPRE[(size_t)(si.row0 + t0 + t) * 256 + g * 16 + r] = f2bf(gl);
                    }
                }
                asm volatile("s_waitcnt lgkmcnt(0)" ::: "memory"); __builtin_amdgcn_wave_barrier();
            }
        }
#undef S5_LOAD
        if (store == 1) {
            float* ore = P.out + (si.sample ? (O_SS5R + ((size_t)(l * NB_S + si.b) * 16 + g) * 64) : (O_PS5R + ((size_t)(l * NB_P + si.b) * 16 + g) * 64));
            float* oim = P.out + (si.sample ? (O_SS5I + ((size_t)(l * NB_S + si.b) * 16 + g) * 64) : (O_PS5I + ((size_t)(l * NB_P + si.b) * 16 + g) * 64));
            ore[p] = sr; oim[p] = sim;
        }
        if (store == 2) segs[seg * 64 + p] = (f32x2){sr, sim};
    }
}

__device__ __forceinline__ float rdl(float x, int k) { return __uint_as_float((unsigned)__builtin_amdgcn_readlane((int)__float_as_uint(x), k)); }
__device__ __forceinline__ float wsum(float x) {
#pragma unroll
    for (int o = 32; o >= 1; o >>= 1) x += __shfl_xor(x, o);
    return x;
}
__device__ __forceinline__ void rh_sample_wave(const Ctx& P, int l, int b, int h, int lane, int isret) {
    const bf16_t* PROJ = (const bf16_t*)(P.ws + W_PROJ); bf16_t* MIX = (bf16_t*)(P.ws + W_MIX);
    const size_t so_ = ((size_t)(l * NB_S + b) * 4 + h) * 4096;
    const float* s0 = P.in(isret ? I_SRET : I_SHG) + so_; float* so = P.out + (isret ? O_SRET : O_SHG) + so_;
    float S[64];
#pragma unroll
    for (int k = 0; k < 64; ++k) S[k] = s0[k * 64 + lane];
    const float gam = 1.0f - exp2f(-5.0f - (float)h);
    const float angk = exp2f(-(float)(lane >> 1) * (13.287712379549449f / 31.0f)) * 0.15915494309189535f;
    float lower = 0.f;
    if (!isret && l == 1) { const float a0 = P.in(I_HGLB)[h * 64 + lane], a1 = P.in(I_HGLB)[256 + h * 64 + lane]; lower = 1.0f / (1.0f + expf(a0 - a1)); }
    const int cb = isret ? 0 : C_HQ;
#pragma unroll 1
    for (int t = 0; t < LEN_S; ++t) {
        const size_t row = (size_t)(T_P + b * LEN_S + t);
        const bf16_t* pp = PROJ + row * NPROJ + cb + h * 64 + lane;
        const float x0 = bf2f(pp[0]), x1 = bf2f(pp[256]), val = bf2f(pp[512]), g = bf2f(pp[768]);
        float dec, key, qry;
        if (isret) {
            const float tr = (float)(16384 + t) * angk;
            const float fr = (tr - floorf(tr)) * 6.283185307179586f;
            const float sn = __sinf(fr), cs = __cosf(fr);
            const float qp = __shfl_xor(x0, 1), kp = __shfl_xor(x1, 1);
            qry = (lane & 1) ? (qp * sn + x0 * cs) : (x0 * cs - qp * sn);
            key = ((lane & 1) ? (kp * sn + x1 * cs) : (x1 * cs - kp * sn)) * 0.125f;
            dec = gam;
        } else {
            const float ef = __expf(-fminf(fmaxf(x1, -30.f), 30.f)), sgm = 1.0f / (1.0f + ef);
            dec = fmaxf(lower + (1.0f - lower) * sgm, 1e-30f); key = (1.0f - lower) * ef * sgm; qry = x0 / (1.0f + __expf(-x0));
        }
        float o = 0.f;
#pragma unroll
        for (int kk = 0; kk < 64; ++kk) { const float dk = rdl(dec, kk), kyk = rdl(key, kk), qk = rdl(qry, kk); S[kk] = fmaf(kyk, val, dk * S[kk]); o = fmaf(qk, S[kk], o); if ((kk & 7) == 7) __builtin_amdgcn_sched_barrier(0); }
        const float mu = isret ? wsum(o) * (1.0f / 64.0f) : 0.f, d = o - mu;
        const float var = wsum(d * d) * (1.0f / 64.0f);
        MIX[row * DM + (isret ? 0 : 256) + h * 64 + lane] = f2bf(d * rsqrtf(var + 1e-6f) * siluf_(g));
    }
#pragma unroll
    for (int k = 0; k < 64; ++k) so[k * 64 + lane] = S[k];
}
__device__ __forceinline__ void ssd_sample_wave(const Ctx& P, int l, int b, int h, int lane, LAS float* YL  ) {
    const bf16_t* PROJ = (const bf16_t*)(P.ws + W_PROJ); bf16_t* MIX = (bf16_t*)(P.ws + W_MIX); float* SSDSQ = (float*)(P.ws + W_SSDSQ);
    const int g = h >> 1;
    const size_t so_ = ((size_t)(l * NB_S + b) * 4 + h) * 8192;
    const float* s0 = P.in(I_SSSD) + so_; float* so = P.out + O_SSSD + so_;
    const float dtb = P.in(I_DTB)[l * 4 + h], aexp = expf(P.in(I_ALOG)[l * 4 + h]), dsk = P.in(I_SSDD)[l * 4 + h];
    const float* cwp = P.in(I_CONVW) + (size_t)l * 4 * 768; const float* cbuf = P.in(I_SCONV) + (size_t)(l * NB_S + b) * 3 * 768;
#pragma unroll 1
    for (int half = 0; half < 2; ++half) {
        float S[64];
#pragma unroll
        for (int n = 0; n < 64; ++n) S[n] = s0[(half * 64 + n) * 64 + lane];
        int ch[3]; ch[0] = h * 64 + lane; ch[1] = 256 + g * 128 + half * 64 + lane; ch[2] = 512 + g * 128 + half * 64 + lane;
        float cw[3][4], cb[3], win[3][3];
#pragma unroll
        for (int c = 0; c < 3; ++c) {
#pragma unroll
            for (int w = 0; w < 4; ++w) cw[c][w] = cwp[w * 768 + ch[c]];
            cb[c] = P.in(I_CONVB)[l * 768 + ch[c]];
#pragma unroll
            for (int w = 0; w < 3; ++w) win[c][w] = bf2f(f2bf(cbuf[w * 768 + ch[c]]));
        }
#pragma unroll 1
        for (int t = 0; t < LEN_S; ++t) {
            const size_t row = (size_t)(T_P + b * LEN_S + t);
            const bf16_t* pr = PROJ + row * NPROJ;
            float cv[3];
#pragma unroll
            for (int c = 0; c < 3; ++c) {
                const float raw = bf2f(pr[C_XBC + ch[c]]);
                cv[c] = siluf_(cb[c] + cw[c][0] * win[c][0] + cw[c][1] * win[c][1] + cw[c][2] * win[c][2] + cw[c][3] * raw);
                win[c][0] = win[c][1]; win[c][1] = win[c][2]; win[c][2] = raw;
            }
            const float dtv = bf2f(pr[C_DT + h]) + dtb;
            const float delta = (dtv > 20.f) ? dtv : log1pf(__expf(dtv));
            const float a = __expf(-delta * aexp);
            const float xc = cv[0], bd = cv[1] * delta;
            float y = 0.f;
#pragma unroll
            for (int n = 0; n < 64; ++n) { const float bn = rdl(bd, n), cn = rdl(cv[2], n); S[n] = fmaf(bn, xc, a * S[n]); y = fmaf(cn, S[n], y); if ((n & 7) == 7) __builtin_amdgcn_sched_barrier(0); }
            if (half == 0) YL[t * 64 + lane] = y;
            else {
                const float z = bf2f(pr[C_SZ + h * 64 + lane]);
                y = (y + YL[t * 64 + lane] + dsk * xc) * siluf_(z);
                MIX[row * DM + 512 + h * 64 + lane] = f2bf(y);
                const float ss = wsum(y * y);
                if (lane == 0) SSDSQ[row * 4 + h] = ss;
            }
        }
#pragma unroll
        for (int n = 0; n < 64; ++n) so[(half * 64 + n) * 64 + lane] = S[n];
    }
    if (h == 0) {
        float* co = P.out + O_SCONV + (size_t)(l * NB_S + b) * 2304;
        for (int idx = lane; idx < 2304; idx += 64) { const int rr = idx / 768, c = idx % 768; co[idx] = bf2f(PROJ[(size_t)(T_P + b * LEN_S + LEN_S - 3 + rr) * NPROJ + C_XBC + c]); }
    }
}

constexpr int N_P1 = 8 * 4 * (NS - 1), N_P1S5 = 8 * 2 * (NS - 1), N_SUB0 = 3 * N_P1 + N_P1S5 + 64 + 64;
constexpr int N_P2 = 8 * 4 * NS, N_P2S5 = 8 * 2 * NS, N_SUB1 = 3 * N_P2 + N_P2S5 + 128;
__device__ __forceinline__ void ssd_norm_block(const Ctx& P, int l, int pm) {
    const int tid_ = pg8::opaque_tid(), wave = tid_ >> 6, lane = tid_ & 63;
    bf16_t* MIX = (bf16_t*)(P.ws + W_MIX); const float* SSDSQ = (const float*)(P.ws + W_SSDSQ);
    const f32x4 nw = *(const f32x4*)(P.in(I_SSDN) + l * 256 + lane * 4);
    const int gq = lane >> 5, r0 = pm * 256 + wave * 32;
    u32x2 w[32]; float ss[32];
#pragma unroll
    for (int u = 0; u < 32; ++u) { const int row = r0 + u; ss[u] = SSDSQ[(size_t)row * 4 + 2 * gq] + SSDSQ[(size_t)row * 4 + 2 * gq + 1]; w[u] = *(const u32x2*)(MIX + (size_t)row * DM + 512 + lane * 4); }
#pragma unroll
    for (int u = 0; u < 32; ++u) { const int row = r0 + u;
        const float rstd = rsqrtf(ss[u] * (1.0f / 128.0f) + 1e-6f);
        const float a = __uint_as_float(w[u].x << 16) * rstd * nw[0], b = __uint_as_float(w[u].x & 0xffff0000u) * rstd * nw[1];
        const float c = __uint_as_float(w[u].y << 16) * rstd * nw[2], d = __uint_as_float(w[u].y & 0xffff0000u) * rstd * nw[3];
        u32x2 o; o.x = cvt_pk_bf16(a, b); o.y = cvt_pk_bf16(c, d);
        *(u32x2*)(MIX + (size_t)row * DM + 512 + lane * 4) = o; }
}
constexpr size_t W_DEP = 20480;
__device__ __forceinline__ void mixer_phase(const Ctx& P, int l, ldsp lds) {
    unsigned* ctr = (unsigned*)(P.ws + W_CTL) + l * 32;
    unsigned* dep = (unsigned*)(P.ws + W_CTL + W_DEP) + l * 512;
    LAS int* slot = (LAS int*)(lds + L_QSLOT);
    const int nitems = N_SUB0 + N_SUB1 + 136;
    unsigned* dg = dep + 4 * 64; unsigned* df = dep + 4 * 64 + 68;
    __syncthreads();
    if (threadIdx.x == 0) *slot = (int)atomicAdd(ctr, 1u);
    __syncthreads();
    int id = *slot;
    while (id < nitems) {
        int nxt = 0;
        if (threadIdx.x == 0) nxt = (int)atomicAdd(ctr, 1u);
        int type, a, b2 = 0, c = 1, seg = 0, tb = 0, te = LEN_S, init = 1, full = 1, store = 1;
        const int tailid = id - (N_SUB0 + N_SUB1);
        if (tailid >= 0) id = N_SUB0;
        const int sub = id >= N_SUB0 ? 1 : 0;
        const int qid = sub ? id - N_SUB0 : id;
        { const int nS5 = sub == 0 ? N_P1S5 : N_P2S5, nOth = sub == 0 ? 3 * N_P1 : 3 * N_P2; id = qid < nS5 ? nOth + qid : (qid < nS5 + nOth ? qid - nS5 : qid); }
        if (sub == 0) {
            if (id < 3 * N_P1) { type = id / N_P1; const int j = id % N_P1; a = j / (4 * (NS - 1)); b2 = (j / (NS - 1)) & 3; seg = j % (NS - 1); init = 0; full = 0; store = 2; tb = seg * SL; te = tb + SL; }
            else if (id < 3 * N_P1 + N_P1S5) { type = 3; const int j = id - 3 * N_P1; b2 = j / (2 * (NS - 1)); a = (j / (NS - 1)) & 1; seg = j % (NS - 1); init = 0; full = 0; store = 2; tb = seg * SL; te = tb + SL; }
            else { const int j = id - 3 * N_P1 - N_P1S5;
                if (j < 64) { type = 4; a = j; }
                else { type = 3; a = (j - 64) & 1; b2 = NB_P + ((j - 64) >> 1) * 4; c = 4; } }
        } else {
            if (id < 3 * N_P2) { type = id / N_P2; const int j = id % N_P2; a = j / (4 * NS); b2 = (j / NS) & 3; seg = j % NS; }
            else if (id < 3 * N_P2 + N_P2S5) { type = 3; const int j = id - 3 * N_P2; b2 = j / (2 * NS); a = (j / NS) & 1; seg = j % NS; }
            else { const int j = id - 3 * N_P2 - N_P2S5; type = 5 + j / 64; a = j % 64; }
            if (type < 4) { init = seg > 0 ? 2 : 0; full = 1; store = (seg == NS - 1) ? 1 : 0; tb = seg * SL; te = tb + SL; }
        }
        if (tailid >= 0) { type = tailid < 68 ? 7 : 8; a = tailid < 68 ? tailid : tailid - 68; seg = 0; store = 0; }
        int chain = (type == 3) ? (b2 & 7) * 2 + a : (a & 7) * 4 + b2;
        chain = __builtin_amdgcn_readfirstlane(chain);
        int ptile = -1;
        if (sub == 1 && type == 3) ptile = (b2 & 7) * 8 + seg;
        if (sub == 1 && type == 0) ptile = (a & 7) * 8 + seg;
        if (sub == 0 && type == 3 && store == 1) ptile = 64 + (b2 - NB_P) / 32;
        if (type == 4) ptile = 64 + a / 16;
        if (tailid >= 0) ptile = -1;
        ptile = __builtin_amdgcn_readfirstlane(ptile);
        type = __builtin_amdgcn_readfirstlane(type); a = __builtin_amdgcn_readfirstlane(a); b2 = __builtin_amdgcn_readfirstlane(b2); c = __builtin_amdgcn_readfirstlane(c);
        seg = __builtin_amdgcn_readfirstlane(seg); tb = __builtin_amdgcn_readfirstlane(tb); te = __builtin_amdgcn_readfirstlane(te);
        init = __builtin_amdgcn_readfirstlane(init); full = __builtin_amdgcn_readfirstlane(full); store = __builtin_amdgcn_readfirstlane(store);
        if (sub == 1 && type < 4 && seg > 0) {
            if (threadIdx.x == 0) {
                unsigned* d = dep + type * 64 + chain;
                while (__hip_atomic_load(d, __ATOMIC_RELAXED, __HIP_MEMORY_SCOPE_AGENT) < (unsigned)(NS - 1)) __builtin_amdgcn_s_sleep(2);
                __builtin_amdgcn_fence(__ATOMIC_ACQUIRE, "agent"); asm volatile("s_waitcnt vmcnt(0)" ::: "memory");
            }
            __syncthreads();
        }
        if (type >= 7) {
            if (threadIdx.x == 0) {
                unsigned* d = (type == 7 ? dg : df) + a; const unsigned need = a < 64 ? (type == 7 ? 2u : 4u) : 16u;
                while (__hip_atomic_load(d, __ATOMIC_RELAXED, __HIP_MEMORY_SCOPE_AGENT) < need) __builtin_amdgcn_s_sleep(2);
                __builtin_amdgcn_fence(__ATOMIC_ACQUIRE, "agent"); asm volatile("s_waitcnt vmcnt(0)" ::: "memory");
            }
            __syncthreads();
            if (type == 7) {
                const bf16_t* YP = (const bf16_t*)(P.ws + W_YPRE);
                pg8::Gemm g{YP, (const bf16_t*)(P.ws + W_WGLU) + (size_t)l * 256 * 256, TT, 256, 256}; pg8::OneUnit S1{a, 4};
                pg8::EpiGlu E{YP, (bf16_t*)(P.ws + W_MIX), P.in(I_GLUB) + l * 256};
                pg8::gemm_phase<pg8::EpiGlu, pg8::OneUnit>(lds, g, S1, E, nullptr);
            } else ssd_norm_block(P, l, a);
        }
        if (type >= 4 && type < 7) {
            const int tq = pg8::opaque_tid(), pair = a * 8 + (tq >> 6), sb = pair >> 2, sh = pair & 3, ln = tq & 63;
            if (type == 4) ssd_sample_wave(P, l, sb, sh, ln, (LAS float*)(lds + (tq >> 6) * 2048));
            else rh_sample_wave(P, l, sb, sh, ln, type == 5);
        }
#ifndef SK_SSD
        if (type == 0) ssd_item(P, l, a, b2, tb, te, init, full, store, seg, lds);
#endif
#ifdef DBL_SSD
        if (type == 0) { __syncthreads(); ssd_item(P, l, a, b2, tb, te, init, full, store, seg, lds); }
#endif
#ifndef SK_RET
        if (type == 1) ret_item(P, l, a, b2, tb, te, init, full, store, seg, lds);
#endif
#ifdef DBL_RET
        if (type == 1) { __syncthreads(); ret_item(P, l, a, b2, tb, te, init, full, store, seg, lds); }
#endif
#ifndef SK_HG
        if (type == 2) hgrn_item(P, l, a, b2, tb, te, init, full, store, seg, lds);
#endif
#ifdef DBL_HG
        if (type == 2) { __syncthreads(); hgrn_item(P, l, a, b2, tb, te, init, full, store, seg, lds); }
#endif
#ifndef SK_S5
        if (type == 3) s5_item(P, l, a, b2, c, tb, te, init, full, store, seg, lds);
#endif
#ifdef DBL_S5
        if (type == 3) { __syncthreads(); s5_item(P, l, a, b2, c, tb, te, init, full, store, seg, lds); }
#endif
        if (sub == 0 && store == 2) {
            asm volatile("s_waitcnt vmcnt(0)" ::: "memory");
            __syncthreads();
            if (threadIdx.x == 0) { __builtin_amdgcn_fence(__ATOMIC_RELEASE, "agent"); asm volatile("s_waitcnt vmcnt(0)" ::: "memory");
                __hip_atomic_fetch_add(dep + type * 64 + chain, 1u, __ATOMIC_RELAXED, __HIP_MEMORY_SCOPE_AGENT); }
        }
        if (ptile >= 0) {
            asm volatile("s_waitcnt vmcnt(0)" ::: "memory");
            __syncthreads();
            if (threadIdx.x == 0) { __builtin_amdgcn_fence(__ATOMIC_RELEASE, "agent"); asm volatile("s_waitcnt vmcnt(0)" ::: "memory");
                __hip_atomic_fetch_add(((type == 3) ? dg : df) + ptile, 1u, __ATOMIC_RELAXED, __HIP_MEMORY_SCOPE_AGENT); }
        }
        __syncthreads();
        if (threadIdx.x == 0) *slot = nxt;
        __syncthreads();
        id = *slot;
    }
}

__device__ __forceinline__ void ssd_norm_fix(const Ctx& P, int l) {
    const int tid_ = pg8::opaque_tid(), wave = tid_ >> 6, lane = tid_ & 63;
    bf16_t* MIX = (bf16_t*)(P.ws + W_MIX); const float* SSDSQ = (const float*)(P.ws + W_SSDSQ);
    const f32x4 nw = *(const f32x4*)(P.in(I_SSDN) + l * 256 + lane * 4);
    const int nskip = gridDim.x >= 136 ? 68 : 0;
    if ((int)blockIdx.x < nskip) return;
    const int gq = lane >> 5, stride = (gridDim.x - nskip) * 8;
    for (int rb = ((int)blockIdx.x - nskip) * 8 + wave; rb < TT; rb += 4 * stride) {
        u32x2 w[4]; float ss[4];
#pragma unroll
        for (int u = 0; u < 4; ++u) { const int row = rb + u * stride; ss[u] = 0.f; w[u] = (u32x2){0u, 0u};
            if (row < TT) { ss[u] = SSDSQ[(size_t)row * 4 + 2 * gq] + SSDSQ[(size_t)row * 4 + 2 * gq + 1]; w[u] = *(const u32x2*)(MIX + (size_t)row * DM + 512 + lane * 4); } }
#pragma unroll
        for (int u = 0; u < 4; ++u) { const int row = rb + u * stride;
            if (row < TT) {
                const float rstd = rsqrtf(ss[u] * (1.0f / 128.0f) + 1e-6f);
                const float a = __uint_as_float(w[u].x << 16) * rstd * nw[0], b = __uint_as_float(w[u].x & 0xffff0000u) * rstd * nw[1];
                const float c = __uint_as_float(w[u].y << 16) * rstd * nw[2], d = __uint_as_float(w[u].y & 0xffff0000u) * rstd * nw[3];
                u32x2 o; o.x = cvt_pk_bf16(a, b); o.y = cvt_pk_bf16(c, d);
                *(u32x2*)(MIX + (size_t)row * DM + 512 + lane * 4) = o;
            } }
    }
}
template <int NSPLIT, bool SLAB16>
__device__ __forceinline__ void sample_fix(const Ctx& P, const float* slab) {
    const int tid_ = pg8::opaque_tid(), wave = tid_ >> 6, lane = tid_ & 63;
    bf16_t* XB = (bf16_t*)(P.ws + W_XB); float* SSQ = (float*)(P.ws + W_SSQ); float* RSTD = (float*)(P.ws + W_RSTD);
    for (int row = T_P + blockIdx.x * 8 + wave; row < TT; row += gridDim.x * 8) {
        float* xp = P.out + (size_t)row * DM; float s = 0.f;
        f32x4 v[4]; u32x2 w16[SLAB16 ? 4 : 1][SLAB16 ? NSPLIT : 1]; f32x4 w32[SLAB16 ? 1 : 4][SLAB16 ? 1 : NSPLIT];
#pragma unroll
        for (int j = 0; j < 4; ++j) {
            v[j] = *(const f32x4*)(xp + j * 256 + lane * 4);
#pragma unroll
            for (int k = 0; k < NSPLIT; ++k) {
                if (SLAB16) w16[j][k] = *(const u32x2*)((const bf16_t*)slab + ((size_t)k * 1024 + (row - T_P)) * 1024 + j * 256 + lane * 4);
                else w32[j][k] = *(const f32x4*)(slab + ((size_t)k * 1024 + (row - T_P)) * 1024 + j * 256 + lane * 4);
            }
        }
#pragma unroll
        for (int j = 0; j < 4; ++j) {
            f32x4 a = v[j];
#pragma unroll
            for (int k = 0; k < NSPLIT; ++k) {
                if (SLAB16) { const u32x2 w2 = w16[j][k]; a[0] += __uint_as_float(w2.x << 16); a[1] += __uint_as_float(w2.x & 0xffff0000u); a[2] += __uint_as_float(w2.y << 16); a[3] += __uint_as_float(w2.y & 0xffff0000u); }
                else a += w32[j][k];
            }
            *(f32x4*)(xp + j * 256 + lane * 4) = a;
            s += (a[0] * a[0] + a[1] * a[1]) + (a[2] * a[2] + a[3] * a[3]);
            u32x2 w; w.x = cvt_pk_bf16(a[0], a[1]); w.y = cvt_pk_bf16(a[2], a[3]);
            *(u32x2*)(XB + (size_t)row * DM + j * 256 + lane * 4) = w;
        }
#pragma unroll
        for (int o = 32; o >= 1; o >>= 1) s += __shfl_xor(s, o);
        if (lane < 16) SSQ[(size_t)row * 16 + lane] = (lane == 0) ? s : 0.f;
        if (lane == 0) RSTD[row] = rsqrtf(s * (1.0f / 1024.0f) + 1e-6f);
    }
    for (int r = blockIdx.x * 64 + tid_; tid_ < 64 && r < T_P; r += gridDim.x * 64) {
        const f32x4* sp = (const f32x4*)(SSQ + (size_t)r * 16);
        const f32x4 s0 = sp[0], s1 = sp[1], s2 = sp[2], s3 = sp[3];
        const float ss = ((s0[0] + s0[1]) + (s0[2] + s0[3])) + ((s1[0] + s1[1]) + (s1[2] + s1[3])) + ((s2[0] + s2[1]) + (s2[2] + s2[3])) + ((s3[0] + s3[1]) + (s3[2] + s3[3]));
        RSTD[r] = rsqrtf(ss * (1.0f / 1024.0f) + 1e-6f);
    }
}
__device__ __forceinline__ void final_norm(const Ctx& P) {
    const int tid_ = pg8::opaque_tid(), wave = tid_ >> 6, lane = tid_ & 63;
    const float* SSQ = (const float*)(P.ws + W_SSQ); const float* nf = P.in(I_NFIN);
    f32x4 wv[4];
#pragma unroll
    for (int j = 0; j < 4; ++j) wv[j] = *(const f32x4*)(nf + j * 256 + lane * 4);
    const int stride = gridDim.x * 8;
    for (int rb = blockIdx.x * 8 + wave; rb < TT; rb += 4 * stride) {
        f32x4 v[4][4]; float sq[4];
#pragma unroll
        for (int u = 0; u < 4; ++u) { const int row = rb + u * stride;
            sq[u] = (row < TT && lane < 16) ? SSQ[(size_t)row * 16 + lane] : 0.f;
#pragma unroll
            for (int j = 0; j < 4; ++j) v[u][j] = (row < TT) ? *(const f32x4*)(P.out + (size_t)row * DM + j * 256 + lane * 4) : (f32x4){0.f, 0.f, 0.f, 0.f}; }
#pragma unroll
        for (int u = 0; u < 4; ++u) { const int row = rb + u * stride;
            float s = sq[u];
#pragma unroll
            for (int o = 8; o >= 1; o >>= 1) s += __shfl_xor(s, o);
            s = __shfl(s, 0);
            const float rstd = rsqrtf(s * (1.0f / 1024.0f) + 1e-6f);
            if (row < TT) {
#pragma unroll
                for (int j = 0; j < 4; ++j) *(f32x4*)(P.out + (size_t)row * DM + j * 256 + lane * 4) = v[u][j] * rstd * wv[j];
            } }
    }
}

__global__ void __launch_bounds__(512, 2) fwd_megakernel(Params P) {
    extern __shared__ __attribute__((aligned(16))) unsigned char lds_raw[];
    cg::grid_group grid = cg::this_grid();
    ldsp lds = (ldsp)lds_raw;
    const int G = gridDim.x, bid = blockIdx.x;
#define PHASE_PTRS unsigned char* ws = P.ws; asm volatile("" : "+s"(ws)); float* X = P.out; asm volatile("" : "+s"(X)); \
    bf16_t* XB = (bf16_t*)(ws + W_XB); bf16_t* MIX = (bf16_t*)(ws + W_MIX); bf16_t* PROJ = (bf16_t*)(ws + W_PROJ); bf16_t* HID = (bf16_t*)(ws + W_HID); bf16_t* YPRE = (bf16_t*)(ws + W_YPRE); float* SSQ = (float*)(ws + W_SSQ); \
    Ctx C; C.out = X; C.ws = ws; (void)XB; (void)MIX; (void)PROJ; (void)HID; (void)YPRE; (void)SSQ; (void)C

    if (threadIdx.x < 2) ((LAS unsigned*)(lds + L_BARST))[threadIdx.x] = 0u;
    __syncthreads();
    (void)xcd_barrier_post((unsigned*)(P.ws + W_BAR), (volatile LAS unsigned*)(lds + L_BARST));
#define XBAR() do { XcdBarrier xb_; xb_.bar = (unsigned*)(P.ws + W_BAR); xb_.x = xb_xcc_id(); xb_.st = (volatile LAS unsigned*)(lds + L_BARST); xcd_barrier(xb_); } while (0)
    phase0(P, lds);
    if (bid == 0) {
#pragma unroll
        for (int i = 0; i < N_IN; ++i) if ((int)threadIdx.x == i) ((const float**)(P.ws + W_TAB))[i] = P.in[i];
    }
    XBAR();
    grid.sync();

#pragma unroll 1
    for (int l = 0; l < 2; ++l) {
        {
            PHASE_PTRS;
            pg8::Gemm g{XB, (const bf16_t*)(ws + W_WIN) + (size_t)l * NPROJ * DM, TT, NPROJ, DM}; pg8::StaticOrder S; S.init(TT, NPROJ, G, bid);
            pg8::EpiScaleBf16<0> E{PROJ, NPROJ, (const float*)(ws + W_RSTD)};
            pg8::gemm_phase<pg8::EpiScaleBf16<0>, pg8::StaticOrder>(lds, g, S, E, nullptr);
        }
        XBAR();
        { PHASE_PTRS; mixer_phase(C, l, lds); }
        XBAR();
        {
            PHASE_PTRS;
            pg8::Gemm g{MIX, (const bf16_t*)(ws + W_WOUT) + (size_t)l * DM * DM, TT, DM, DM}; pg8::SplitOrder S; S.init(T_P, DM, G, bid, DM, 4);
            pg8::EpiRes E{l == 0 ? C.in(I_XP) : X, X + (size_t)T_P * DM, X, XB, SSQ, (float*)HID, 0};
            pg8::gemm_phase<pg8::EpiRes, pg8::SplitOrder>(lds, g, S, E, nullptr);
        }
        XBAR();
        { PHASE_PTRS; sample_fix<4, false>(C, (const float*)HID); }
        XBAR();
        {
            PHASE_PTRS;
            pg8::Gemm g{XB, (const bf16_t*)(ws + W_WUP) + (size_t)l * DFF * DM, TT, DFF, DM}; pg8::StaticOrder S; S.init(TT, DFF, G, bid);
            pg8::EpiScaleBf16<1> E{HID, DFF, (const float*)(ws + W_RSTD)};
#ifdef REP_UP
#pragma unroll 1
            for (int rep = 0; rep < 3; ++rep)
#endif
            pg8::gemm_phase<pg8::EpiScaleBf16<1>, pg8::StaticOrder>(lds, g, S, E, nullptr);
        }
        XBAR();
        {
            PHASE_PTRS;
            pg8::Gemm g{HID, (const bf16_t*)(ws + W_WDN) + (size_t)l * DM * DFF, TT, DM, DFF}; pg8::SplitOrder S; S.init(T_P, DM, G, bid, DFF, 16);
            pg8::EpiRes E{X, X + (size_t)T_P * DM, X, XB, SSQ, (float*)MIX, 1};
            pg8::gemm_phase<pg8::EpiRes, pg8::SplitOrder>(lds, g, S, E, nullptr);
        }
        XBAR();
        { PHASE_PTRS; sample_fix<16, true>(C, (const float*)MIX); }
        XBAR();
    }
    { PHASE_PTRS; final_norm(C); }
#undef PHASE_PTRS
}
}

extern "C" void kernel_launch(void* const* d_in, const int* in_sizes, int n_in, void* d_out, int out_size, void* d_ws, size_t ws_size, hipStream_t stream) {
    static int grid_blocks = 0;
    if (grid_blocks == 0) {
        if (n_in != mk::N_IN || (size_t)out_size != mk::O_END || ws_size < mk::W_END) {
            fprintf(stderr, "kernel_launch: unexpected shapes: n_in %d out %d ws %zu (need %zu)\n", n_in, out_size, ws_size, (size_t)mk::W_END); grid_blocks = -1; return; }
        int dev = 0, cus = 0, per_cu = 0;
        (void)hipGetDevice(&dev);
        (void)hipDeviceGetAttribute(&cus, hipDeviceAttributeMultiprocessorCount, dev);
        (void)hipFuncSetAttribute((const void*)mk::fwd_megakernel, hipFuncAttributeMaxDynamicSharedMemorySize, mk::LDS_BYTES);
        (void)hipOccupancyMaxActiveBlocksPerMultiprocessor(&per_cu, (const void*)mk::fwd_megakernel, 512, mk::LDS_BYTES);
        if (per_cu < 1) { fprintf(stderr, "kernel_launch: occupancy query says 0 blocks per CU\n"); per_cu = 1; }
        if (per_cu > 1) per_cu = 1;
        grid_blocks = cus * per_cu;
    }
    if (grid_blocks < 0) return;
    (void)hipMemsetAsync((char*)d_ws + mk::W_CTL, 0, 32768, stream);
    mk::Params p{};
    for (int i = 0; i < mk::N_IN; ++i) p.in[i] = (const float*)d_in[i];
    p.out = (float*)d_out; p.ws = (unsigned char*)d_ws;
    void* args[] = {&p};
    hipError_t e = hipLaunchCooperativeKernel((const void*)mk::fwd_megakernel, dim3(grid_blocks), dim3(512), args, mk::LDS_BYTES, stream);
    if (e != hipSuccess) fprintf(stderr, "cooperative launch failed: %s (grid %d)\n", hipGetErrorString(e), grid_blocks);
}
```
